# Optimizing an MI355X kernel written in HIP

```python
import functools
import jax, jax.numpy as jnp
from jax import lax
import numpy as np

D_MODEL = 1024
BATCH = 4
SEQ = 4096
DEPTH = 1

PLE_DIM = 256
D_FF = 2816
NORM_EPS = 1e-6
GM_WIDTH = 1024
GM_GROUPS = 8
GM_GROUP_DIM = GM_WIDTH // GM_GROUPS
GM_CHUNK = 128
N_HEADS = 16
N_KV_HEADS = 4
HEAD_DIM = 64
Q_PER_KV = N_HEADS // N_KV_HEADS
KV_WIDTH = N_KV_HEADS * HEAD_DIM
ROPE_DIM = HEAD_DIM // 4
ROPE_THETA = 500000.0
CMP_LEN = 32
CMP_STRIDE = 16
CMP_HIDDEN = 256
SEL_LEN = 64
SEL_TOP = 16
WINDOW = 512
Q_BLOCK = 64
N_NSA_BRANCH = 3
N_MERGE = 2
MASK_VALUE = -1e30
FORCE_SCORE = 1e9
IN_SPLITS = [GM_WIDTH, GM_WIDTH, N_HEADS * HEAD_DIM, 6 * KV_WIDTH, N_HEADS * N_NSA_BRANCH, N_MERGE * D_MODEL]

kernel_name = 'hybrid_gmlp_nsa_macaron'


def rms_norm(x, g):
    xf = x.astype(jnp.float32)
    y = xf * lax.rsqrt(jnp.mean(xf * xf, axis=-1, keepdims=True) + NORM_EPS)
    return (y * g.astype(jnp.float32)).astype(x.dtype)


def layer_norm(x, g, b):
    xf = x.astype(jnp.float32)
    mu = jnp.mean(xf, axis=-1, keepdims=True)
    var = jnp.mean(jnp.square(xf - mu), axis=-1, keepdims=True)
    y = (xf - mu) * lax.rsqrt(var + NORM_EPS)
    return (y * g.astype(jnp.float32) + b.astype(jnp.float32)).astype(x.dtype)


def swiglu(x, w_in, w_out):
    gate, up = jnp.split(x @ w_in, 2, axis=-1)
    return (jax.nn.silu(gate) * up) @ w_out


def rotary(x, pos):
    inv_freq = ROPE_THETA ** (-jnp.arange(0, ROPE_DIM, 2, dtype=jnp.float32) / ROPE_DIM)
    ang = pos.astype(jnp.float32)[:, None] * inv_freq[None, :]
    cos = jnp.cos(ang)[None, :, None, :]
    sin = jnp.sin(ang)[None, :, None, :]
    xr = x[..., :ROPE_DIM].astype(jnp.float32)
    x1, x2 = jnp.split(xr, 2, axis=-1)
    rot = jnp.concatenate([x1 * cos - x2 * sin, x2 * cos + x1 * sin], axis=-1).astype(x.dtype)
    return jnp.concatenate([rot, x[..., ROPE_DIM:]], axis=-1)


def masked_softmax(s, mask):
    s = jnp.where(mask, s.astype(jnp.float32), MASK_VALUE)
    return jax.nn.softmax(s, axis=-1) * mask


def gmlp_mixer(u, v, ln_g, ln_b, w_s, b_s):
    B, S, _ = u.shape
    vn = layer_norm(v, ln_g, ln_b).reshape(B, S // GM_CHUNK, GM_CHUNK, GM_GROUPS, GM_GROUP_DIM)
    causal = jnp.tril(jnp.ones((GM_CHUNK, GM_CHUNK), dtype=bool))
    w = jnp.where(causal[None], w_s, jnp.zeros_like(w_s))
    mix = jnp.einsum('gts,bcsgd->bctgd', w, vn) + b_s.T[None, None, :, :, None]
    return u * mix.reshape(B, S, GM_WIDTH)


def compress(x, pos_emb, w1, w2):
    B, S = x.shape[:2]
    n_sub = CMP_LEN // CMP_STRIDE
    n_chunks = S // CMP_STRIDE
    n_cmp = n_chunks - n_sub + 1
    xc = x.reshape(B, n_chunks, CMP_STRIDE, N_KV_HEADS, HEAD_DIM)
    blocks = jnp.concatenate([xc[:, r:r + n_cmp] for r in range(n_sub)], axis=2)
    blocks = blocks + pos_emb[None, None, :, None, :]
    flat = blocks.transpose(0, 1, 3, 2, 4).reshape(B, n_cmp, N_KV_HEADS, CMP_LEN * HEAD_DIM)
    return jax.nn.gelu(flat @ w1) @ w2


def selection_importance(p_cmp, n_sel):
    r_sel = SEL_LEN // CMP_STRIDE
    l_cmp = CMP_LEN // CMP_STRIDE
    pad = ((0, 0),) * (p_cmp.ndim - 1) + ((l_cmp - 1, r_sel + l_cmp),)
    padded = jnp.pad(p_cmp, pad)
    imp = jnp.zeros(p_cmp.shape[:-1] + (n_sel,), p_cmp.dtype)
    for r in range(1 - l_cmp, r_sel):
        start = r + l_cmp - 1
        imp = imp + padded[..., start:start + r_sel * n_sel:r_sel]
    return imp


def nsa_query_block(args, k_cmp, v_cmp, k_sel_blocks, v_sel_blocks, k_win_pad, v_win_pad):
    q_raw, q_rot, gate_logits, s0 = args
    B = q_raw.shape[0]
    n_cmp = k_cmp.shape[1]
    n_sel = k_sel_blocks.shape[2]
    n_top = min(SEL_TOP, n_sel)
    t = s0 + jnp.arange(Q_BLOCK)
    scale = HEAD_DIM ** -0.5
    qg = q_raw.reshape(B, Q_BLOCK, N_KV_HEADS, Q_PER_KV, HEAD_DIM)
    s_c = jnp.einsum('bqkgd,bnkd->bkgqn', qg, k_cmp) * scale
    cmp_end = jnp.arange(n_cmp) * CMP_STRIDE + CMP_LEN - 1
    p_c = masked_softmax(s_c, cmp_end[None, :] <= t[:, None])
    o_cmp = jnp.einsum('bkgqn,bnkd->bqkgd', p_c.astype(v_cmp.dtype), v_cmp)
    imp = selection_importance(p_c.sum(axis=2), n_sel)
    blk = jnp.arange(n_sel)[None, :]
    cur = (t // SEL_LEN)[:, None]
    forced = (blk == 0) | (blk == cur) | (blk == cur - 1)
    future = blk > cur
    score = jnp.where(forced, FORCE_SCORE, jnp.where(future, -FORCE_SCORE, imp))
    _, idx = lax.top_k(score, n_top)
    bi = jnp.arange(B)[:, None, None, None]
    ki = jnp.arange(N_KV_HEADS)[None, :, None, None]
    k_g = k_sel_blocks[bi, ki, idx]
    v_g = v_sel_blocks[bi, ki, idx]
    qs = q_rot.reshape(B, Q_BLOCK, N_KV_HEADS, Q_PER_KV, HEAD_DIM)
    s_s = jnp.einsum('bqkgd,bkqnld->bkgqnl', qs, k_g) * scale
    key_pos = idx[..., None] * SEL_LEN + jnp.arange(SEL_LEN)
    sel_mask = (key_pos <= t[None, None, :, None, None]).reshape(B, N_KV_HEADS, 1, Q_BLOCK, n_top * SEL_LEN)
    p_s = masked_softmax(s_s.reshape(B, N_KV_HEADS, Q_PER_KV, Q_BLOCK, n_top * SEL_LEN), sel_mask)
    p_s = p_s.reshape(s_s.shape).astype(v_g.dtype)
    o_sel = jnp.einsum('bkgqnl,bkqnld->bqkgd', p_s, v_g)
    k_w = lax.dynamic_slice_in_dim(k_win_pad, s0, WINDOW + Q_BLOCK, axis=1)
    v_w = lax.dynamic_slice_in_dim(v_win_pad, s0, WINDOW + Q_BLOCK, axis=1)
    pos = s0 - WINDOW + jnp.arange(WINDOW + Q_BLOCK)
    dist = t[:, None] - pos[None, :]
    win_mask = (dist >= 0) & (dist < WINDOW) & (pos[None, :] >= 0)
    s_w = jnp.einsum('bqkgd,blkd->bkgql', qs, k_w) * scale
    p_w = masked_softmax(s_w, win_mask).astype(v_w.dtype)
    o_win = jnp.einsum('bkgql,blkd->bqkgd', p_w, v_w)
    g = jax.nn.sigmoid(gate_logits.astype(jnp.float32)).reshape(B, Q_BLOCK, N_KV_HEADS, Q_PER_KV, N_NSA_BRANCH)
    o = g[..., 0:1] * o_cmp + g[..., 1:2] * o_sel + g[..., 2:3] * o_win
    return o.reshape(B, Q_BLOCK, N_HEADS * HEAD_DIM).astype(q_raw.dtype)


def nsa_mixer(q, k_c, v_c, k_s, v_s, k_w, v_w, gate_logits,
              cmp_pos_k, cmp_k_w1, cmp_k_w2, cmp_pos_v, cmp_v_w1, cmp_v_w2):
    B, S = q.shape[:2]
    pos = jnp.arange(S)
    q_rot = rotary(q, pos)
    k_cmp = compress(k_c, cmp_pos_k, cmp_k_w1, cmp_k_w2)
    v_cmp = compress(v_c, cmp_pos_v, cmp_v_w1, cmp_v_w2)
    n_sel = S // SEL_LEN

    def to_blocks(a):
        return a.reshape(B, n_sel, SEL_LEN, N_KV_HEADS, HEAD_DIM).transpose(0, 3, 1, 2, 4)

    k_sel_blocks = to_blocks(rotary(k_s, pos))
    v_sel_blocks = to_blocks(v_s)
    pad = ((0, 0), (WINDOW, 0), (0, 0), (0, 0))
    k_win_pad = jnp.pad(rotary(k_w, pos), pad)
    v_win_pad = jnp.pad(v_w, pad)
    n_qb = S // Q_BLOCK

    def q_blocks(a):
        return a.reshape((B, n_qb, Q_BLOCK) + a.shape[2:]).swapaxes(0, 1)

    starts = jnp.arange(n_qb, dtype=jnp.int32) * Q_BLOCK
    step = functools.partial(nsa_query_block, k_cmp=k_cmp, v_cmp=v_cmp, k_sel_blocks=k_sel_blocks,
                             v_sel_blocks=v_sel_blocks, k_win_pad=k_win_pad, v_win_pad=v_win_pad)
    out = lax.map(step, (q_blocks(q), q_blocks(q_rot), q_blocks(gate_logits), starts))
    return out.swapaxes(0, 1).reshape(B, S, N_HEADS * HEAD_DIM)


def setup_inputs(seed: int = 0) -> dict:
    key = jax.random.key(seed)
    ks = iter(jax.random.split(key, 40))

    def nrm(shape, scale):
        return scale * jax.random.normal(next(ks), shape, jnp.float32)

    def gain(n):
        return 1.0 + nrm((DEPTH, n), 0.02)

    in_width = sum(IN_SPLITS)
    return {
        'x': nrm((BATCH, SEQ, D_MODEL), 1.0),
        'p': nrm((DEPTH, BATCH, SEQ, PLE_DIM), 1.0),
        'ffn1_norm': gain(D_MODEL),
        'ffn1_w_in': nrm((DEPTH, D_MODEL, 2 * D_FF), D_MODEL ** -0.5),
        'ffn1_w_out': nrm((DEPTH, D_FF, D_MODEL), D_FF ** -0.5),
        'mix_norm': gain(D_MODEL),
        'w_in': nrm((DEPTH, D_MODEL, in_width), D_MODEL ** -0.5),
        'gm_ln_g': gain(GM_WIDTH),
        'gm_ln_b': nrm((DEPTH, GM_WIDTH), 0.02),
        'gm_w_s': nrm((DEPTH, GM_GROUPS, GM_CHUNK, GM_CHUNK), GM_CHUNK ** -0.5),
        'gm_b_s': 1.0 + nrm((DEPTH, GM_GROUPS, GM_CHUNK), 0.02),
        'w_branch_a': nrm((DEPTH, GM_WIDTH, D_MODEL), GM_WIDTH ** -0.5),
        'cmp_pos_k': nrm((DEPTH, CMP_LEN, HEAD_DIM), 0.02),
        'cmp_k_w1': nrm((DEPTH, CMP_LEN * HEAD_DIM, CMP_HIDDEN), (CMP_LEN * HEAD_DIM) ** -0.5),
        'cmp_k_w2': nrm((DEPTH, CMP_HIDDEN, HEAD_DIM), CMP_HIDDEN ** -0.5),
        'cmp_pos_v': nrm((DEPTH, CMP_LEN, HEAD_DIM), 0.02),
        'cmp_v_w1': nrm((DEPTH, CMP_LEN * HEAD_DIM, CMP_HIDDEN), (CMP_LEN * HEAD_DIM) ** -0.5),
        'cmp_v_w2': nrm((DEPTH, CMP_HIDDEN, HEAD_DIM), CMP_HIDDEN ** -0.5),
        'w_branch_b': nrm((DEPTH, N_HEADS * HEAD_DIM, D_MODEL), (N_HEADS * HEAD_DIM) ** -0.5),
        'w_out': nrm((DEPTH, D_MODEL, D_MODEL), D_MODEL ** -0.5),
        'ffn2_norm': gain(D_MODEL),
        'ffn2_w_in': nrm((DEPTH, D_MODEL, 2 * D_FF), D_MODEL ** -0.5),
        'ffn2_w_out': nrm((DEPTH, D_FF, D_MODEL), D_FF ** -0.5),
        'ple_norm': gain(D_MODEL),
        'ple_w_gate': nrm((DEPTH, D_MODEL, D_MODEL), D_MODEL ** -0.5),
        'ple_w_proj': nrm((DEPTH, PLE_DIM, D_MODEL), PLE_DIM ** -0.5),
        'final_norm': 1.0 + nrm((D_MODEL,), 0.02),
    }


def reference(x, p, ffn1_norm, ffn1_w_in, ffn1_w_out, mix_norm, w_in, gm_ln_g, gm_ln_b, gm_w_s, gm_b_s,
              w_branch_a, cmp_pos_k, cmp_k_w1, cmp_k_w2, cmp_pos_v, cmp_v_w1, cmp_v_w2, w_branch_b, w_out,
              ffn2_norm, ffn2_w_in, ffn2_w_out, ple_norm, ple_w_gate, ple_w_proj, final_norm):
    B, S, _ = x.shape
    offsets = np.cumsum(IN_SPLITS)[:-1].tolist()
    h = x
    for i in range(DEPTH):
        h = h + 0.5 * swiglu(rms_norm(h, ffn1_norm[i]), ffn1_w_in[i], ffn1_w_out[i])
        n = rms_norm(h, mix_norm[i])
        u, v, q, kv, nsa_gate, merge_gate = jnp.split(n @ w_in[i], offsets, axis=-1)
        y_a = gmlp_mixer(jax.nn.gelu(u), jax.nn.gelu(v), gm_ln_g[i], gm_ln_b[i], gm_w_s[i], gm_b_s[i]) @ w_branch_a[i]
        k_c, v_c, k_s, v_s, k_w, v_w = [a.reshape(B, S, N_KV_HEADS, HEAD_DIM) for a in jnp.split(kv, 6, axis=-1)]
        o_b = nsa_mixer(q.reshape(B, S, N_HEADS, HEAD_DIM), k_c, v_c, k_s, v_s, k_w, v_w,
                        nsa_gate.reshape(B, S, N_HEADS, N_NSA_BRANCH),
                        cmp_pos_k[i], cmp_k_w1[i], cmp_k_w2[i], cmp_pos_v[i], cmp_v_w1[i], cmp_v_w2[i])
        y_b = o_b @ w_branch_b[i]
        g_a, g_b = jnp.split(jax.nn.sigmoid(merge_gate), 2, axis=-1)
        h = h + (g_a * y_a + g_b * y_b) @ w_out[i]
        h = h + 0.5 * swiglu(rms_norm(h, ffn2_norm[i]), ffn2_w_in[i], ffn2_w_out[i])
        gate = jax.nn.sigmoid(rms_norm(h, ple_norm[i]) @ ple_w_gate[i])
        h = h + gate * (p[i] @ ple_w_proj[i])
    return rms_norm(h, final_norm)
```

```cpp
#include <hip/hip_runtime.h>
#include <hip/hip_cooperative_groups.h>
#include <cstdint>
#include <cstdio>
namespace cg = cooperative_groups;

#ifndef MK_SINGLE
#define MK_SINGLE 1
#endif

#define LAS __attribute__((address_space(3)))
typedef unsigned short bf16_t;
typedef short bf16x8 __attribute__((ext_vector_type(8)));
typedef float f32x4 __attribute__((ext_vector_type(4)));
typedef float f32x2 __attribute__((ext_vector_type(2)));
typedef float f32x16 __attribute__((ext_vector_type(16)));
typedef unsigned u32x4 __attribute__((ext_vector_type(4)));
typedef unsigned u32x2 __attribute__((ext_vector_type(2)));

constexpr int T = 16384, SEQ = 4096, DM = 1024, FF = 2816, PLE = 256;
constexpr int N3 = 5888;
constexpr float EPS = 1e-6f;
constexpr float LOG2E = 1.4426950408889634f;
constexpr float QSCALE = 0.125f * LOG2E;
constexpr int NPHASE = 13;

constexpr size_t MiB = 1u << 20;
constexpr size_t WS_SSA = 0, WS_SSB = 1 * MiB, WS_VSTAT = 2 * MiB, WS_ROPE = 4 * MiB, WS_GMW = 4 * MiB + 256 * 1024,
                 WS_KCMP = 4 * MiB + 512 * 1024, WS_VCMPT = 5 * MiB, WS_CBIAS = 5 * MiB + 512 * 1024, WS_GATE = 6 * MiB, WS_SSC = 9 * MiB, WS_SSD = 10 * MiB;
constexpr size_t WS_WIN = 11 * MiB;
constexpr size_t WS_WGB = WS_WIN + (size_t)N3 * 1024 * 2;
constexpr size_t WS_WA = WS_WGB + 2 * MiB, WS_WB = WS_WA + 2 * MiB, WS_WO = WS_WB + 2 * MiB, WS_WPG = WS_WO + 2 * MiB, WS_WPP = WS_WPG + 2 * MiB,
                 WS_WC1 = 33 * MiB;
constexpr size_t WS_WFIN = 35 * MiB, WS_WFOUT = 46 * MiB;
constexpr size_t WS_KC = 35 * MiB, WS_VC = 43 * MiB;
constexpr size_t WS_HID = 52 * MiB;
constexpr size_t WS_QRAW = 52 * MiB, WS_QROT = 84 * MiB, WS_KS = 92 * MiB, WS_KW = 100 * MiB, WS_VST = 108 * MiB, WS_VWT = 116 * MiB,
                 WS_GA = 124 * MiB, WS_UB = 156 * MiB, WS_HB = 188 * MiB, WS_GV = 220 * MiB, WS_CHID = 252 * MiB;
constexpr size_t WS_XB = 140 * MiB, WS_PB = 140 * MiB, WS_PP = 148 * MiB;
constexpr size_t WS_BAR = 51 * MiB + 512 * 1024;
constexpr size_t WS_END = 256 * MiB;
static_assert(WS_WPP + 512 * 1024 <= WS_WC1 && WS_WC1 + 2 * MiB <= WS_WFIN, "weight map");

typedef __bf16 bf16x2_t __attribute__((ext_vector_type(2)));
__device__ __forceinline__ unsigned cvt_pk_bf16(float lo, float hi) { f32x2 v = {lo, hi}; bf16x2_t b = __builtin_convertvector(v, bf16x2_t); return __builtin_bit_cast(unsigned, b); }
__device__ __forceinline__ float bf2f(unsigned short b) { return __uint_as_float((unsigned)b << 16); }
__device__ __forceinline__ float bflo(unsigned w) { return __uint_as_float(w << 16); }
__device__ __forceinline__ float bfhi(unsigned w) { return __uint_as_float(w & 0xffff0000u); }
__device__ __forceinline__ float fsigmoid(float x) { return __builtin_amdgcn_rcpf(1.0f + __builtin_amdgcn_exp2f(-x * LOG2E)); }
__device__ __forceinline__ float fsilu(float x) { return x * fsigmoid(x); }
__device__ __forceinline__ float fgelu(float x) { return x * fsigmoid(1.5957691216057308f * (x + 0.044715f * x * x * x)); }
__device__ __forceinline__ u32x4 pack8(const float (&v)[8]) { u32x4 w; w.x = cvt_pk_bf16(v[0], v[1]); w.y = cvt_pk_bf16(v[2], v[3]); w.z = cvt_pk_bf16(v[4], v[5]); w.w = cvt_pk_bf16(v[6], v[7]); return w; }
__device__ __forceinline__ void unpack8(const u32x4 w, float (&v)[8]) { v[0] = bflo(w.x); v[1] = bfhi(w.x); v[2] = bflo(w.y); v[3] = bfhi(w.y); v[4] = bflo(w.z); v[5] = bfhi(w.z); v[6] = bflo(w.w); v[7] = bfhi(w.w); }
#define LDS_FENCE() asm volatile("s_waitcnt lgkmcnt(0)" ::: "memory")
__device__ __forceinline__ float quad_sum(float v) {
    v += __int_as_float(__builtin_amdgcn_update_dpp(0, __float_as_int(v), 0xB1, 0xF, 0xF, true));
    v += __int_as_float(__builtin_amdgcn_update_dpp(0, __float_as_int(v), 0x4E, 0xF, 0xF, true));
    return v;
}

namespace pg8 {
constexpr int BM = 256, BK = 64, HALF = 128, HTB = HALF * BK * 2, STAGE_BYTES = 8 * HTB, NXCD = 8, WGM = 4;
__host__ __device__ __forceinline__ int lds_byte(int r, int c) { const int st = (r >> 4) * 2 + (c >> 5), rr = r & 15, cc = c & 31, ob = rr * 64 + cc * 2; return st * 1024 + (ob ^ (((ob >> 9) & 1) << 5)); }
__host__ __device__ __forceinline__ void stage_rc(int b, int& R, int& C) { const int st = b / 1024, sb = b % 1024, swz = sb ^ (((sb >> 9) & 1) << 5); R = (st >> 1) * 16 + swz / 64; C = (st & 1) * 32 + (swz % 64) / 2; }
__host__ __device__ __forceinline__ int perm32(int rho) { const int n = rho >> 4, i = rho & 15; return 8 * (i >> 2) + 4 * n + (i & 3); }

struct Unit { int pm, pn; };
struct Gemm { const char* A; const char* Bt; int lda; int kstepA; int K; int nM, nN; int mode; };
__device__ __forceinline__ const char* abase(const Gemm& g, const Unit& u) {
    if (g.mode == 1) { const int pm = u.pm; return g.A + ((size_t)(pm >> 4) * ((size_t)T * 256) + (size_t)((pm & 15) >> 2) * 64 + (size_t)(pm & 3) * 256 * 4096) * 2; }
    return g.A + (size_t)u.pm * ((size_t)BM * g.lda * 2);
}
__device__ __forceinline__ const char* bbase(const Gemm& g, const Unit& u) {
    if (g.mode == 1) return g.Bt + (size_t)(u.pm >> 4) * ((size_t)256 * 2048 * 2);
    return g.Bt + (size_t)u.pn * ((size_t)BM * g.K * 2);
}

struct StaticOrder {
    int nM, nN, nwg, G, c;
    __device__ void init(int nM_, int nN_, int G_, int c_) { nM = nM_; nN = nN_; nwg = nM * nN; G = G_; c = c_; }
    __device__ bool next(int i, Unit& u) const {
        if (c < 0) return false;
        const long L = (long)i * G + c; if (L >= nwg) return false;
        int wgid = (int)L; { const int q = nwg / NXCD, r = nwg % NXCD, xcd = wgid % NXCD, off = wgid / NXCD; wgid = (xcd < r ? xcd * (q + 1) : r * (q + 1) + (xcd - r) * q) + off; }
        const int nig = WGM * nN, gid = wgid / nig, fm = gid * WGM, gsz = (nM - fm) < WGM ? (nM - fm) : WGM;
        u.pm = fm + ((wgid % nig) % gsz); u.pn = (wgid % nig) / gsz; return true;
    }
};

template <class Epi, class Sched, bool ALIGN_EPI = true, bool SP2 = true>
__device__ __forceinline__ void gemm_phase(LAS unsigned char* lds, const Gemm g, const Sched& S, const Epi& E) {
    const int tid = threadIdx.x, wid = __builtin_amdgcn_readfirstlane(tid >> 6), lane = tid & 63, wr = wid >> 2, wc = wid & 3, fr = lane & 15, fq = lane >> 4;
    const int K = g.K, nt = K / BK;
    unsigned voffA[2], voffB[2];
#pragma unroll
    for (int i = 0; i < 2; ++i) { int R, C; stage_rc(tid * 16 + i * 8192, R, C); const int Rb = Epi::PERM ? ((R & ~31) + perm32(R & 31)) : R;
        voffA[i] = (unsigned)(R * g.lda + C) * 2u; voffB[i] = (unsigned)(Rb * K + C) * 2u; }
    const size_t kstepA = (size_t)g.kstepA, kstepB = (size_t)(BK * 2);
    const size_t hstepA = (size_t)HALF * g.lda * 2, hstepB = (size_t)HALF * K * 2;
    const unsigned ldsw = (unsigned)wid * 1024u;
    const int aoff = lds_byte(wr * 64 + fr, fq * 8), boff = lds_byte(wc * 32 + fr, fq * 8);
#define PG8_SA(b, h) (((b) * 2 + (h)) * HTB)
#define PG8_SB(b, h) ((4 + (b) * 2 + (h)) * HTB)
#define PG8_STAGE(bufoff, gbase, voff) do { _Pragma("unroll") for (int _i = 0; _i < 2; ++_i) \
        __builtin_amdgcn_global_load_lds((const unsigned*)((const char*)(gbase) + (voff)[_i]), (LAS unsigned*)(lds + (bufoff) + ldsw + _i * 8192), 16, 0, 0); } while (0)
#define PG8_LDA(dst, b, h) do { _Pragma("unroll") for (int m = 0; m < 4; ++m) _Pragma("unroll") for (int k = 0; k < 2; ++k) dst[m][k] = *(const LAS bf16x8*)(lds + PG8_SA(b, h) + aoff + m * 2048 + k * 1024); } while (0)
#define PG8_LDB(dst, b, h) do { _Pragma("unroll") for (int n = 0; n < 2; ++n) _Pragma("unroll") for (int k = 0; k < 2; ++k) dst[n][k] = *(const LAS bf16x8*)(lds + PG8_SB(b, h) + boff + n * 2048 + k * 1024); } while (0)
#define PG8_MMA(ai, bj, At, Bt) do { __builtin_amdgcn_s_setprio(1); _Pragma("unroll") for (int m = 0; m < 4; ++m) _Pragma("unroll") for (int n = 0; n < 2; ++n) _Pragma("unroll") for (int k = 0; k < 2; ++k) \
        acc[ai][bj][m][n] = __builtin_amdgcn_mfma_f32_16x16x32_bf16(Bt[n][k], At[m][k], acc[ai][bj][m][n], 0, 0, 0); __builtin_amdgcn_s_setprio(0); } while (0)
#define PG8_WAIT_V(n) asm volatile("s_waitcnt vmcnt(" #n ")" ::: "memory")
#define PG8_WAIT_L(n) asm volatile("s_waitcnt lgkmcnt(" #n ")" ::: "memory")
#define PG8_BAR __builtin_amdgcn_s_barrier()
#define PG8_SCHED __builtin_amdgcn_sched_barrier(0)
    Unit cur, nxt; int ui = 0;
    if (!S.next(0, cur)) return;
    f32x4 acc[2][2][4][2];
#pragma unroll
    for (int a = 0; a < 2; ++a)
#pragma unroll
        for (int b = 0; b < 2; ++b)
#pragma unroll
            for (int m = 0; m < 4; ++m)
#pragma unroll
                for (int n = 0; n < 2; ++n) acc[a][b][m][n] = (f32x4){0.f, 0.f, 0.f, 0.f};
    bf16x8 At[4][2], B0[2][2], B1[2][2];
    const char* cA = abase(g, cur); const char* cB = bbase(g, cur);
    if constexpr (SP2) {
        PG8_STAGE(PG8_SB(0, 0), cB, voffB); PG8_STAGE(PG8_SB(0, 1), cB + hstepB, voffB); PG8_STAGE(PG8_SA(0, 0), cA, voffA); PG8_STAGE(PG8_SA(0, 1), cA + hstepA, voffA);
        if (wr == 1) PG8_BAR;
        PG8_WAIT_V(2); PG8_BAR;
        PG8_STAGE(PG8_SB(1, 0), cB + kstepB, voffB); PG8_STAGE(PG8_SA(1, 0), cA + kstepA, voffA); PG8_STAGE(PG8_SB(1, 1), cB + hstepB + kstepB, voffB);
        PG8_WAIT_V(6); PG8_BAR;
    } else {
        PG8_STAGE(PG8_SB(0, 0), cB, voffB); PG8_STAGE(PG8_SA(0, 0), cA, voffA); PG8_STAGE(PG8_SB(0, 1), cB + hstepB, voffB); PG8_STAGE(PG8_SA(0, 1), cA + hstepA, voffA);
        if (wr == 1) PG8_BAR;
        PG8_WAIT_V(4); PG8_BAR;
        PG8_STAGE(PG8_SB(1, 0), cB + kstepB, voffB); PG8_STAGE(PG8_SA(1, 0), cA + kstepA, voffA); PG8_STAGE(PG8_SB(1, 1), cB + hstepB + kstepB, voffB);
        PG8_WAIT_V(6); PG8_BAR;
    }
    for (;;) {
        const bool has_next = S.next(ui + 1, nxt);
        const char* nA = has_next ? abase(g, nxt) : cA; const char* nB = has_next ? bbase(g, nxt) : cB;
        for (int t = 0; t < nt; t += 2) {
            const bool last = (t == nt - 2);
            const char* a1 = cA + (size_t)(t + 1) * kstepA;
            const char* a2 = last ? nA : cA + (size_t)(t + 2) * kstepA; const char* b2 = last ? nB : cB + (size_t)(t + 2) * kstepB;
            const char* a3 = a2 + kstepA; const char* b3 = b2 + kstepB;
            if constexpr (SP2) {
            PG8_LDB(B0, 0, 0); PG8_LDB(B1, 0, 1); PG8_SCHED; PG8_LDA(At, 0, 0); PG8_STAGE(PG8_SA(1, 1), a1 + hstepA, voffA);
            PG8_WAIT_V(8); PG8_WAIT_L(0); PG8_BAR; PG8_MMA(0, 0, At, B0); PG8_MMA(0, 1, At, B1); PG8_BAR; PG8_SCHED;
            PG8_LDA(At, 0, 1); PG8_STAGE(PG8_SB(0, 0), b2, voffB); PG8_STAGE(PG8_SB(0, 1), b2 + hstepB, voffB); PG8_STAGE(PG8_SA(0, 0), a2, voffA);
            PG8_WAIT_V(8); PG8_WAIT_L(0); PG8_BAR; PG8_MMA(1, 0, At, B0); PG8_MMA(1, 1, At, B1); PG8_BAR; PG8_SCHED;
            PG8_LDB(B0, 1, 0); PG8_LDB(B1, 1, 1); PG8_SCHED; PG8_LDA(At, 1, 0); PG8_STAGE(PG8_SA(0, 1), a2 + hstepA, voffA);
            PG8_WAIT_V(8); PG8_WAIT_L(0); PG8_BAR; PG8_MMA(0, 0, At, B0); PG8_MMA(0, 1, At, B1); PG8_BAR; PG8_SCHED;
            PG8_LDA(At, 1, 1); PG8_STAGE(PG8_SB(1, 0), b3, voffB); PG8_STAGE(PG8_SB(1, 1), b3 + hstepB, voffB); PG8_STAGE(PG8_SA(1, 0), a3, voffA);
            PG8_WAIT_V(8); PG8_WAIT_L(0); PG8_BAR; PG8_MMA(1, 0, At, B0); PG8_MMA(1, 1, At, B1); PG8_BAR; PG8_SCHED;
            } else {
            PG8_LDB(B0, 0, 0); PG8_SCHED; PG8_LDA(At, 0, 0); PG8_STAGE(PG8_SA(1, 1), a1 + hstepA, voffA);
            PG8_WAIT_L(8); PG8_BAR; PG8_WAIT_L(0); PG8_MMA(0, 0, At, B0); PG8_BAR; PG8_SCHED;
            PG8_LDB(B1, 0, 1); PG8_STAGE(PG8_SB(0, 0), b2, voffB);
            PG8_BAR; PG8_WAIT_L(0); PG8_MMA(0, 1, At, B1); PG8_BAR;
            PG8_LDA(At, 0, 1); PG8_STAGE(PG8_SA(0, 0), a2, voffA);
            PG8_BAR; PG8_WAIT_L(0); PG8_MMA(1, 0, At, B0); PG8_BAR; PG8_SCHED;
            PG8_STAGE(PG8_SB(0, 1), b2 + hstepB, voffB);
            PG8_WAIT_V(6); PG8_BAR; PG8_MMA(1, 1, At, B1); PG8_BAR;
            PG8_LDB(B0, 1, 0); PG8_SCHED; PG8_LDA(At, 1, 0); PG8_STAGE(PG8_SA(0, 1), a2 + hstepA, voffA);
            PG8_WAIT_L(8); PG8_BAR; PG8_WAIT_L(0); PG8_MMA(0, 0, At, B0); PG8_BAR; PG8_SCHED;
            PG8_LDB(B1, 1, 1); PG8_STAGE(PG8_SB(1, 0), b3, voffB);
            PG8_BAR; PG8_WAIT_L(0); PG8_MMA(0, 1, At, B1); PG8_BAR;
            PG8_LDA(At, 1, 1); PG8_STAGE(PG8_SA(1, 0), a3, voffA);
            PG8_BAR; PG8_WAIT_L(0); PG8_MMA(1, 0, At, B0); PG8_BAR; PG8_SCHED;
            PG8_STAGE(PG8_SB(1, 1), b3 + hstepB, voffB);
            PG8_WAIT_V(6); PG8_BAR; PG8_MMA(1, 1, At, B1); PG8_BAR;
            }
        }
        if constexpr (ALIGN_EPI) { if (wr == 0) PG8_BAR; }
        if constexpr (!Epi::AFTER_DRAIN) E(acc, cur, wr, wc, fr, fq);
        if (!has_next) break;
#pragma unroll
        for (int a = 0; a < 2; ++a)
#pragma unroll
            for (int b = 0; b < 2; ++b)
#pragma unroll
                for (int m = 0; m < 4; ++m)
#pragma unroll
                    for (int n = 0; n < 2; ++n) acc[a][b][m][n] = (f32x4){0.f, 0.f, 0.f, 0.f};
        cur = nxt; cA = nA; cB = nB; ++ui;
        if constexpr (ALIGN_EPI) { if (wr == 1) PG8_BAR; }
    }
    PG8_WAIT_V(0);
    if constexpr (!ALIGN_EPI) { if (wr == 0) PG8_BAR; }
    PG8_BAR;
    if constexpr (Epi::AFTER_DRAIN) E.fused(acc, cur, wr, wc, fr, fq, lds, wid, lane);
#undef PG8_SA
#undef PG8_SB
#undef PG8_STAGE
#undef PG8_LDA
#undef PG8_LDB
#undef PG8_MMA
#undef PG8_WAIT_V
#undef PG8_WAIT_L
#undef PG8_BAR
#undef PG8_SCHED
}

typedef f32x4 Acc[2][2][4][2];
__device__ __forceinline__ void load_rs(const float* ssp, int row0, int fq, float (&rs)[2][4]) {
#pragma unroll
    for (int ai = 0; ai < 2; ++ai)
#pragma unroll
        for (int m = 0; m < 4; ++m) { const f32x4* pp = (const f32x4*)(ssp + (size_t)(row0 + 128 * ai + 16 * m) * 16); const f32x4 p0 = pp[0], p1 = pp[1], p2 = pp[2], p3 = pp[3];
            const float s = (((p0.x + p0.y) + (p0.z + p0.w)) + ((p1.x + p1.y) + (p1.z + p1.w))) + (((p2.x + p2.y) + (p2.z + p2.w)) + ((p3.x + p3.y) + (p3.z + p3.w)));
            rs[ai][m] = rsqrtf(s * (1.0f / 1024.0f) + EPS); asm volatile("" : "+v"(rs[ai][m]) :: "memory"); }
}
#define ACC8(v, ai, bj, m, sc) do { const f32x4 a0_ = acc[ai][bj][m][0], a1_ = acc[ai][bj][m][1]; v[0] = a0_[0] * (sc); v[1] = a0_[1] * (sc); v[2] = a0_[2] * (sc); v[3] = a0_[3] * (sc); \
        v[4] = a1_[0] * (sc); v[5] = a1_[1] * (sc); v[6] = a1_[2] * (sc); v[7] = a1_[3] * (sc); } while (0)

struct EpiSwiGLU { static constexpr bool PERM = true, AFTER_DRAIN = false; const float* ssp; bf16_t* hid;
    __device__ __forceinline__ void operator()(const Acc& acc, const Unit& u, int wr, int wc, int fr, int fq) const {
        const int row0 = u.pm * 256 + wr * 64 + fr; float rs[2][4]; load_rs(ssp, row0, fq, rs);
#pragma unroll
        for (int ai = 0; ai < 2; ++ai)
#pragma unroll
            for (int m = 0; m < 4; ++m) { float gt[8], up[8], o[8]; ACC8(gt, ai, 0, m, rs[ai][m]); ACC8(up, ai, 1, m, rs[ai][m]);
#pragma unroll
                for (int j = 0; j < 8; ++j) o[j] = fsilu(gt[j]) * up[j];
                *(u32x4*)(hid + (size_t)(row0 + 128 * ai + 16 * m) * FF + u.pn * 128 + wc * 32 + fq * 8) = pack8(o); }
    }
};
struct EpiResid { static constexpr bool PERM = true, AFTER_DRAIN = false; const float* basef; float coef; bf16_t* hb; float* ssp;
    __device__ __forceinline__ void operator()(const Acc& acc, const Unit& u, int wr, int wc, int fr, int fq) const {
        const int row0 = u.pm * 256 + wr * 64 + fr;
#pragma unroll
        for (int ai = 0; ai < 2; ++ai)
#pragma unroll
            for (int m = 0; m < 4; ++m) { const int row = row0 + 128 * ai + 16 * m; float ss = 0.f;
#pragma unroll
                for (int bj = 0; bj < 2; ++bj) { const size_t off = (size_t)row * DM + u.pn * 256 + bj * 128 + wc * 32 + fq * 8; float v[8], bb[8]; ACC8(v, ai, bj, m, coef);
                    if (basef) { const f32x4 b0 = *(const f32x4*)(basef + off), b1 = *(const f32x4*)(basef + off + 4);
                        bb[0] = b0[0]; bb[1] = b0[1]; bb[2] = b0[2]; bb[3] = b0[3]; bb[4] = b1[0]; bb[5] = b1[1]; bb[6] = b1[2]; bb[7] = b1[3]; }
                    else unpack8(*(const u32x4*)(hb + off), bb);
#pragma unroll
                    for (int j = 0; j < 8; ++j) { v[j] += bb[j]; ss += v[j] * v[j]; }
                    *(u32x4*)(hb + off) = pack8(v); }
                ss += __shfl_xor(ss, 16); ss += __shfl_xor(ss, 32);
                if (fq == 0) ssp[(size_t)row * 16 + u.pn * 4 + wc] = ss; }
    }
};
struct EpiPle { static constexpr bool PERM = true, AFTER_DRAIN = false; const float* ssp_in; const bf16_t* pp; const bf16_t* hb; float* out; float* ssp;
    __device__ __forceinline__ void operator()(const Acc& acc, const Unit& u, int wr, int wc, int fr, int fq) const {
        const int row0 = u.pm * 256 + wr * 64 + fr; float rs[2][4]; load_rs(ssp_in, row0, fq, rs);
#pragma unroll
        for (int ai = 0; ai < 2; ++ai)
#pragma unroll
            for (int m = 0; m < 4; ++m) { const int row = row0 + 128 * ai + 16 * m; float ss = 0.f;
#pragma unroll
                for (int bj = 0; bj < 2; ++bj) { const size_t off = (size_t)row * DM + u.pn * 256 + bj * 128 + wc * 32 + fq * 8; float v[8], pv[8], bb[8]; ACC8(v, ai, bj, m, rs[ai][m]);
                    unpack8(*(const u32x4*)(pp + off), pv); unpack8(*(const u32x4*)(hb + off), bb);
#pragma unroll
                    for (int j = 0; j < 8; ++j) { v[j] = bb[j] + fsigmoid(v[j]) * pv[j]; ss += v[j] * v[j]; }
                    *(f32x4*)(out + off) = (f32x4){v[0], v[1], v[2], v[3]}; *(f32x4*)(out + off + 4) = (f32x4){v[4], v[5], v[6], v[7]}; }
                ss += __shfl_xor(ss, 16); ss += __shfl_xor(ss, 32);
                if (fq == 0) ssp[(size_t)row * 16 + u.pn * 4 + wc] = ss; }
    }
};
struct EpiPleFinal { static constexpr bool PERM = true, AFTER_DRAIN = true; const float* ssp_in; const bf16_t* pp; const bf16_t* hb; float* out; const float* fnorm; unsigned* xbuf; unsigned* cnt;
    __device__ __forceinline__ void operator()(const Acc&, const Unit&, int, int, int, int) const {}
    __device__ __forceinline__ void fused(Acc& acc, const Unit& u, int wr, int wc, int fr, int fq, LAS unsigned char* lds, int wid, int lane) const {
        const int row0 = u.pm * 256 + wr * 64 + fr; float rs[2][4]; load_rs(ssp_in, row0, fq, rs);
        LAS float* P = (LAS float*)lds;
        LAS float* Sr = (LAS float*)(lds + 4096);
        LAS unsigned* flag = (LAS unsigned*)(lds + 4096 + 1024);
#pragma unroll
        for (int ai = 0; ai < 2; ++ai)
#pragma unroll
            for (int m = 0; m < 4; ++m) { const int row = row0 + 128 * ai + 16 * m; float ss = 0.f;
#pragma unroll
                for (int bj = 0; bj < 2; ++bj) { const size_t off = (size_t)row * DM + u.pn * 256 + bj * 128 + wc * 32 + fq * 8; float v[8], pv[8], bb[8]; ACC8(v, ai, bj, m, rs[ai][m]);
                    unpack8(*(const u32x4*)(pp + off), pv); unpack8(*(const u32x4*)(hb + off), bb);
#pragma unroll
                    for (int j = 0; j < 8; ++j) { v[j] = bb[j] + fsigmoid(v[j]) * pv[j]; ss += v[j] * v[j]; }
                    acc[ai][bj][m][0] = (f32x4){v[0], v[1], v[2], v[3]}; acc[ai][bj][m][1] = (f32x4){v[4], v[5], v[6], v[7]}; }
                ss += __shfl_xor(ss, 16); ss += __shfl_xor(ss, 32);
                if (fq == 0) P[(128 * ai + 64 * wr + 16 * m + fr) * 4 + wc] = ss; }
        __syncthreads();
        const int tid = wid * 64 + lane;
        if (tid < 256) { const float sum = (P[tid * 4 + 0] + P[tid * 4 + 1]) + (P[tid * 4 + 2] + P[tid * 4 + 3]);
            __hip_atomic_store(xbuf + ((size_t)u.pm * 256 + tid) * 4 + u.pn, __float_as_uint(sum), __ATOMIC_RELAXED, __HIP_MEMORY_SCOPE_AGENT); }
        asm volatile("s_waitcnt vmcnt(0)" ::: "memory");
        if (lane == 0) __hip_atomic_fetch_add(cnt + 64 * u.pm, 1u, __ATOMIC_RELAXED, __HIP_MEMORY_SCOPE_AGENT);
        if (wid == 0) { unsigned sp = 0;
            while ((unsigned)__builtin_amdgcn_readfirstlane(__hip_atomic_load(cnt + 64 * u.pm, __ATOMIC_RELAXED, __HIP_MEMORY_SCOPE_AGENT)) < 32u) { __builtin_amdgcn_s_sleep(2); if (++sp > (1u << 22)) break; }
            __builtin_amdgcn_fence(__ATOMIC_ACQUIRE, "agent");
            if (lane == 0) flag[0] = 1u; }
        asm volatile("s_waitcnt vmcnt(0) lgkmcnt(0)" ::: "memory");
        __syncthreads();
        if (tid < 256) { const unsigned* slot = xbuf + ((size_t)u.pm * 256 + tid) * 4; float s = 0.f;
#pragma unroll
            for (int t = 0; t < 4; ++t) s += __uint_as_float(__hip_atomic_load(slot + t, __ATOMIC_RELAXED, __HIP_MEMORY_SCOPE_AGENT));
            Sr[tid] = rsqrtf(s * (1.0f / 1024.0f) + EPS); }
        __syncthreads();
#pragma unroll
        for (int ai = 0; ai < 2; ++ai)
#pragma unroll
            for (int m = 0; m < 4; ++m) { const int lrow = 128 * ai + 64 * wr + 16 * m + fr; const float r = Sr[lrow];
#pragma unroll
                for (int bj = 0; bj < 2; ++bj) { const int col = u.pn * 256 + bj * 128 + wc * 32 + fq * 8; const size_t off = (size_t)(u.pm * 256 + lrow) * DM + col;
                    const f32x4 g0 = *(const f32x4*)(fnorm + col), g1 = *(const f32x4*)(fnorm + col + 4); const f32x4 a0 = acc[ai][bj][m][0], a1 = acc[ai][bj][m][1];
                    *(f32x4*)(out + off) = (f32x4){a0[0] * r * g0[0], a0[1] * r * g0[1], a0[2] * r * g0[2], a0[3] * r * g0[3]};
                    *(f32x4*)(out + off + 4) = (f32x4){a1[0] * r * g1[0], a1[1] * r * g1[1], a1[2] * r * g1[2], a1[3] * r * g1[3]}; } }
    }
};
template <int MODE> struct EpiBf16 { static constexpr bool PERM = true, AFTER_DRAIN = false; bf16_t* O; const float* ssp; const bf16_t* mul; const bf16_t* add;
    __device__ __forceinline__ void operator()(const Acc& acc, const Unit& u, int wr, int wc, int fr, int fq) const {
        const int row0 = u.pm * 256 + wr * 64 + fr; float rs[2][4];
        if (MODE == 1 || MODE == 4) load_rs(ssp, row0, fq, rs);
#pragma unroll
        for (int ai = 0; ai < 2; ++ai)
#pragma unroll
            for (int m = 0; m < 4; ++m)
#pragma unroll
                for (int bj = 0; bj < 2; ++bj) { const size_t off = (size_t)(row0 + 128 * ai + 16 * m) * DM + u.pn * 256 + bj * 128 + wc * 32 + fq * 8; float v[8];
                    ACC8(v, ai, bj, m, (MODE == 1 ? rs[ai][m] : 1.0f));
                    if (MODE == 1) {
#pragma unroll
                        for (int j = 0; j < 8; ++j) v[j] = fsigmoid(v[j]); }
                    if (MODE == 2 || MODE == 3) { float mv[8]; unpack8(*(const u32x4*)(mul + off), mv);
#pragma unroll
                        for (int j = 0; j < 8; ++j) v[j] *= mv[j]; }
                    if (MODE == 4) { float mv[8]; unpack8(*(const u32x4*)(mul + off), mv);
#pragma unroll
                        for (int j = 0; j < 8; ++j) v[j] *= fsigmoid(mv[j] * rs[ai][m]); }
                    if (MODE == 3 || MODE == 4) { float av[8]; unpack8(*(const u32x4*)(add + off), av);
#pragma unroll
                        for (int j = 0; j < 8; ++j) v[j] += av[j]; }
                    *(u32x4*)(O + off) = pack8(v); }
    }
};
struct EpiCmp1 { static constexpr bool PERM = true, AFTER_DRAIN = false; bf16_t* chid; const float* bias;
    __device__ __forceinline__ void operator()(const Acc& acc, const Unit& u, int wr, int wc, int fr, int fq) const {
        const int row0 = u.pm * 256 + wr * 64 + fr; const float* bs = bias + (u.pm >> 4) * 256;
#pragma unroll
        for (int bj = 0; bj < 2; ++bj) { const int col = bj * 128 + wc * 32 + fq * 8; const f32x4 b0 = *(const f32x4*)(bs + col), b1 = *(const f32x4*)(bs + col + 4);
            const float bb[8] = {b0[0], b0[1], b0[2], b0[3], b1[0], b1[1], b1[2], b1[3]};
#pragma unroll
            for (int ai = 0; ai < 2; ++ai)
#pragma unroll
                for (int m = 0; m < 4; ++m) { float v[8]; ACC8(v, ai, bj, m, 1.0f);
#pragma unroll
                    for (int j = 0; j < 8; ++j) v[j] = fgelu(v[j] + bb[j]);
                    *(u32x4*)(chid + (size_t)(row0 + 128 * ai + 16 * m) * 256 + col) = pack8(v); } }
    }
};
__device__ __forceinline__ void rope8(float (&v)[8], int fq, const float* cs) {
    const f32x4 c0 = *(const f32x4*)(cs), c1 = *(const f32x4*)(cs + 4), c2 = *(const f32x4*)(cs + 8), c3 = *(const f32x4*)(cs + 12);
    const float cc[8] = {c0[0], c0[2], c1[0], c1[2], c2[0], c2[2], c3[0], c3[2]}, sn[8] = {c0[1], c0[3], c1[1], c1[3], c2[1], c2[3], c3[1], c3[3]};
#pragma unroll
    for (int j = 0; j < 8; ++j) { const float other = __shfl_xor(v[j], 16); v[j] = (fq == 0) ? (v[j] * cc[j] - other * sn[j]) : (v[j] * cc[j] + other * sn[j]); }
}
struct EpiProj { static constexpr bool PERM = true, AFTER_DRAIN = false;
    const float* ssp; const float* rope; bf16_t *ub, *gv, *qraw, *qrot, *kc, *vc, *ks, *kw, *vst, *vwt, *ga; float* vstat; float* gate;
    __device__ __forceinline__ void operator()(const Acc& acc, const Unit& u, int wr, int wc, int fr, int fq) const {
        const int row0 = u.pm * 256 + wr * 64 + fr; float rs[2][4]; load_rs(ssp, row0, fq, rs);
        const int pn = u.pn;
        if (pn < 4) {
#pragma unroll
            for (int ai = 0; ai < 2; ++ai)
#pragma unroll
                for (int m = 0; m < 4; ++m)
#pragma unroll
                    for (int bj = 0; bj < 2; ++bj) { float v[8]; ACC8(v, ai, bj, m, rs[ai][m]);
#pragma unroll
                        for (int j = 0; j < 8; ++j) v[j] = fgelu(v[j]);
                        *(u32x4*)(ub + (size_t)(row0 + 128 * ai + 16 * m) * DM + pn * 256 + bj * 128 + wc * 32 + fq * 8) = pack8(v); }
        } else if (pn >= 18 && pn < 22) {
#pragma unroll
            for (int ai = 0; ai < 2; ++ai)
#pragma unroll
                for (int m = 0; m < 4; ++m)
#pragma unroll
                    for (int bj = 0; bj < 2; ++bj) { float v[8]; ACC8(v, ai, bj, m, rs[ai][m]);
#pragma unroll
                        for (int j = 0; j < 8; ++j) v[j] = fsigmoid(v[j]);
                        *(u32x4*)(ga + (size_t)(row0 + 128 * ai + 16 * m) * DM + (pn - 18) * 256 + bj * 128 + wc * 32 + fq * 8) = pack8(v); }
        } else if (pn < 8) {
#pragma unroll
            for (int ai = 0; ai < 2; ++ai)
#pragma unroll
                for (int m = 0; m < 4; ++m) { const int row = row0 + 128 * ai + 16 * m; float s1 = 0.f, s2 = 0.f;
#pragma unroll
                    for (int bj = 0; bj < 2; ++bj) { float v[8]; ACC8(v, ai, bj, m, rs[ai][m]);
#pragma unroll
                        for (int j = 0; j < 8; ++j) { v[j] = fgelu(v[j]); s1 += v[j]; s2 += v[j] * v[j]; }
                        *(u32x4*)(gv + (size_t)row * DM + (pn - 4) * 256 + bj * 128 + wc * 32 + fq * 8) = pack8(v); }
                    s1 += __shfl_xor(s1, 16); s1 += __shfl_xor(s1, 32); s2 += __shfl_xor(s2, 16); s2 += __shfl_xor(s2, 32);
                    if (fq == 0) *(f32x2*)(vstat + ((size_t)row * 16 + (pn - 4) * 4 + wc) * 2) = (f32x2){s1, s2}; }
        } else if (pn < 12) {
#pragma unroll
            for (int ai = 0; ai < 2; ++ai)
#pragma unroll
                for (int m = 0; m < 4; ++m) { const int row = row0 + 128 * ai + 16 * m;
#pragma unroll
                    for (int bj = 0; bj < 2; ++bj) { float v[8]; ACC8(v, ai, bj, m, rs[ai][m] * QSCALE);
                        *(u32x4*)(qraw + (size_t)row * DM + (pn - 8) * 256 + bj * 128 + wc * 32 + fq * 8) = pack8(v);
                        if ((wc & 1) == 0) { rope8(v, fq, rope + (size_t)(row & (SEQ - 1)) * 16);
                            const int head = (pn - 8) * 4 + bj * 2 + (wc >> 1);
                            if (fq < 2) *(u32x4*)(qrot + ((size_t)row * 16 + head) * 16 + fq * 8) = pack8(v); } } }
        } else if (pn == 12 || pn == 13 || pn == 14 || pn == 16) {
            bf16_t* O = pn == 12 ? kc : pn == 13 ? vc : pn == 14 ? ks : kw; const bool rot = pn >= 14;
#pragma unroll
            for (int ai = 0; ai < 2; ++ai)
#pragma unroll
                for (int m = 0; m < 4; ++m) { const int row = row0 + 128 * ai + 16 * m;
#pragma unroll
                    for (int bj = 0; bj < 2; ++bj) { float v[8]; ACC8(v, ai, bj, m, rs[ai][m]);
                        if (rot && (wc & 1) == 0) { float w[8];
#pragma unroll
                            for (int j = 0; j < 8; ++j) w[j] = v[j];
                            rope8(w, fq, rope + (size_t)(row & (SEQ - 1)) * 16);
                            if (fq < 2) {
#pragma unroll
                                for (int j = 0; j < 8; ++j) v[j] = w[j]; } }
                        *(u32x4*)(O + (size_t)row * 256 + bj * 128 + wc * 32 + fq * 8) = pack8(v); } }
        } else if (pn == 15 || pn == 17) {
            bf16_t* O = pn == 15 ? vst : vwt;
#pragma unroll
            for (int ai = 0; ai < 2; ++ai)
#pragma unroll
                for (int m = 0; m < 4; ++m) { const int row = row0 + 128 * ai + 16 * m; const int b = row >> 12, t = row & (SEQ - 1);
#pragma unroll
                    for (int bj = 0; bj < 2; ++bj) { float v[8]; ACC8(v, ai, bj, m, rs[ai][m]); const int kvh = bj * 2 + (wc >> 1), d0 = (wc & 1) * 32 + fq * 8;
                        bf16_t* p = O + ((size_t)(b * 4 + kvh) * 64 + d0) * SEQ + t;
#pragma unroll
                        for (int j = 0; j < 8; j += 2) { const unsigned w = cvt_pk_bf16(v[j], v[j + 1]); p[(size_t)j * SEQ] = (bf16_t)(w & 0xffffu); p[(size_t)(j + 1) * SEQ] = (bf16_t)(w >> 16); } } }
        } else {
            if (wc < 2) {
#pragma unroll
                for (int ai = 0; ai < 2; ++ai)
#pragma unroll
                    for (int m = 0; m < 4; ++m) { const int row = row0 + 128 * ai + 16 * m; float v[8]; ACC8(v, ai, 0, m, rs[ai][m]); const int col = wc * 32 + fq * 8;
                        if (col < 48) {
#pragma unroll
                            for (int j = 0; j < 8; ++j) v[j] = fsigmoid(v[j]);
                            *(f32x4*)(gate + (size_t)row * 48 + col) = (f32x4){v[0], v[1], v[2], v[3]}; *(f32x4*)(gate + (size_t)row * 48 + col + 4) = (f32x4){v[4], v[5], v[6], v[7]}; } }
            }
        }
    }
};
}

struct Ctx { LAS unsigned char* lds; int tid, lane, wave, G, bid; };

__device__ __forceinline__ float wave_sum(float v) {
#pragma unroll
    for (int o = 1; o < 64; o <<= 1) v += __shfl_xor(v, o);
    return v;
}
__device__ __forceinline__ int map_row(int map, int n) {
    if (map == 1) { const int up = n >= FF ? 1 : 0, j = n - up * FF; return (j >> 7) * 256 + up * 128 + (j & 127); }
    if (map == 2) { if (n < 4608) return n; if (n < 4656) return 5632 + (n - 4608); if (n < 5680) return 4608 + (n - 4656); return N3 + (n - 5680); }
    return n;
}
constexpr int TR_SCR = 17408;
__device__ __forceinline__ void transpose_item(const float* W, int K, int N, bf16_t* WT, const float* ks, int map, LAS float* scr, int item, int lane) {
    const int nblk = (N + 63) / 64, kb = item / nblk, nb = item % nblk, k0 = 64 * kb, n0 = 64 * nb;
    const int n4 = (lane & 15) * 4, r0 = lane >> 4;
    f32x4 v[16];
#pragma unroll
    for (int i = 0; i < 16; ++i) { const int kk = r0 + 4 * i; v[i] = (f32x4){0.f, 0.f, 0.f, 0.f}; if (n0 + n4 < N) v[i] = *(const f32x4*)(W + (size_t)(k0 + kk) * N + n0 + n4); }
#pragma unroll
    for (int i = 0; i < 16; ++i) { const int kk = r0 + 4 * i; const float sc = ks ? ks[k0 + kk] : 1.0f; LAS float* d = scr + kk * 65 + n4;
        d[0] = v[i].x * sc; d[1] = v[i].y * sc; d[2] = v[i].z * sc; d[3] = v[i].w * sc; }
    LDS_FENCE();
    const int c = lane >> 3, nl = lane & 7;
#pragma unroll
    for (int j = 0; j < 8; ++j) { const int nn = nl + 8 * j, n = n0 + nn;
        if (n < N) { const LAS float* s0 = scr + (8 * c) * 65 + nn;
            u32x4 o; o.x = cvt_pk_bf16(s0[0 * 65], s0[1 * 65]); o.y = cvt_pk_bf16(s0[2 * 65], s0[3 * 65]); o.z = cvt_pk_bf16(s0[4 * 65], s0[5 * 65]); o.w = cvt_pk_bf16(s0[6 * 65], s0[7 * 65]);
            *(u32x4*)(WT + (size_t)map_row(map, n) * K + k0 + 8 * c) = o; } }
    LDS_FENCE();
}
struct TJob { const float* W; int K, N; bf16_t* dst; const float* ks; int map; };
__device__ __forceinline__ int tjob_items(const TJob& j) { return (j.K / 64) * ((j.N + 63) / 64); }

struct Args {
    const float* in[27]; float* out; unsigned char* ws; int ph_lo, ph_hi;
};
enum { I_X = 0, I_P, I_F1N, I_F1WI, I_F1WO, I_MIXN, I_WIN, I_LNG, I_LNB, I_GWS, I_GBS, I_WA, I_CPK, I_CKW1, I_CKW2, I_CPV, I_CVW1, I_CVW2, I_WB, I_WO,
       I_F2N, I_F2WI, I_F2WO, I_PLEN, I_PLEG, I_PLEP, I_FIN };

__device__ __forceinline__ void run_tjobs(const Ctx& C, const TJob* jobs, int njobs) {
    LAS float* scr = (LAS float*)(C.lds + C.wave * TR_SCR);
    const int gw = C.bid * 8 + C.wave, NGW = C.G * 8;
    int total = 0;
    for (int j = 0; j < njobs; ++j) total += tjob_items(jobs[j]);
    for (int it = gw; it < total; it += NGW) { int r = it;
        for (int j = 0; j < njobs; ++j) { const int n = tjob_items(jobs[j]); if (r < n) { transpose_item(jobs[j].W, jobs[j].K, jobs[j].N, jobs[j].dst, jobs[j].ks, jobs[j].map, scr, r, C.lane); break; } r -= n; } }
}

__device__ __forceinline__ void p0_prologue(const Ctx& C, const Args& a) {
    unsigned char* ws = a.ws;
    {
        const int gw = C.bid * 8 + C.wave, NGW = C.G * 8;
        LAS float* scr = (LAS float*)(C.lds + C.wave * TR_SCR);
        for (int it = gw; it < 5136; it += NGW) { int r = it;
            if (r < 1408) { transpose_item(a.in[I_F1WI], 1024, 5632, (bf16_t*)(ws + WS_WFIN), a.in[I_F1N], 1, scr, r, C.lane); continue; } r -= 1408;
            if (r < 704) { transpose_item(a.in[I_F1WO], 2816, 1024, (bf16_t*)(ws + WS_WFOUT), nullptr, 0, scr, r, C.lane); continue; } r -= 704;
            if (r < 1680) { transpose_item(a.in[I_WIN], 1024, 6704, (bf16_t*)(ws + WS_WIN), a.in[I_MIXN], 2, scr, r, C.lane); continue; } r -= 1680;
            if (r < 256) { transpose_item(a.in[I_WA], 1024, 1024, (bf16_t*)(ws + WS_WA), nullptr, 0, scr, r, C.lane); continue; } r -= 256;
            if (r < 256) { transpose_item(a.in[I_WB], 1024, 1024, (bf16_t*)(ws + WS_WB), nullptr, 0, scr, r, C.lane); continue; } r -= 256;
            if (r < 256) { transpose_item(a.in[I_WO], 1024, 1024, (bf16_t*)(ws + WS_WO), nullptr, 0, scr, r, C.lane); continue; } r -= 256;
            if (r < 256) { transpose_item(a.in[I_PLEG], 1024, 1024, (bf16_t*)(ws + WS_WPG), a.in[I_PLEN], 0, scr, r, C.lane); continue; } r -= 256;
            if (r < 64) { transpose_item(a.in[I_PLEP], 256, 1024, (bf16_t*)(ws + WS_WPP), nullptr, 0, scr, r, C.lane); continue; } r -= 64;
            if (r < 128) { transpose_item(a.in[I_CKW1], 2048, 256, (bf16_t*)(ws + WS_WC1), nullptr, 0, scr, r, C.lane); continue; } r -= 128;
            transpose_item(a.in[I_CVW1], 2048, 256, (bf16_t*)(ws + WS_WC1) + 256 * 2048, nullptr, 0, scr, r, C.lane);
        }
        const float* x = a.in[I_X]; bf16_t* xb = (bf16_t*)(ws + WS_XB); float* ssa = (float*)(ws + WS_SSA);
        for (int r = gw; r < T; r += NGW) { const f32x4* xr = (const f32x4*)(x + (size_t)r * DM) + C.lane; float s = 0.f; f32x4 v[4];
#pragma unroll
            for (int j = 0; j < 4; ++j) { v[j] = xr[64 * j]; s += (v[j].x * v[j].x + v[j].y * v[j].y) + (v[j].z * v[j].z + v[j].w * v[j].w); }
            s = wave_sum(s);
            u32x2* o = (u32x2*)(xb + (size_t)r * DM) + C.lane;
#pragma unroll
            for (int j = 0; j < 4; ++j) o[64 * j] = (u32x2){cvt_pk_bf16(v[j].x, v[j].y), cvt_pk_bf16(v[j].z, v[j].w)};
            if (C.lane < 16) ssa[(size_t)r * 16 + C.lane] = C.lane == 0 ? s : 0.f; }
        float* cb = (float*)(ws + WS_CBIAS);
        for (int it = gw; it < 64; it += NGW) { const int tsr = it >> 5, n0 = (it & 31) * 8; const float* pos = a.in[tsr ? I_CPV : I_CPK]; const float* w1 = a.in[tsr ? I_CVW1 : I_CKW1];
            float acc8[8] = {0.f, 0.f, 0.f, 0.f, 0.f, 0.f, 0.f, 0.f};
            for (int i = 0; i < 32; ++i) { const int k = C.lane + 64 * i; const float pk = pos[k]; const f32x4 w0 = *(const f32x4*)(w1 + (size_t)k * 256 + n0), w4 = *(const f32x4*)(w1 + (size_t)k * 256 + n0 + 4);
                acc8[0] += pk * w0[0]; acc8[1] += pk * w0[1]; acc8[2] += pk * w0[2]; acc8[3] += pk * w0[3]; acc8[4] += pk * w4[0]; acc8[5] += pk * w4[1]; acc8[6] += pk * w4[2]; acc8[7] += pk * w4[3]; }
#pragma unroll
            for (int j = 0; j < 8; ++j) { const float s = wave_sum(acc8[j]); if (C.lane == 0) cb[tsr * 256 + n0 + j] = s; } }
    }
    const int gt = C.bid * 512 + C.tid, NGT = C.G * 512;
    {
        float* rope = (float*)(ws + WS_ROPE);
        for (int e = gt; e < SEQ * 8; e += NGT) { const int t = e >> 3, i = e & 7;
            const float invf = i == 0 ? 1.0f : i == 1 ? 0.1939227432012558f : i == 2 ? 0.03760603070259094f : i == 3 ? 0.007292664609849453f : i == 4 ? 0.0014142135623842478f : i == 5 ? 0.00027424818836152554f : i == 6 ? 5.318296098266728e-05f : 1.0313386155758053e-05f;
            const float angf = (float)t * invf; const double ang = (double)angf;
            const double qd = __builtin_rint(ang * 0.63661977236758134308); const double r = (ang - qd * 1.5707963267948966192) - qd * 6.123233995736766e-17; const int qi = ((int)qd) & 3;
            const double r2 = r * r;
            const double sr = r * (1.0 + r2 * (-1.0 / 6 + r2 * (1.0 / 120 + r2 * (-1.0 / 5040 + r2 * (1.0 / 362880 + r2 * (-1.0 / 39916800 + r2 * (1.0 / 6227020800.0)))))));
            const double cr = 1.0 + r2 * (-0.5 + r2 * (1.0 / 24 + r2 * (-1.0 / 720 + r2 * (1.0 / 40320 + r2 * (-1.0 / 3628800 + r2 * (1.0 / 479001600.0 + r2 * (-1.0 / 87178291200.0)))))));
            const double sn = qi == 0 ? sr : qi == 1 ? cr : qi == 2 ? -sr : -cr, cs = qi == 0 ? cr : qi == 1 ? -sr : qi == 2 ? -cr : sr;
            rope[e * 2] = (float)cs; rope[e * 2 + 1] = (float)sn; }
    }
    {
        const float* w = a.in[I_GWS]; bf16_t* o = (bf16_t*)(ws + WS_GMW);
        for (int e = gt; e < 8 * 128 * 128; e += NGT) { const int t = (e >> 7) & 127, s = e & 127; const float v = s <= t ? w[e] : 0.f; o[e] = (bf16_t)(cvt_pk_bf16(v, 0.f) & 0xffffu); }
    }
}

__device__ __forceinline__ void p8_extras(const Ctx& C, const Args& a) {
    unsigned char* ws = a.ws; const int gw = C.bid * 8 + C.wave, NGW = C.G * 8;
    LAS float* scr = (LAS float*)(C.lds + C.wave * TR_SCR);
    for (int it = gw; it < 2112; it += NGW) { int r = it;
        if (r < 1408) { transpose_item(a.in[I_F2WI], 1024, 5632, (bf16_t*)(ws + WS_WFIN), a.in[I_F2N], 1, scr, r, C.lane); continue; } r -= 1408;
        transpose_item(a.in[I_F2WO], 2816, 1024, (bf16_t*)(ws + WS_WFOUT), nullptr, 0, scr, r, C.lane); }
    const float* p = a.in[I_P]; bf16_t* pb = (bf16_t*)(ws + WS_PB);
    for (int r = gw; r < T; r += NGW) { const f32x4 v = ((const f32x4*)(p + (size_t)r * PLE))[C.lane]; ((u32x2*)(pb + (size_t)r * PLE))[C.lane] = (u32x2){cvt_pk_bf16(v.x, v.y), cvt_pk_bf16(v.z, v.w)}; }
}

__device__ __forceinline__ void gmlp_job(const Ctx& C, const Args& a, int job) {
    unsigned char* ws = a.ws; const int g = job & 7, chunk = job >> 3; const int tok0 = chunk * 128;
    const bf16_t* gv = (const bf16_t*)(ws + WS_GV); bf16_t* ub = (bf16_t*)(ws + WS_UB); const float* vstat = (const float*)(ws + WS_VSTAT); const bf16_t* gmw = (const bf16_t*)(ws + WS_GMW);
    LAS bf16_t* vnT = (LAS bf16_t*)C.lds;
    const int wr = C.wave >> 1, wc = C.wave & 1, n = C.lane & 31, hi = C.lane >> 5;
    bf16x8 af[8];
    {   const bf16_t* wrow = gmw + ((size_t)g * 128 + wr * 32 + n) * 128 + 8 * hi;
#pragma unroll
        for (int k0 = 0; k0 < 8; ++k0) af[k0] = *(const bf16x8*)(wrow + 16 * k0); }
    {   const int s = C.tid >> 2, cq = C.tid & 3; const size_t row = (size_t)tok0 + s;
        float s1 = 0.f, s2 = 0.f;
#pragma unroll
        for (int k = 0; k < 8; ++k) { const f32x4 p = *(const f32x4*)(vstat + row * 32 + 4 * k); s1 += p.x + p.z; s2 += p.y + p.w; }
        const float mean = s1 * (1.0f / 1024.0f), var = s2 * (1.0f / 1024.0f) - mean * mean, rstd = rsqrtf(var + EPS);
        const float* lng = a.in[I_LNG] + g * 128 + cq * 32; const float* lnb = a.in[I_LNB] + g * 128 + cq * 32;
#pragma unroll
        for (int c8 = 0; c8 < 4; ++c8) { float v[8]; unpack8(*(const u32x4*)(gv + row * DM + g * 128 + cq * 32 + c8 * 8), v);
#pragma unroll
            for (int j = 0; j < 8; ++j) { const float y = (v[j] - mean) * rstd * lng[c8 * 8 + j] + lnb[c8 * 8 + j]; vnT[(cq * 32 + c8 * 8 + j) * 136 + s] = (bf16_t)(cvt_pk_bf16(y, 0.f) & 0xffffu); } }
    }
    __syncthreads();
    {   f32x16 acc0 = {}, acc1 = {};
        const LAS bf16_t* b0p = vnT + (wc * 64 + n) * 136 + 8 * hi; const LAS bf16_t* b1p = b0p + 32 * 136;
#pragma unroll
        for (int k0 = 0; k0 < 8; ++k0) if (k0 < 2 * (wr + 1)) { const bf16x8 bf0 = *(const LAS bf16x8*)(b0p + 16 * k0), bf1 = *(const LAS bf16x8*)(b1p + 16 * k0);
            acc0 = __builtin_amdgcn_mfma_f32_32x32x16_bf16(af[k0], bf0, acc0, 0, 0, 0); acc1 = __builtin_amdgcn_mfma_f32_32x32x16_bf16(af[k0], bf1, acc1, 0, 0, 0); }
        const float* bs = a.in[I_GBS] + g * 128 + wr * 32;
#pragma unroll
        for (int r = 0; r < 16; ++r) { const int tl = (r & 3) + 8 * (r >> 2) + 4 * hi; const float bias = bs[tl]; const size_t off = ((size_t)tok0 + wr * 32 + tl) * DM + g * 128 + wc * 64 + n;
            const float u0 = bf2f(ub[off]), u1 = bf2f(ub[off + 32]);
            ub[off] = (bf16_t)(cvt_pk_bf16(u0 * (acc0[r] + bias), 0.f) & 0xffffu); ub[off + 32] = (bf16_t)(cvt_pk_bf16(u1 * (acc1[r] + bias), 0.f) & 0xffffu); }
    }
    __syncthreads();
}

__device__ __forceinline__ void cmp2_phase(const Ctx& C, const Args& a) {
    unsigned char* ws = a.ws; const bf16_t* chid = (const bf16_t*)(ws + WS_CHID); bf16_t* kcmp = (bf16_t*)(ws + WS_KCMP); bf16_t* vcmpT = (bf16_t*)(ws + WS_VCMPT);
    const int gw = C.bid * 8 + C.wave, NGW = C.G * 8;
    for (int it = gw; it < 2048; it += NGW) { const int tsr = it >> 10, R0 = (it & 1023) * 4;
        const float* w2 = a.in[tsr ? I_CVW2 : I_CKW2]; const bf16_t* hr = chid + ((size_t)tsr * 4096 + R0) * 256;
        float acc[4] = {0.f, 0.f, 0.f, 0.f};
        for (int k8 = 0; k8 < 32; ++k8) { float wv[8];
#pragma unroll
            for (int j = 0; j < 8; ++j) wv[j] = w2[(k8 * 8 + j) * 64 + C.lane];
#pragma unroll
            for (int rr = 0; rr < 4; ++rr) { float hv[8]; unpack8(*(const u32x4*)(hr + rr * 256 + k8 * 8), hv);
#pragma unroll
                for (int j = 0; j < 8; ++j) acc[rr] += hv[j] * wv[j]; } }
#pragma unroll
        for (int rr = 0; rr < 4; ++rr) { const int R = R0 + rr; const int h = R >> 10, b = (R >> 8) & 3, i = R & 255;
            const bf16_t o = (bf16_t)(cvt_pk_bf16(i == 255 ? 0.f : acc[rr], 0.f) & 0xffffu);
            if (tsr == 0) kcmp[((size_t)(b * 4 + h) * 256 + i) * 64 + C.lane] = o; else vcmpT[((size_t)(b * 4 + h) * 64 + C.lane) * 256 + i] = o; } }
}

__device__ __forceinline__ void final_phase(const Ctx& C, const Args& a) {
    const float* ssa = (const float*)(a.ws + WS_SSA); const float* fn = a.in[I_FIN]; const int gw = C.bid * 8 + C.wave, NGW = C.G * 8;
    for (int r = gw; r < T; r += NGW) { float s = C.lane < 16 ? ssa[(size_t)r * 16 + C.lane] : 0.f; s = wave_sum(s); const float rstd = rsqrtf(s * (1.0f / 1024.0f) + EPS);
        f32x4* o = (f32x4*)(a.out + (size_t)r * DM) + C.lane; const f32x4* gp = (const f32x4*)fn + C.lane;
#pragma unroll
        for (int j = 0; j < 4; ++j) { const f32x4 v = o[64 * j], gg = gp[64 * j]; o[64 * j] = (f32x4){v.x * rstd * gg.x, v.y * rstd * gg.y, v.z * rstd * gg.z, v.w * rstd * gg.w}; } }
}

namespace att {
constexpr int ROWB = 144;
constexpr int TILEB = 64 * ROWB;
constexpr int OFF_K = 0, OFF_V = 2 * TILEB, OFF_PC = 4 * TILEB, PCROW = 260, OFF_WSF = OFF_PC + 64 * PCROW * 4, OFF_SELM = OFF_WSF + 8 * 64 * 4, LDS_END = OFF_SELM + 64 * 8;
static_assert(LDS_END <= 131072, "attention LDS");
__device__ __forceinline__ int crow(int r, int hi) { return (r & 3) + 8 * (r >> 2) + 4 * hi; }

struct Stream { const bf16_t* K; size_t kstride; const bf16_t* V; size_t vstride; };

struct State { float m, l; f32x16 o0, o1; };

struct Pre { u32x4 k0, v0, k1; };
__device__ __forceinline__ Pre prefetch(int tid, const Stream& S, int t0, int nt, bool needv) {
    const int lr = tid >> 3, lc = tid & 7; Pre p;
    const bf16_t* kg = S.K + (size_t)(t0 * 64 + lr) * S.kstride + lc * 8;
    p.k0 = *(const u32x4*)kg; p.v0 = (u32x4){0u, 0u, 0u, 0u}; p.k1 = p.v0;
    if (needv) p.v0 = *(const u32x4*)(S.V + (size_t)lr * S.vstride + (size_t)t0 * 64 + lc * 8);
    if (nt > 1) p.k1 = *(const u32x4*)(kg + (size_t)64 * S.kstride);
    return p;
}
template <int MODE>
__device__ __forceinline__ void run_branch(int tid, LAS unsigned char* lds, const Stream& S, const Pre& pre, int t0, int nt, const bf16x8 (&qf)[4], int klo, int khi, unsigned long long selbits,
                                           State& st, float inv_l, int tokl, int g) {
    const int lane = tid & 63, q = lane & 31, hi = lane >> 5, wid = __builtin_amdgcn_readfirstlane(tid >> 6);
    const int lr = tid >> 3, lc = tid & 7;
    const int pim = 16 * (q >> 4) + 8 * ((q >> 2) & 1) + 4 * ((q >> 3) & 1) + (q & 3);
    LAS float* wsf = (LAS float*)(lds + OFF_WSF) + wid * 64;
    LAS float* pc = (LAS float*)(lds + OFF_PC);
    const bf16_t* kg = S.K + (size_t)(t0 * 64 + lr) * S.kstride + lc * 8;
    const bf16_t* vg = S.V + (size_t)lr * S.vstride + (size_t)t0 * 64 + lc * 8;
    const unsigned sto = lr * ROWB + lc * 16;
    u32x4 kreg = pre.k1, vreg = pre.v0;
    *(LAS u32x4*)(lds + OFF_K + sto) = pre.k0; if (MODE != 1) *(LAS u32x4*)(lds + OFF_V + sto) = pre.v0;
    if (nt > 1) *(LAS u32x4*)(lds + OFF_K + TILEB + sto) = pre.k1;
    __syncthreads();
    const LAS unsigned char* kfb = lds + OFF_K + pim * ROWB + hi * 16;
    f32x16 p0 = {}, p1 = {};
#pragma unroll
    for (int d0 = 0; d0 < 4; ++d0) { const bf16x8 a0 = *(const LAS bf16x8*)(kfb + d0 * 32), a1 = *(const LAS bf16x8*)(kfb + 32 * ROWB + d0 * 32);
        p0 = __builtin_amdgcn_mfma_f32_32x32x16_bf16(a0, qf[d0], p0, 0, 0, 0); p1 = __builtin_amdgcn_mfma_f32_32x32x16_bf16(a1, qf[d0], p1, 0, 0, 0); }
    f32x16 q0 = {}, q1 = {};
    for (int t = 0; t < nt; t += 2) {
        {   const int jt = t0 + t; constexpr int buf = 0;
        if (t + 2 < nt) kreg = *(const u32x4*)(kg + (size_t)(t + 2) * 64 * S.kstride);
        if (MODE != 1 && t + 1 < nt) vreg = *(const u32x4*)(vg + (size_t)(t + 1) * 64);
        const int kb0 = jt * 64;
        const bool bit = (selbits >> jt) & 1ull;
        const bool none = !bit || kb0 > khi || kb0 + 63 < klo;
        const bool allv = bit && kb0 >= klo && kb0 + 63 <= khi;
        const bool colv = !none;
        if (__any(colv && !allv)) {
            const int hr = khi - kb0 - 8 * hi, lrr = klo - kb0 - 8 * hi;
#pragma unroll
            for (int r = 0; r < 16; ++r) { const int c = 16 * (r >> 3) + (r & 7);
                if (!(c <= hr && c >= lrr)) p0[r] = -__builtin_inff();
                if (!(c + 32 <= hr && c + 32 >= lrr)) p1[r] = -__builtin_inff(); }
        }
        float tm = fmaxf(fmaxf(p0[0], p0[1]), p0[2]);
#pragma unroll
        for (int r = 3; r < 15; r += 2) tm = fmaxf(fmaxf(tm, p0[r]), p0[r + 1]);
        tm = fmaxf(tm, p0[15]);
#pragma unroll
        for (int r = 0; r < 16; r += 2) tm = fmaxf(fmaxf(tm, p1[r]), p1[r + 1]);
        tm = fmaxf(tm, __shfl_xor(tm, 32));
        if (!colv) tm = -__builtin_inff();
        float mref;
        if (MODE == 2) { mref = st.m; }
        else {
            if (__any(tm > st.m + 8.0f)) {
                const float mn = fmaxf(st.m, tm); const float alpha = __builtin_amdgcn_exp2f(st.m - mn); st.l *= alpha; st.m = mn;
                if (MODE == 0) { if (hi == 0) wsf[q] = alpha; LDS_FENCE();
#pragma unroll
                    for (int r = 0; r < 16; ++r) { const float f = wsf[crow(r, hi)]; st.o0[r] *= f; st.o1[r] *= f; }
                    LDS_FENCE(); }
            }
            mref = st.m;
        }
        const float msub = colv ? mref : __builtin_inff();
        q0 = (f32x16){}; q1 = (f32x16){};
        {   const LAS unsigned char* kb = kfb + (buf ^ 1) * TILEB;
#pragma unroll
            for (int d0 = 0; d0 < 4; ++d0) { const bf16x8 a0 = *(const LAS bf16x8*)(kb + d0 * 32), a1 = *(const LAS bf16x8*)(kb + 32 * ROWB + d0 * 32);
                q0 = __builtin_amdgcn_mfma_f32_32x32x16_bf16(a0, qf[d0], q0, 0, 0, 0); q1 = __builtin_amdgcn_mfma_f32_32x32x16_bf16(a1, qf[d0], q1, 0, 0, 0); } }
        float ls = 0.f;
#pragma unroll
        for (int r = 0; r < 16; ++r) { p0[r] = __builtin_amdgcn_exp2f(p0[r] - msub); p1[r] = __builtin_amdgcn_exp2f(p1[r] - msub); ls += p0[r] + p1[r]; }
        if (MODE != 2) st.l += ls;
        if (MODE == 2) {
#pragma unroll
            for (int r = 0; r < 16; ++r) { p0[r] *= inv_l; p1[r] *= inv_l; }
            float hs0[16], hs1[16];
#pragma unroll
            for (int r = 0; r < 16; ++r) { hs0[r] = quad_sum(p0[r]); hs1[r] = quad_sum(p1[r]); }
            if (g == 0) { LAS float* pr = pc + tokl * PCROW + kb0 + 8 * hi;
#pragma unroll
                for (int r = 0; r < 16; ++r) { pr[16 * (r >> 3) + (r & 7)] = hs0[r]; pr[16 * (r >> 3) + (r & 7) + 32] = hs1[r]; } }
        }
        if (MODE != 1) {
            bf16x8 pa[4];
            {   u32x4 w;
                w.x = cvt_pk_bf16(p0[0], p0[1]); w.y = cvt_pk_bf16(p0[2], p0[3]); w.z = cvt_pk_bf16(p0[4], p0[5]); w.w = cvt_pk_bf16(p0[6], p0[7]); pa[0] = __builtin_bit_cast(bf16x8, w);
                w.x = cvt_pk_bf16(p0[8], p0[9]); w.y = cvt_pk_bf16(p0[10], p0[11]); w.z = cvt_pk_bf16(p0[12], p0[13]); w.w = cvt_pk_bf16(p0[14], p0[15]); pa[1] = __builtin_bit_cast(bf16x8, w);
                w.x = cvt_pk_bf16(p1[0], p1[1]); w.y = cvt_pk_bf16(p1[2], p1[3]); w.z = cvt_pk_bf16(p1[4], p1[5]); w.w = cvt_pk_bf16(p1[6], p1[7]); pa[2] = __builtin_bit_cast(bf16x8, w);
                w.x = cvt_pk_bf16(p1[8], p1[9]); w.y = cvt_pk_bf16(p1[10], p1[11]); w.z = cvt_pk_bf16(p1[12], p1[13]); w.w = cvt_pk_bf16(p1[14], p1[15]); pa[3] = __builtin_bit_cast(bf16x8, w); }
            const LAS unsigned char* vb = lds + OFF_V + buf * TILEB + q * ROWB + hi * 16;
#pragma unroll
            for (int c = 0; c < 4; ++c) { const bf16x8 v0 = *(const LAS bf16x8*)(vb + c * 32), v1 = *(const LAS bf16x8*)(vb + 32 * ROWB + c * 32);
                st.o0 = __builtin_amdgcn_mfma_f32_32x32x16_bf16(pa[c], v0, st.o0, 0, 0, 0); st.o1 = __builtin_amdgcn_mfma_f32_32x32x16_bf16(pa[c], v1, st.o1, 0, 0, 0); }
        }
        if (t + 2 < nt) *(LAS u32x4*)(lds + OFF_K + buf * TILEB + sto) = kreg;
        if (MODE != 1 && t + 1 < nt) *(LAS u32x4*)(lds + OFF_V + (buf ^ 1) * TILEB + sto) = vreg;
        __syncthreads();
        }
        if (t + 1 < nt) { const int t_ = t; { const int t = t_ + 1; const int jt = t0 + t; constexpr int buf = 1;
        if (t + 2 < nt) kreg = *(const u32x4*)(kg + (size_t)(t + 2) * 64 * S.kstride);
        if (MODE != 1 && t + 1 < nt) vreg = *(const u32x4*)(vg + (size_t)(t + 1) * 64);
        const int kb0 = jt * 64;
        const bool bit = (selbits >> jt) & 1ull;
        const bool none = !bit || kb0 > khi || kb0 + 63 < klo;
        const bool allv = bit && kb0 >= klo && kb0 + 63 <= khi;
        const bool colv = !none;
        if (__any(colv && !allv)) {
            const int hr = khi - kb0 - 8 * hi, lrr = klo - kb0 - 8 * hi;
#pragma unroll
            for (int r = 0; r < 16; ++r) { const int c = 16 * (r >> 3) + (r & 7);
                if (!(c <= hr && c >= lrr)) q0[r] = -__builtin_inff();
                if (!(c + 32 <= hr && c + 32 >= lrr)) q1[r] = -__builtin_inff(); }
        }
        float tm = fmaxf(fmaxf(q0[0], q0[1]), q0[2]);
#pragma unroll
        for (int r = 3; r < 15; r += 2) tm = fmaxf(fmaxf(tm, q0[r]), q0[r + 1]);
        tm = fmaxf(tm, q0[15]);
#pragma unroll
        for (int r = 0; r < 16; r += 2) tm = fmaxf(fmaxf(tm, q1[r]), q1[r + 1]);
        tm = fmaxf(tm, __shfl_xor(tm, 32));
        if (!colv) tm = -__builtin_inff();
        float mref;
        if (MODE == 2) { mref = st.m; }
        else {
            if (__any(tm > st.m + 8.0f)) {
                const float mn = fmaxf(st.m, tm); const float alpha = __builtin_amdgcn_exp2f(st.m - mn); st.l *= alpha; st.m = mn;
                if (MODE == 0) { if (hi == 0) wsf[q] = alpha; LDS_FENCE();
#pragma unroll
                    for (int r = 0; r < 16; ++r) { const float f = wsf[crow(r, hi)]; st.o0[r] *= f; st.o1[r] *= f; }
                    LDS_FENCE(); }
            }
            mref = st.m;
        }
        const float msub = colv ? mref : __builtin_inff();
        p0 = (f32x16){}; p1 = (f32x16){};
        {   const LAS unsigned char* kb = kfb + (buf ^ 1) * TILEB;
#pragma unroll
            for (int d0 = 0; d0 < 4; ++d0) { const bf16x8 a0 = *(const LAS bf16x8*)(kb + d0 * 32), a1 = *(const LAS bf16x8*)(kb + 32 * ROWB + d0 * 32);
                p0 = __builtin_amdgcn_mfma_f32_32x32x16_bf16(a0, qf[d0], p0, 0, 0, 0); p1 = __builtin_amdgcn_mfma_f32_32x32x16_bf16(a1, qf[d0], p1, 0, 0, 0); } }
        float ls = 0.f;
#pragma unroll
        for (int r = 0; r < 16; ++r) { q0[r] = __builtin_amdgcn_exp2f(q0[r] - msub); q1[r] = __builtin_amdgcn_exp2f(q1[r] - msub); ls += q0[r] + q1[r]; }
        if (MODE != 2) st.l += ls;
        if (MODE == 2) {
#pragma unroll
            for (int r = 0; r < 16; ++r) { q0[r] *= inv_l; q1[r] *= inv_l; }
            float hs0[16], hs1[16];
#pragma unroll
            for (int r = 0; r < 16; ++r) { hs0[r] = quad_sum(q0[r]); hs1[r] = quad_sum(q1[r]); }
            if (g == 0) { LAS float* pr = pc + tokl * PCROW + kb0 + 8 * hi;
#pragma unroll
                for (int r = 0; r < 16; ++r) { pr[16 * (r >> 3) + (r & 7)] = hs0[r]; pr[16 * (r >> 3) + (r & 7) + 32] = hs1[r]; } }
        }
        if (MODE != 1) {
            bf16x8 pa[4];
            {   u32x4 w;
                w.x = cvt_pk_bf16(q0[0], q0[1]); w.y = cvt_pk_bf16(q0[2], q0[3]); w.z = cvt_pk_bf16(q0[4], q0[5]); w.w = cvt_pk_bf16(q0[6], q0[7]); pa[0] = __builtin_bit_cast(bf16x8, w);
                w.x = cvt_pk_bf16(q0[8], q0[9]); w.y = cvt_pk_bf16(q0[10], q0[11]); w.z = cvt_pk_bf16(q0[12], q0[13]); w.w = cvt_pk_bf16(q0[14], q0[15]); pa[1] = __builtin_bit_cast(bf16x8, w);
                w.x = cvt_pk_bf16(q1[0], q1[1]); w.y = cvt_pk_bf16(q1[2], q1[3]); w.z = cvt_pk_bf16(q1[4], q1[5]); w.w = cvt_pk_bf16(q1[6], q1[7]); pa[2] = __builtin_bit_cast(bf16x8, w);
                w.x = cvt_pk_bf16(q1[8], q1[9]); w.y = cvt_pk_bf16(q1[10], q1[11]); w.z = cvt_pk_bf16(q1[12], q1[13]); w.w = cvt_pk_bf16(q1[14], q1[15]); pa[3] = __builtin_bit_cast(bf16x8, w); }
            const LAS unsigned char* vb = lds + OFF_V + buf * TILEB + q * ROWB + hi * 16;
#pragma unroll
            for (int c = 0; c < 4; ++c) { const bf16x8 v0 = *(const LAS bf16x8*)(vb + c * 32), v1 = *(const LAS bf16x8*)(vb + 32 * ROWB + c * 32);
                st.o0 = __builtin_amdgcn_mfma_f32_32x32x16_bf16(pa[c], v0, st.o0, 0, 0, 0); st.o1 = __builtin_amdgcn_mfma_f32_32x32x16_bf16(pa[c], v1, st.o1, 0, 0, 0); }
        }
        if (t + 2 < nt) *(LAS u32x4*)(lds + OFF_K + buf * TILEB + sto) = kreg;
        if (MODE != 1 && t + 1 < nt) *(LAS u32x4*)(lds + OFF_V + (buf ^ 1) * TILEB + sto) = vreg;
        __syncthreads();
        } }
    }
}

struct Tensors { const bf16_t *qraw, *qrot, *ks, *kw, *vst, *vwt, *kcmp, *vcmpT; const float* gate; bf16_t* ob; };

template <bool FIRST>
__device__ __forceinline__ void fold(LAS float* wsf, LAS float* oacc, int q, int hi, float fac, const State& st) {
    if (hi == 0) wsf[q] = fac; LDS_FENCE();
#pragma unroll
    for (int r = 0; r < 16; ++r) { const int row = crow(r, hi); const float f = wsf[row]; LAS float* p = oacc + row * 64 + q;
        if (FIRST) { p[0] = st.o0[r] * f; p[32] = st.o1[r] * f; } else { p[0] += st.o0[r] * f; p[32] += st.o1[r] * f; } }
    LDS_FENCE();
}

__device__ __forceinline__ void job(LAS unsigned char* lds, const Tensors& X, int b, int kvh, int qb) {
    int tid_ = threadIdx.x; asm volatile("" : "+v"(tid_));
    const int tid = tid_, lane = tid & 63, q = lane & 31, hi = lane >> 5, wid = __builtin_amdgcn_readfirstlane(tid >> 6);
    const int tokl = 8 * wid + (q >> 2), g = q & 3, tq = 64 * qb + tokl, head = 4 * kvh + g;
    const size_t trow = (size_t)b * SEQ + tq;
    LAS float* wsf = (LAS float*)(lds + OFF_WSF) + wid * 64;
    LAS float* pc = (LAS float*)(lds + OFF_PC);
    LAS unsigned long long* selm = (LAS unsigned long long*)(lds + OFF_SELM);
    bf16x8 qf[4];
    {   const bf16_t* qp = X.qraw + trow * DM + head * 64 + 8 * hi;
#pragma unroll
        for (int d0 = 0; d0 < 4; ++d0) qf[d0] = *(const bf16x8*)(qp + 16 * d0); }
    const float g0 = X.gate[trow * 48 + head * 3 + 0], g1 = X.gate[trow * 48 + head * 3 + 1], g2 = X.gate[trow * 48 + head * 3 + 2];
    LAS float* oacc = pc + 8 * wid * PCROW;
    const size_t bk = (size_t)b * 4 + kvh;
    const Stream Ssel{X.ks + (size_t)b * SEQ * 256 + kvh * 64, 256, X.vst + bk * 64 * SEQ, SEQ};
    Pre prs;
    {   const Stream S{X.kcmp + bk * 256 * 64, 64, X.vcmpT + bk * 64 * 256, 256};
        const int nct = (qb >> 4) + 1; const int mmax = tq >= 31 ? ((tq - 31) >> 4) : -1;
        State st; st.m = -1e30f; st.l = 0.f; st.o0 = (f32x16){}; st.o1 = (f32x16){};
        const Pre prc = prefetch(tid, S, 0, nct, true);
        run_branch<1>(tid, lds, S, prc, 0, nct, qf, -(1 << 30), mmax, ~0ull, st, 0.f, tokl, g);
        float lt = st.l + __shfl_xor(st.l, 32); const float inv_l = lt > 0.f ? 1.0f / lt : 0.f;
        run_branch<2>(tid, lds, S, prc, 0, nct, qf, -(1 << 30), mmax, ~0ull, st, inv_l, tokl, g);
    prs = prefetch(tid, Ssel, 0, qb + 1, true);
    {
        if (qb < 16) { if (lane < 8) selm[8 * wid + lane] = (2ull << qb) - 1ull; }
        else
#pragma unroll 1
        for (int i = 0; i < 4; ++i) { const int j = lane; unsigned keyA, keyB;
            if (j == 0 || j == qb || j == qb - 1) { keyA = 0xffffffc0u; keyB = 0xffffffc0u; } else if (j > qb) { keyA = 0u; keyB = 0u; }
            else { const LAS float* pa_ = pc + (8 * wid + i) * PCROW + 4 * j; const LAS float* pb_ = pa_ + 4 * PCROW;
                const float sa = (((pa_[-1] + pa_[0]) + pa_[1]) + pa_[2]) + pa_[3], sb = (((pb_[-1] + pb_[0]) + pb_[1]) + pb_[2]) + pb_[3];
                keyA = (__float_as_uint(sa) & 0x7fffffc0u) + 64u; keyB = (__float_as_uint(sb) & 0x7fffffc0u) + 64u; }
            keyA |= (unsigned)(63 - j); keyB |= (unsigned)(63 - j);
            unsigned thrA = 0u, thrB = 0u;
#pragma unroll
            for (int bpos = 29; bpos >= 0; --bpos) { const unsigned cA = thrA | (1u << bpos), cB = thrB | (1u << bpos);
                const unsigned long long mA = __ballot(keyA >= cA), mB = __ballot(keyB >= cB); if (__popcll(mA) >= 16) thrA = cA; if (__popcll(mB) >= 16) thrB = cB; }
            const unsigned long long maskA = __ballot(keyA >= thrA), maskB = __ballot(keyB >= thrB);
            if (lane == 0) { selm[8 * wid + i] = maskA; selm[8 * wid + i + 4] = maskB; } }
        LDS_FENCE();
        fold<true>(wsf, oacc, q, hi, g0, st);
    }
    }
    const unsigned long long mysel = selm[tokl];
    qf[0] = *(const bf16x8*)(X.qrot + (trow * 16 + head) * 16 + 8 * hi);
    const Stream Swin{X.kw + (size_t)b * SEQ * 256 + kvh * 64, 256, X.vwt + bk * 64 * SEQ, SEQ};
    const int tw0 = qb >= 8 ? qb - 8 : 0;
    Pre prw;
    {   State st; st.m = -1e30f; st.l = 0.f; st.o0 = (f32x16){}; st.o1 = (f32x16){};
        run_branch<0>(tid, lds, Ssel, prs, 0, qb + 1, qf, -(1 << 30), tq, mysel, st, 0.f, tokl, g);
        prw = prefetch(tid, Swin, tw0, qb + 1 - tw0, true);
        const float lt = st.l + __shfl_xor(st.l, 32); fold<false>(wsf, oacc, q, hi, lt > 0.f ? g1 / lt : 0.f, st);
    }
    {   State st; st.m = -1e30f; st.l = 0.f; st.o0 = (f32x16){}; st.o1 = (f32x16){};
        run_branch<0>(tid, lds, Swin, prw, tw0, qb + 1 - tw0, qf, tq - 511, tq, ~0ull, st, 0.f, tokl, g);
        const float lt = st.l + __shfl_xor(st.l, 32); fold<false>(wsf, oacc, q, hi, lt > 0.f ? g2 / lt : 0.f, st);
    }
    {   const int qq = lane >> 1, ch = lane & 1; const LAS float* src = oacc + qq * 64 + ch * 32;
        bf16_t* op = X.ob + ((size_t)b * SEQ + 64 * qb + 8 * wid + (qq >> 2)) * DM + (4 * kvh + (qq & 3)) * 64 + ch * 32;
#pragma unroll
        for (int c = 0; c < 4; ++c) { const f32x4 x0 = *(const LAS f32x4*)(src + c * 8), x1 = *(const LAS f32x4*)(src + c * 8 + 4);
            *(u32x4*)(op + c * 8) = (u32x4){cvt_pk_bf16(x0[0], x0[1]), cvt_pk_bf16(x0[2], x0[3]), cvt_pk_bf16(x1[0], x1[1]), cvt_pk_bf16(x1[2], x1[3])}; }
        LDS_FENCE(); }
}
}


#define XB_TMO      128
#define XB_XCNT(j)  (256  + 64 * (j))
#define XB_XSUB(j)  (1280 + 64 * (j))
#define XB_XGEN(j)  (2304 + 64 * (j))
#define XB_TOP      3328
#define XB_TOPGEN   3392
#define XCD_BAR_WORDS 3456
#define XB_SPIN_CAP (1u << 20)
__device__ __forceinline__ unsigned xb_ld(unsigned* p)              { return __hip_atomic_load(p, __ATOMIC_RELAXED, __HIP_MEMORY_SCOPE_AGENT); }
__device__ __forceinline__ unsigned xb_add(unsigned* p, unsigned v) { return __hip_atomic_fetch_add(p, v, __ATOMIC_RELAXED, __HIP_MEMORY_SCOPE_AGENT); }
__device__ __forceinline__ unsigned xb_xcc_id() { return (unsigned)__builtin_amdgcn_s_getreg((3 << 11) | 20) & 0xFu; }
#define XB_SPIN(cond, bar) do { unsigned _sp = 0; while (cond) { __builtin_amdgcn_s_sleep(1); \
    if ((++_sp & 255u) == 0u) { if (xb_ld(&(bar)[XB_TMO])) break; if (_sp > XB_SPIN_CAP) { atomicAdd(&(bar)[XB_TMO], 1u); break; } } } } while (0)
struct XcdBarrier { unsigned* bar; unsigned x; volatile LAS unsigned* st; };
__device__ __forceinline__ XcdBarrier xcd_barrier_post(unsigned* bar, volatile LAS unsigned* st) {
    XcdBarrier b; b.bar = bar; b.x = xb_xcc_id(); b.st = st;
    if (threadIdx.x == 0) (void)xb_add(&bar[XB_XCNT(b.x)], 1u);
    return b;
}
__device__ __forceinline__ void xcd_barrier_complete(unsigned* bar, unsigned x, unsigned& nloc, unsigned& nx) {
    const unsigned G = gridDim.x * gridDim.y * gridDim.z;
    unsigned sum, cnt, mine, sp = 0u;
    for (;;) {
        sum = 0u; cnt = 0u; mine = 0u;
#pragma unroll
        for (unsigned j = 0; j < 16; ++j) { const unsigned c = xb_ld(&bar[XB_XCNT(j)]); sum += c; cnt += (c > 0u) ? 1u : 0u; mine = (j == x) ? c : mine; }
        if (sum == G) break;
        __builtin_amdgcn_s_sleep(1);
        if ((++sp & 255u) == 0u) { if (xb_ld(&bar[XB_TMO])) break; if (sp > XB_SPIN_CAP) { atomicAdd(&bar[XB_TMO], 1u); break; } }
    }
    nloc = mine > 0u ? mine : 1u; nx = cnt > 0u ? cnt : 1u;
}
__device__ __forceinline__ void xcd_barrier(const XcdBarrier& b) {
    asm volatile("s_waitcnt vmcnt(0)" ::: "memory");
    __syncthreads();
    if (threadIdx.x == 0) {
        unsigned* bar = b.bar;
        __builtin_amdgcn_s_waitcnt(0);
        unsigned nloc = b.st[0], nx = b.st[1];
        if (nloc == 0u) { xcd_barrier_complete(bar, b.x, nloc, nx); b.st[0] = nloc; b.st[1] = nx; }
        const unsigned old = xb_add(&bar[XB_XSUB(b.x)], 1u);
        const unsigned gen = old / nloc;
        if (old + 1u == (gen + 1u) * nloc) {
            __builtin_amdgcn_fence(__ATOMIC_RELEASE, "agent");
            asm volatile("s_waitcnt vmcnt(0)" ::: "memory");
            const unsigned og = xb_add(&bar[XB_TOP], 1u);
            const unsigned tg = og / nx;
            if (og + 1u == (tg + 1u) * nx) xb_add(&bar[XB_TOPGEN], 1u);
            else XB_SPIN(xb_ld(&bar[XB_TOPGEN]) == tg, bar);
            __builtin_amdgcn_fence(__ATOMIC_ACQUIRE, "agent");
            xb_add(&bar[XB_XGEN(b.x)], 1u);
            asm volatile("s_waitcnt vmcnt(0)" ::: "memory");
        } else {
            XB_SPIN(xb_ld(&bar[XB_XGEN(b.x)]) == gen, bar);
            __builtin_amdgcn_fence(__ATOMIC_ACQUIRE, "agent");
            asm volatile("s_waitcnt vmcnt(0)" ::: "memory");
        }
    }
    __syncthreads();
}

constexpr int LDS_BYTES = 147456;
typedef const __attribute__((address_space(4))) Args* KArgP;
#define KARGS() (*(const Args*)({ KArgP p_ = (KArgP)__builtin_amdgcn_kernarg_segment_ptr(); asm volatile("" : "+s"(p_)); p_; }))
__global__ void __launch_bounds__(512, 2) mk_fwd(Args a_unused) {
    extern __shared__ __attribute__((aligned(16))) unsigned char lds_raw[];
    Ctx C; C.lds = (LAS unsigned char*)lds_raw; C.tid = threadIdx.x; C.lane = C.tid & 63; C.wave = __builtin_amdgcn_readfirstlane(C.tid >> 6); C.G = gridDim.x; C.bid = blockIdx.x;
    const int lo = KARGS().ph_lo, hi = KARGS().ph_hi;
    volatile LAS unsigned* xst = (volatile LAS unsigned*)(C.lds + LDS_BYTES - 64);
    if (C.tid < 2) xst[C.tid] = 0u;
    __syncthreads();
    if (lo > NPHASE) cg::this_grid().sync();
    const XcdBarrier xbar = xcd_barrier_post((unsigned*)(KARGS().ws + WS_BAR), xst);
#ifdef ONLY_PHASE
#define IN(k) ((k) == ONLY_PHASE && lo <= (k) && (k) < hi)
#else
#define IN(k) (lo <= (k) && (k) < hi)
#endif
#define SEAM(k) do { if (IN(k) && IN((k) + 1)) { xcd_barrier(xbar); } } while (0)
    using namespace pg8;
    const int NT = T / 256;
#define PHASE_VARS const Args& a = KARGS(); unsigned char* ws = a.ws; float* ssA = (float*)(ws + WS_SSA); float* ssB = (float*)(ws + WS_SSB); bf16_t* hb = (bf16_t*)(ws + WS_HB); bf16_t* hid = (bf16_t*)(ws + WS_HID); float* ssC = (float*)(ws + WS_SSC); float* ssD = (float*)(ws + WS_SSD); (void)ssC; (void)ssD; \
    (void)ssA; (void)ssB; (void)hb; (void)hid;

    if (IN(0)) { PHASE_VARS p0_prologue(C, a);
#ifdef PROBE_P0X2
        __syncthreads(); p0_prologue(C, a);
#endif
    } SEAM(0);
    if (IN(1)) { PHASE_VARS
        Gemm g{(const char*)(ws + WS_XB), (const char*)(ws + WS_WFIN), DM, 128, DM, NT, 22, 0}; StaticOrder S; S.init(NT, 22, C.G, C.bid);
        EpiSwiGLU E{ssA, hid}; gemm_phase<EpiSwiGLU, StaticOrder>(C.lds, g, S, E);
#ifdef PROBE_G1X2
        gemm_phase<EpiSwiGLU, StaticOrder>(C.lds, g, S, E);
#endif
    } SEAM(1);
    if (IN(2)) { PHASE_VARS
        Gemm g{(const char*)hid, (const char*)(ws + WS_WFOUT), FF, 128, FF, NT, 4, 0}; StaticOrder S; S.init(NT, 4, C.G, C.bid);
        EpiResid E{a.in[I_X], 0.5f, hb, ssB}; gemm_phase<EpiResid, StaticOrder>(C.lds, g, S, E);
    } SEAM(2);
    if (IN(3)) { PHASE_VARS
        Gemm g{(const char*)hb, (const char*)(ws + WS_WIN), DM, 128, DM, NT, 23, 0}; StaticOrder S; S.init(NT, 23, C.G, C.bid);
        EpiProj E{ssB, (const float*)(ws + WS_ROPE), (bf16_t*)(ws + WS_UB), (bf16_t*)(ws + WS_GV), (bf16_t*)(ws + WS_QRAW), (bf16_t*)(ws + WS_QROT), (bf16_t*)(ws + WS_KC), (bf16_t*)(ws + WS_VC),
                  (bf16_t*)(ws + WS_KS), (bf16_t*)(ws + WS_KW), (bf16_t*)(ws + WS_VST), (bf16_t*)(ws + WS_VWT), (bf16_t*)(ws + WS_GA), (float*)(ws + WS_VSTAT), (float*)(ws + WS_GATE)};
        gemm_phase<EpiProj, StaticOrder>(C.lds, g, S, E);
#ifdef PROBE_G3X2
        gemm_phase<EpiProj, StaticOrder>(C.lds, g, S, E);
#endif
    } SEAM(3);
    if (IN(4)) { PHASE_VARS
#ifndef NO_CMP
        {   Gemm g{(const char*)(ws + WS_KC), (const char*)(ws + WS_WC1), 4096, 512, 2048, 32, 1, 1}; StaticOrder S; S.init(32, 1, C.G, C.bid);
            EpiCmp1 E{(bf16_t*)(ws + WS_CHID), (const float*)(ws + WS_CBIAS)}; gemm_phase<EpiCmp1, StaticOrder>(C.lds, g, S, E); }
#endif
        __syncthreads();
#ifndef NO_GMLP
        if (C.G == 256) { if (C.bid >= 32) for (int j = C.bid - 32; j < 1024; j += 224) gmlp_job(C, a, j); }
        else for (int j = C.bid; j < 1024; j += C.G) gmlp_job(C, a, j);
#endif
    } SEAM(4);
    if (IN(5)) { PHASE_VARS
        {   Gemm g{(const char*)(ws + WS_UB), (const char*)(ws + WS_WA), DM, 128, DM, NT, 4, 0}; StaticOrder S; S.init(NT, 4, C.G, C.bid);
            EpiBf16<2> E{(bf16_t*)(ws + WS_GV), nullptr, (const bf16_t*)(ws + WS_GA), nullptr}; gemm_phase<EpiBf16<2>, StaticOrder>(C.lds, g, S, E); }
#ifndef NO_CMP
        cmp2_phase(C, a);
#endif
    } SEAM(5);
    if (IN(6)) { PHASE_VARS
        att::Tensors X{(const bf16_t*)(ws + WS_QRAW), (const bf16_t*)(ws + WS_QROT), (const bf16_t*)(ws + WS_KS), (const bf16_t*)(ws + WS_KW), (const bf16_t*)(ws + WS_VST), (const bf16_t*)(ws + WS_VWT),
                       (const bf16_t*)(ws + WS_KCMP), (const bf16_t*)(ws + WS_VCMPT), (const float*)(ws + WS_GATE), (bf16_t*)(ws + WS_QRAW)};
#ifndef NO_ATTN
#ifdef PROBE_ATTN2
        { att::Tensors X0 = X; X0.ob = (bf16_t*)(ws + WS_UB);
        if (C.G == 256) { const int vcu = (C.bid & 7) * 32 + (C.bid >> 3); const int bkv = vcu >> 4, s = vcu & 15;
#pragma unroll 1
            for (int i = 0; i < 4; ++i) { const int qb = i == 0 ? 63 - s : i == 1 ? 32 + s : i == 2 ? 31 - s : s; att::job(C.lds, X0, bkv >> 2, bkv & 3, qb); }
        } else { for (int j = C.bid; j < 1024; j += C.G) { const int bkv = j & 15, qb = 63 - (j >> 4); att::job(C.lds, X0, bkv >> 2, bkv & 3, qb); } }
        __syncthreads(); }
#endif
        if (C.G == 256) { const int vcu = (C.bid & 7) * 32 + (C.bid >> 3); const int bkv = vcu >> 4, s = vcu & 15;
#pragma unroll 1
            for (int i = 0; i < 4; ++i) { const int qb = i == 0 ? 63 - s : i == 1 ? 32 + s : i == 2 ? 31 - s : s; att::job(C.lds, X, bkv >> 2, bkv & 3, qb); }
        } else { for (int j = C.bid; j < 1024; j += C.G) { const int bkv = j & 15, qb = 63 - (j >> 4); att::job(C.lds, X, bkv >> 2, bkv & 3, qb); } }
#endif
        __syncthreads();
#ifndef NO_GB
        {   Gemm g{(const char*)hb, (const char*)(ws + WS_WGB), DM, 128, DM, NT, 4, 0}; StaticOrder S; S.init(NT, 4, C.G, C.bid);
            EpiBf16<0> E{(bf16_t*)(ws + WS_UB), nullptr, nullptr, nullptr}; gemm_phase<EpiBf16<0>, StaticOrder>(C.lds, g, S, E); }
#endif
    } SEAM(6);
    if (IN(7)) { PHASE_VARS
        Gemm g{(const char*)(ws + WS_QRAW), (const char*)(ws + WS_WB), DM, 128, DM, NT, 4, 0}; StaticOrder S; S.init(NT, 4, C.G, C.bid);
        EpiBf16<4> E{(bf16_t*)(ws + WS_GV), ssB, (const bf16_t*)(ws + WS_UB), (const bf16_t*)(ws + WS_GV)}; gemm_phase<EpiBf16<4>, StaticOrder>(C.lds, g, S, E);
    } SEAM(7);
    if (IN(8)) { PHASE_VARS
        {   Gemm g{(const char*)(ws + WS_GV), (const char*)(ws + WS_WO), DM, 128, DM, NT, 4, 0}; StaticOrder S; S.init(NT, 4, C.G, C.bid);
            EpiResid E{nullptr, 1.0f, hb, ssC}; gemm_phase<EpiResid, StaticOrder>(C.lds, g, S, E); }
        __syncthreads();
        p8_extras(C, a);
    } SEAM(8);
    if (IN(9)) { PHASE_VARS
        {   Gemm g{(const char*)hb, (const char*)(ws + WS_WFIN), DM, 128, DM, NT, 22, 0}; StaticOrder S; S.init(NT, 22, C.G, C.bid);
            EpiSwiGLU E{ssC, hid}; gemm_phase<EpiSwiGLU, StaticOrder>(C.lds, g, S, E); }
        int opq = 0; asm volatile("" : "+s"(opq));
        if (opq == 0) {   int kple = PLE; asm volatile("" : "+s"(kple));
            Gemm g{(const char*)(ws + WS_PB), (const char*)(ws + WS_WPP), PLE, 128, kple, NT, 4, 0}; StaticOrder S;
            if (C.G == 256) S.init(NT, 4, 128, C.bid >= 128 ? C.bid - 128 : -1); else S.init(NT, 4, C.G, C.bid);
            EpiBf16<0> E{(bf16_t*)(ws + WS_PP), nullptr, nullptr, nullptr}; gemm_phase<EpiBf16<0>, StaticOrder>(C.lds, g, S, E); }
    } SEAM(9);
    if (IN(10)) { PHASE_VARS
        Gemm g{(const char*)hid, (const char*)(ws + WS_WFOUT), FF, 128, FF, NT, 4, 0}; StaticOrder S; S.init(NT, 4, C.G, C.bid);
        EpiResid E{nullptr, 0.5f, hb, ssD}; gemm_phase<EpiResid, StaticOrder>(C.lds, g, S, E);
    } SEAM(10);
    if (IN(11)) { PHASE_VARS
        Gemm g{(const char*)hb, (const char*)(ws + WS_WPG), DM, 128, DM, NT, 4, 0}; StaticOrder S; S.init(NT, 4, C.G, C.bid);
        if (C.G == 256) { EpiPleFinal E{ssD, (const bf16_t*)(ws + WS_PP), hb, a.out, a.in[I_FIN], (unsigned*)(ws + WS_BAR + 32768), (unsigned*)(ws + WS_BAR + 16384)};
            gemm_phase<EpiPleFinal, StaticOrder>(C.lds, g, S, E); }
        else { EpiPle E{ssD, (const bf16_t*)(ws + WS_PP), hb, a.out, ssA}; gemm_phase<EpiPle, StaticOrder>(C.lds, g, S, E); }
    }
    if (C.G != 256) { SEAM(11); if (IN(12)) { PHASE_VARS final_phase(C, a); } }
#undef IN
#undef SEAM
}

extern "C" void kernel_launch(void* const* d_in, const int* in_sizes, int n_in, void* d_out, int out_size, void* d_ws, size_t ws_size, hipStream_t stream) {
    static int grid = 0;
    if (grid == 0) {
        if (n_in != 27 || out_size != T * DM || ws_size < WS_END) { fprintf(stderr, "kernel_launch: unexpected problem (n_in %d, out %d, ws %zu)\n", n_in, out_size, ws_size); grid = -1; return; }
        int dev = 0, cus = 0, per_cu = 0;
        hipGetDevice(&dev); hipDeviceGetAttribute(&cus, hipDeviceAttributeMultiprocessorCount, dev);
        hipFuncSetAttribute((const void*)mk_fwd, hipFuncAttributeMaxDynamicSharedMemorySize, LDS_BYTES);
        hipOccupancyMaxActiveBlocksPerMultiprocessor(&per_cu, (const void*)mk_fwd, 512, LDS_BYTES);
        if (per_cu < 1) { fprintf(stderr, "kernel_launch: occupancy query says %d blocks per CU\n", per_cu); per_cu = 1; }
        (void)hipGetLastError();
        grid = cus * 1;
    }
    if (grid < 0) return;
    Args a{};
    for (int i = 0; i < 27; ++i) a.in[i] = (const float*)d_in[i];
    a.out = (float*)d_out; a.ws = (unsigned char*)d_ws;
#if MK_SINGLE
    hipMemsetAsync((char*)d_ws + WS_BAR, 0, 32768, stream);
    a.ph_lo = 0; a.ph_hi = NPHASE;
    void* args[] = {&a};
    hipError_t e = hipLaunchCooperativeKernel((const void*)mk_fwd, dim3(grid), dim3(512), args, LDS_BYTES, stream);
    if (e != hipSuccess) fprintf(stderr, "cooperative launch failed: %s (grid %d)\n", hipGetErrorString(e), grid);
#else
    for (int k = 0; k < NPHASE; ++k) { a.ph_lo = k; a.ph_hi = k + 1; hipLaunchKernelGGL(mk_fwd, dim3(grid), dim3(512), LDS_BYTES, stream, a); }
#endif
}
```

```cpp
#include <hip/hip_runtime.h>
#include <hip/hip_cooperative_groups.h>
#include <cstdint>
#include <cstdio>
namespace cg = cooperative_groups;

#ifndef MK_SINGLE
#define MK_SINGLE 1
#endif

#define LAS __attribute__((address_space(3)))
typedef unsigned short bf16_t;
typedef short bf16x8 __attribute__((ext_vector_type(8)));
typedef float f32x4 __attribute__((ext_vector_type(4)));
typedef float f32x2 __attribute__((ext_vector_type(2)));
typedef float f32x16 __attribute__((ext_vector_type(16)));
typedef unsigned u32x4 __attribute__((ext_vector_type(4)));
typedef unsigned u32x2 __attribute__((ext_vector_type(2)));

constexpr int T = 16384, SEQ = 4096, DM = 1024, FF = 2816, PLE = 256;
constexpr int N3 = 5888;
constexpr float EPS = 1e-6f;
constexpr float LOG2E = 1.4426950408889634f;
constexpr float QSCALE = 0.125f * LOG2E;
constexpr int NPHASE = 13;

constexpr size_t MiB = 1u << 20;
constexpr size_t WS_SSA = 0, WS_SSB = 1 * MiB, WS_VSTAT = 2 * MiB, WS_ROPE = 4 * MiB, WS_GMW = 4 * MiB + 256 * 1024,
                 WS_KCMP = 4 * MiB + 512 * 1024, WS_VCMPT = 5 * MiB, WS_CBIAS = 5 * MiB + 512 * 1024, WS_GATE = 6 * MiB, WS_SSC = 9 * MiB, WS_SSD = 10 * MiB;
constexpr size_t WS_WIN = 11 * MiB;
constexpr size_t WS_WGB = WS_WIN + (size_t)N3 * 1024 * 2;
constexpr size_t WS_WA = WS_WGB + 2 * MiB, WS_WB = WS_WA + 2 * MiB, WS_WO = WS_WB + 2 * MiB, WS_WPG = WS_WO + 2 * MiB, WS_WPP = WS_WPG + 2 * MiB,
                 WS_WC1 = 33 * MiB;
constexpr size_t WS_WFIN = 35 * MiB, WS_WFOUT = 46 * MiB;
constexpr size_t WS_KC = 35 * MiB, WS_VC = 43 * MiB;
constexpr size_t WS_HID = 52 * MiB;
constexpr size_t WS_QRAW = 52 * MiB, WS_QROT = 84 * MiB, WS_KS = 92 * MiB, WS_KW = 100 * MiB, WS_VST = 108 * MiB, WS_VWT = 116 * MiB,
                 WS_GA = 124 * MiB, WS_UB = 156 * MiB, WS_HB = 188 * MiB, WS_GV = 220 * MiB, WS_CHID = 252 * MiB;
constexpr size_t WS_XB = 140 * MiB, WS_PB = 140 * MiB, WS_PP = 148 * MiB;
constexpr size_t WS_BAR = 51 * MiB + 512 * 1024;
constexpr size_t WS_END = 256 * MiB;
static_assert(WS_WPP + 512 * 1024 <= WS_WC1 && WS_WC1 + 2 * MiB <= WS_WFIN, "weight map");

typedef __bf16 bf16x2_t __attribute__((ext_vector_type(2)));
__device__ __forceinline__ unsigned cvt_pk_bf16(float lo, float hi) { f32x2 v = {lo, hi}; bf16x2_t b = __builtin_convertvector(v, bf16x2_t); return __builtin_bit_cast(unsigned, b); }
__device__ __forceinline__ float bf2f(unsigned short b) { return __uint_as_float((unsigned)b << 16); }
__device__ __forceinline__ float bflo(unsigned w) { return __uint_as_float(w << 16); }
__device__ __forceinline__ float bfhi(unsigned w) { return __uint_as_float(w & 0xffff0000u); }
__device__ __forceinline__ float fsigmoid(float x) { return __builtin_amdgcn_rcpf(1.0f + __builtin_amdgcn_exp2f(-x * LOG2E)); }
__device__ __forceinline__ float fsilu(float x) { return x * fsigmoid(x); }
__device__ __forceinline__ float fgelu(float x) { return x * fsigmoid(1.5957691216057308f * (x + 0.044715f * x * x * x)); }
__device__ __forceinline__ u32x4 pack8(const float (&v)[8]) { u32x4 w; w.x = cvt_pk_bf16(v[0], v[1]); w.y = cvt_pk_bf16(v[2], v[3]); w.z = cvt_pk_bf16(v[4], v[5]); w.w = cvt_pk_bf16(v[6], v[7]); return w; }
__device__ __forceinline__ void unpack8(const u32x4 w, float (&v)[8]) { v[0] = bflo(w.x); v[1] = bfhi(w.x); v[2] = bflo(w.y); v[3] = bfhi(w.y); v[4] = bflo(w.z); v[5] = bfhi(w.z); v[6] = bflo(w.w); v[7] = bfhi(w.w); }
#define LDS_FENCE() asm volatile("s_waitcnt lgkmcnt(0)" ::: "memory")
__device__ __forceinline__ float quad_sum(float v) {
    v += __int_as_float(__builtin_amdgcn_update_dpp(0, __float_as_int(v), 0xB1, 0xF, 0xF, true));
    v += __int_as_float(__builtin_amdgcn_update_dpp(0, __float_as_int(v), 0x4E, 0xF, 0xF, true));
    return v;
}

namespace pg8 {
constexpr int BM = 256, BK = 64, HALF = 128, HTB = HALF * BK * 2, STAGE_BYTES = 8 * HTB, NXCD = 8, WGM = 4;
__host__ __device__ __forceinline__ int lds_byte(int r, int c) { const int st = (r >> 4) * 2 + (c >> 5), rr = r & 15, cc = c & 31, ob = rr * 64 + cc * 2; return st * 1024 + (ob ^ (((ob >> 9) & 1) << 5)); }
__host__ __device__ __forceinline__ void stage_rc(int b, int& R, int& C) { const int st = b / 1024, sb = b % 1024, swz = sb ^ (((sb >> 9) & 1) << 5); R = (st >> 1) * 16 + swz / 64; C = (st & 1) * 32 + (swz % 64) / 2; }
__host__ __device__ __forceinline__ int perm32(int rho) { const int n = rho >> 4, i = rho & 15; return 8 * (i >> 2) + 4 * n + (i & 3); }

struct Unit { int pm, pn; };
struct Gemm { const char* A; const char* Bt; int lda; int kstepA; int K; int nM, nN; int mode; };
__device__ __forceinline__ const char* abase(const Gemm& g, const Unit& u) {
    if (g.mode == 1) { const int pm = u.pm; return g.A + ((size_t)(pm >> 4) * ((size_t)T * 256) + (size_t)((pm & 15) >> 2) * 64 + (size_t)(pm & 3) * 256 * 4096) * 2; }
    return g.A + (size_t)u.pm * ((size_t)BM * g.lda * 2);
}
__device__ __forceinline__ const char* bbase(const Gemm& g, const Unit& u) {
    if (g.mode == 1) return g.Bt + (size_t)(u.pm >> 4) * ((size_t)256 * 2048 * 2);
    return g.Bt + (size_t)u.pn * ((size_t)BM * g.K * 2);
}

struct StaticOrder {
    int nM, nN, nwg, G, c;
    __device__ void init(int nM_, int nN_, int G_, int c_) { nM = nM_; nN = nN_; nwg = nM * nN; G = G_; c = c_; }
    __device__ bool next(int i, Unit& u) const {
        if (c < 0) return false;
        const long L = (long)i * G + c; if (L >= nwg) return false;
        int wgid = (int)L; { const int q = nwg / NXCD, r = nwg % NXCD, xcd = wgid % NXCD, off = wgid / NXCD; wgid = (xcd < r ? xcd * (q + 1) : r * (q + 1) + (xcd - r) * q) + off; }
        const int nig = WGM * nN, gid = wgid / nig, fm = gid * WGM, gsz = (nM - fm) < WGM ? (nM - fm) : WGM;
        u.pm = fm + ((wgid % nig) % gsz); u.pn = (wgid % nig) / gsz; return true;
    }
};

template <class Epi, class Sched, bool ALIGN_EPI = true, bool SP2 = true>
__device__ __forceinline__ void gemm_phase(LAS unsigned char* lds, const Gemm g, const Sched& S, const Epi& E) {
    const int tid = threadIdx.x, wid = __builtin_amdgcn_readfirstlane(tid >> 6), lane = tid & 63, wr = wid >> 2, wc = wid & 3, fr = lane & 15, fq = lane >> 4;
    const int K = g.K, nt = K / BK;
    unsigned voffA[2], voffB[2];
#pragma unroll
    for (int i = 0; i < 2; ++i) { int R, C; stage_rc(tid * 16 + i * 8192, R, C); const int Rb = Epi::PERM ? ((R & ~31) + perm32(R & 31)) : R;
        voffA[i] = (unsigned)(R * g.lda + C) * 2u; voffB[i] = (unsigned)(Rb * K + C) * 2u; }
    const size_t kstepA = (size_t)g.kstepA, kstepB = (size_t)(BK * 2);
    const size_t hstepA = (size_t)HALF * g.lda * 2, hstepB = (size_t)HALF * K * 2;
    const unsigned ldsw = (unsigned)wid * 1024u;
    const int aoff = lds_byte(wr * 64 + fr, fq * 8), boff = lds_byte(wc * 32 + fr, fq * 8);
#define PG8_SA(b, h) (((b) * 2 + (h)) * HTB)
#define PG8_SB(b, h) ((4 + (b) * 2 + (h)) * HTB)
#define PG8_STAGE(bufoff, gbase, voff) do { _Pragma("unroll") for (int _i = 0; _i < 2; ++_i) \
        __builtin_amdgcn_global_load_lds((const unsigned*)((const char*)(gbase) + (voff)[_i]), (LAS unsigned*)(lds + (bufoff) + ldsw + _i * 8192), 16, 0, 0); } while (0)
#define PG8_LDA(dst, b, h) do { _Pragma("unroll") for (int m = 0; m < 4; ++m) _Pragma("unroll") for (int k = 0; k < 2; ++k) dst[m][k] = *(const LAS bf16x8*)(lds + PG8_SA(b, h) + aoff + m * 2048 + k * 1024); } while (0)
#define PG8_LDB(dst, b, h) do { _Pragma("unroll") for (int n = 0; n < 2; ++n) _Pragma("unroll") for (int k = 0; k < 2; ++k) dst[n][k] = *(const LAS bf16x8*)(lds + PG8_SB(b, h) + boff + n * 2048 + k * 1024); } while (0)
#define PG8_MMA(ai, bj, At, Bt) do { __builtin_amdgcn_s_setprio(1); _Pragma("unroll") for (int m = 0; m < 4; ++m) _Pragma("unroll") for (int n = 0; n < 2; ++n) _Pragma("unroll") for (int k = 0; k < 2; ++k) \
        acc[ai][bj][m][n] = __builtin_amdgcn_mfma_f32_16x16x32_bf16(Bt[n][k], At[m][k], acc[ai][bj][m][n], 0, 0, 0); __builtin_amdgcn_s_setprio(0); } while (0)
#define PG8_WAIT_V(n) asm volatile("s_waitcnt vmcnt(" #n ")" ::: "memory")
#define PG8_WAIT_L(n) asm volatile("s_waitcnt lgkmcnt(" #n ")" ::: "memory")
#define PG8_BAR __builtin_amdgcn_s_barrier()
#define PG8_SCHED __builtin_amdgcn_sched_barrier(0)
    Unit cur, nxt; int ui = 0;
    if (!S.next(0, cur)) return;
    f32x4 acc[2][2][4][2];
#pragma unroll
    for (int a = 0; a < 2; ++a)
#pragma unroll
        for (int b = 0; b < 2; ++b)
#pragma unroll
            for (int m = 0; m < 4; ++m)
#pragma unroll
                for (int n = 0; n < 2; ++n) acc[a][b][m][n] = (f32x4){0.f, 0.f, 0.f, 0.f};
    bf16x8 At[4][2], B0[2][2], B1[2][2];
    const char* cA = abase(g, cur); const char* cB = bbase(g, cur);
    if constexpr (SP2) {
        PG8_STAGE(PG8_SB(0, 0), cB, voffB); PG8_STAGE(PG8_SB(0, 1), cB + hstepB, voffB); PG8_STAGE(PG8_SA(0, 0), cA, voffA); PG8_STAGE(PG8_SA(0, 1), cA + hstepA, voffA);
        if (wr == 1) PG8_BAR;
        PG8_WAIT_V(2); PG8_BAR;
        PG8_STAGE(PG8_SB(1, 0), cB + kstepB, voffB); PG8_STAGE(PG8_SA(1, 0), cA + kstepA, voffA); PG8_STAGE(PG8_SB(1, 1), cB + hstepB + kstepB, voffB);
        PG8_WAIT_V(6); PG8_BAR;
    } else {
        PG8_STAGE(PG8_SB(0, 0), cB, voffB); PG8_STAGE(PG8_SA(0, 0), cA, voffA); PG8_STAGE(PG8_SB(0, 1), cB + hstepB, voffB); PG8_STAGE(PG8_SA(0, 1), cA + hstepA, voffA);
        if (wr == 1) PG8_BAR;
        PG8_WAIT_V(4); PG8_BAR;
        PG8_STAGE(PG8_SB(1, 0), cB + kstepB, voffB); PG8_STAGE(PG8_SA(1, 0), cA + kstepA, voffA); PG8_STAGE(PG8_SB(1, 1), cB + hstepB + kstepB, voffB);
        PG8_WAIT_V(6); PG8_BAR;
    }
    for (;;) {
        const bool has_next = S.next(ui + 1, nxt);
        const char* nA = has_next ? abase(g, nxt) : cA; const char* nB = has_next ? bbase(g, nxt) : cB;
        for (int t = 0; t < nt; t += 2) {
            const bool last = (t == nt - 2);
            const char* a1 = cA + (size_t)(t + 1) * kstepA;
            const char* a2 = last ? nA : cA + (size_t)(t + 2) * kstepA; const char* b2 = last ? nB : cB + (size_t)(t + 2) * kstepB;
            const char* a3 = a2 + kstepA; const char* b3 = b2 + kstepB;
            if constexpr (SP2) {
            PG8_LDB(B0, 0, 0); PG8_LDB(B1, 0, 1); PG8_SCHED; PG8_LDA(At, 0, 0); PG8_STAGE(PG8_SA(1, 1), a1 + hstepA, voffA);
            PG8_WAIT_V(8); PG8_WAIT_L(0); PG8_BAR; PG8_MMA(0, 0, At, B0); PG8_MMA(0, 1, At, B1); PG8_BAR; PG8_SCHED;
            PG8_LDA(At, 0, 1); PG8_STAGE(PG8_SB(0, 0), b2, voffB); PG8_STAGE(PG8_SB(0, 1), b2 + hstepB, voffB); PG8_STAGE(PG8_SA(0, 0), a2, voffA);
            PG8_WAIT_V(8); PG8_WAIT_L(0); PG8_BAR; PG8_MMA(1, 0, At, B0); PG8_MMA(1, 1, At, B1); PG8_BAR; PG8_SCHED;
            PG8_LDB(B0, 1, 0); PG8_LDB(B1, 1, 1); PG8_SCHED; PG8_LDA(At, 1, 0); PG8_STAGE(PG8_SA(0, 1), a2 + hstepA, voffA);
            PG8_WAIT_V(8); PG8_WAIT_L(0); PG8_BAR; PG8_MMA(0, 0, At, B0); PG8_MMA(0, 1, At, B1); PG8_BAR; PG8_SCHED;
            PG8_LDA(At, 1, 1); PG8_STAGE(PG8_SB(1, 0), b3, voffB); PG8_STAGE(PG8_SB(1, 1), b3 + hstepB, voffB); PG8_STAGE(PG8_SA(1, 0), a3, voffA);
            PG8_WAIT_V(8); PG8_WAIT_L(0); PG8_BAR; PG8_MMA(1, 0, At, B0); PG8_MMA(1, 1, At, B1); PG8_BAR; PG8_SCHED;
            } else {
            PG8_LDB(B0, 0, 0); PG8_SCHED; PG8_LDA(At, 0, 0); PG8_STAGE(PG8_SA(1, 1), a1 + hstepA, voffA);
            PG8_WAIT_L(8); PG8_BAR; PG8_WAIT_L(0); PG8_MMA(0, 0, At, B0); PG8_BAR; PG8_SCHED;
            PG8_LDB(B1, 0, 1); PG8_STAGE(PG8_SB(0, 0), b2, voffB);
            PG8_BAR; PG8_WAIT_L(0); PG8_MMA(0, 1, At, B1); PG8_BAR;
            PG8_LDA(At, 0, 1); PG8_STAGE(PG8_SA(0, 0), a2, voffA);
            PG8_BAR; PG8_WAIT_L(0); PG8_MMA(1, 0, At, B0); PG8_BAR; PG8_SCHED;
            PG8_STAGE(PG8_SB(0, 1), b2 + hstepB, voffB);
            PG8_WAIT_V(6); PG8_BAR; PG8_MMA(1, 1, At, B1); PG8_BAR;
            PG8_LDB(B0, 1, 0); PG8_SCHED; PG8_LDA(At, 1, 0); PG8_STAGE(PG8_SA(0, 1), a2 + hstepA, voffA);
            PG8_WAIT_L(8); PG8_BAR; PG8_WAIT_L(0); PG8_MMA(0, 0, At, B0); PG8_BAR; PG8_SCHED;
            PG8_LDB(B1, 1, 1); PG8_STAGE(PG8_SB(1, 0), b3, voffB);
            PG8_BAR; PG8_WAIT_L(0); PG8_MMA(0, 1, At, B1); PG8_BAR;
            PG8_LDA(At, 1, 1); PG8_STAGE(PG8_SA(1, 0), a3, voffA);
            PG8_BAR; PG8_WAIT_L(0); PG8_MMA(1, 0, At, B0); PG8_BAR; PG8_SCHED;
            PG8_STAGE(PG8_SB(1, 1), b3 + hstepB, voffB);
            PG8_WAIT_V(6); PG8_BAR; PG8_MMA(1, 1, At, B1); PG8_BAR;
            }
        }
        if constexpr (ALIGN_EPI) { if (wr == 0) PG8_BAR; }
        if constexpr (!Epi::AFTER_DRAIN) E(acc, cur, wr, wc, fr, fq);
        if (!has_next) break;
#pragma unroll
        for (int a = 0; a < 2; ++a)
#pragma unroll
            for (int b = 0; b < 2; ++b)
#pragma unroll
                for (int m = 0; m < 4; ++m)
#pragma unroll
                    for (int n = 0; n < 2; ++n) acc[a][b][m][n] = (f32x4){0.f, 0.f, 0.f, 0.f};
        cur = nxt; cA = nA; cB = nB; ++ui;
        if constexpr (ALIGN_EPI) { if (wr == 1) PG8_BAR; }
    }
    PG8_WAIT_V(0);
    if constexpr (!ALIGN_EPI) { if (wr == 0) PG8_BAR; }
    PG8_BAR;
    if constexpr (Epi::AFTER_DRAIN) E.fused(acc, cur, wr, wc, fr, fq, lds, wid, lane);
#undef PG8_SA
#undef PG8_SB
#undef PG8_STAGE
#undef PG8_LDA
#undef PG8_LDB
#undef PG8_MMA
#undef PG8_WAIT_V
#undef PG8_WAIT_L
#undef PG8_BAR
#undef PG8_SCHED
}

typedef f32x4 Acc[2][2][4][2];
__device__ __forceinline__ void load_rs(const float* ssp, int row0, int fq, float (&rs)[2][4]) {
#pragma unroll
    for (int ai = 0; ai < 2; ++ai)
#pragma unroll
        for (int m = 0; m < 4; ++m) { const f32x4* pp = (const f32x4*)(ssp + (size_t)(row0 + 128 * ai + 16 * m) * 16); const f32x4 p0 = pp[0], p1 = pp[1], p2 = pp[2], p3 = pp[3];
            const float s = (((p0.x + p0.y) + (p0.z + p0.w)) + ((p1.x + p1.y) + (p1.z + p1.w))) + (((p2.x + p2.y) + (p2.z + p2.w)) + ((p3.x + p3.y) + (p3.z + p3.w)));
            rs[ai][m] = rsqrtf(s * (1.0f / 1024.0f) + EPS); asm volatile("" : "+v"(rs[ai][m]) :: "memory"); }
}
#define ACC8(v, ai, bj, m, sc) do { const f32x4 a0_ = acc[ai][bj][m][0], a1_ = acc[ai][bj][m][1]; v[0] = a0_[0] * (sc); v[1] = a0_[1] * (sc); v[2] = a0_[2] * (sc); v[3] = a0_[3] * (sc); \
        v[4] = a1_[0] * (sc); v[5] = a1_[1] * (sc); v[6] = a1_[2] * (sc); v[7] = a1_[3] * (sc); } while (0)

struct EpiSwiGLU { static constexpr bool PERM = true, AFTER_DRAIN = false; const float* ssp; bf16_t* hid;
    __device__ __forceinline__ void operator()(const Acc& acc, const Unit& u, int wr, int wc, int fr, int fq) const {
        const int row0 = u.pm * 256 + wr * 64 + fr; float rs[2][4]; load_rs(ssp, row0, fq, rs);
#pragma unroll
        for (int ai = 0; ai < 2; ++ai)
#pragma unroll
            for (int m = 0; m < 4; ++m) { float gt[8], up[8], o[8]; ACC8(gt, ai, 0, m, rs[ai][m]); ACC8(up, ai, 1, m, rs[ai][m]);
#pragma unroll
                for (int j = 0; j < 8; ++j) o[j] = fsilu(gt[j]) * up[j];
                *(u32x4*)(hid + (size_t)(row0 + 128 * ai + 16 * m) * FF + u.pn * 128 + wc * 32 + fq * 8) = pack8(o); }
    }
};
struct EpiResid { static constexpr bool PERM = true, AFTER_DRAIN = false; const bf16_t* baseb; float coef; bf16_t* hb; float* ssp;
    __device__ __forceinline__ void operator()(const Acc& acc, const Unit& u, int wr, int wc, int fr, int fq) const {
        const int row0 = u.pm * 256 + wr * 64 + fr;
#pragma unroll
        for (int ai = 0; ai < 2; ++ai)
#pragma unroll
            for (int m = 0; m < 4; ++m) { const int row = row0 + 128 * ai + 16 * m; float ss = 0.f;
#pragma unroll
                for (int bj = 0; bj < 2; ++bj) { const size_t off = (size_t)row * DM + u.pn * 256 + bj * 128 + wc * 32 + fq * 8; float v[8], bb[8]; ACC8(v, ai, bj, m, coef);
                    unpack8(*(const u32x4*)(baseb + off), bb);
#pragma unroll
                    for (int j = 0; j < 8; ++j) { v[j] += bb[j]; ss += v[j] * v[j]; }
                    *(u32x4*)(hb + off) = pack8(v); }
                ss += __shfl_xor(ss, 16); ss += __shfl_xor(ss, 32);
                if (fq == 0) ssp[(size_t)row * 16 + u.pn * 4 + wc] = ss; }
    }
};
struct EpiPle { static constexpr bool PERM = true, AFTER_DRAIN = false; const float* ssp_in; const bf16_t* pp; const bf16_t* hb; float* out; float* ssp;
    __device__ __forceinline__ void operator()(const Acc& acc, const Unit& u, int wr, int wc, int fr, int fq) const {
        const int row0 = u.pm * 256 + wr * 64 + fr; float rs[2][4]; load_rs(ssp_in, row0, fq, rs);
#pragma unroll
        for (int ai = 0; ai < 2; ++ai)
#pragma unroll
            for (int m = 0; m < 4; ++m) { const int row = row0 + 128 * ai + 16 * m; float ss = 0.f;
#pragma unroll
                for (int bj = 0; bj < 2; ++bj) { const size_t off = (size_t)row * DM + u.pn * 256 + bj * 128 + wc * 32 + fq * 8; float v[8], pv[8], bb[8]; ACC8(v, ai, bj, m, rs[ai][m]);
                    unpack8(*(const u32x4*)(pp + off), pv); unpack8(*(const u32x4*)(hb + off), bb);
#pragma unroll
                    for (int j = 0; j < 8; ++j) { v[j] = bb[j] + fsigmoid(v[j]) * pv[j]; ss += v[j] * v[j]; }
                    *(f32x4*)(out + off) = (f32x4){v[0], v[1], v[2], v[3]}; *(f32x4*)(out + off + 4) = (f32x4){v[4], v[5], v[6], v[7]}; }
                ss += __shfl_xor(ss, 16); ss += __shfl_xor(ss, 32);
                if (fq == 0) ssp[(size_t)row * 16 + u.pn * 4 + wc] = ss; }
    }
};
struct EpiPleFinal { static constexpr bool PERM = true, AFTER_DRAIN = true; const float* ssp_in; const bf16_t* pp; const bf16_t* hb; float* out; const float* fnorm; unsigned* xbuf; unsigned* cnt;
    __device__ __forceinline__ void operator()(const Acc&, const Unit&, int, int, int, int) const {}
    __device__ __forceinline__ void fused(Acc& acc, const Unit& u, int wr, int wc, int fr, int fq, LAS unsigned char* lds, int wid, int lane) const {
        const int row0 = u.pm * 256 + wr * 64 + fr; float rs[2][4]; load_rs(ssp_in, row0, fq, rs);
        LAS float* P = (LAS float*)lds;
        LAS float* Sr = (LAS float*)(lds + 4096);
        LAS unsigned* flag = (LAS unsigned*)(lds + 4096 + 1024);
#pragma unroll
        for (int ai = 0; ai < 2; ++ai)
#pragma unroll
            for (int m = 0; m < 4; ++m) { const int row = row0 + 128 * ai + 16 * m; float ss = 0.f;
#pragma unroll
                for (int bj = 0; bj < 2; ++bj) { const size_t off = (size_t)row * DM + u.pn * 256 + bj * 128 + wc * 32 + fq * 8; float v[8], pv[8], bb[8]; ACC8(v, ai, bj, m, rs[ai][m]);
                    unpack8(*(const u32x4*)(pp + off), pv); unpack8(*(const u32x4*)(hb + off), bb);
#pragma unroll
                    for (int j = 0; j < 8; ++j) { v[j] = bb[j] + fsigmoid(v[j]) * pv[j]; ss += v[j] * v[j]; }
                    acc[ai][bj][m][0] = (f32x4){v[0], v[1], v[2], v[3]}; acc[ai][bj][m][1] = (f32x4){v[4], v[5], v[6], v[7]}; }
                ss += __shfl_xor(ss, 16); ss += __shfl_xor(ss, 32);
                if (fq == 0) P[(128 * ai + 64 * wr + 16 * m + fr) * 4 + wc] = ss; }
        __syncthreads();
        const int tid = wid * 64 + lane;
        if (tid < 256) { const float sum = (P[tid * 4 + 0] + P[tid * 4 + 1]) + (P[tid * 4 + 2] + P[tid * 4 + 3]);
            __hip_atomic_store(xbuf + ((size_t)u.pm * 256 + tid) * 4 + u.pn, __float_as_uint(sum), __ATOMIC_RELAXED, __HIP_MEMORY_SCOPE_AGENT); }
        asm volatile("s_waitcnt vmcnt(0)" ::: "memory");
        if (lane == 0) __hip_atomic_fetch_add(cnt + 64 * u.pm, 1u, __ATOMIC_RELAXED, __HIP_MEMORY_SCOPE_AGENT);
        if (wid == 0) { unsigned sp = 0;
            while ((unsigned)__builtin_amdgcn_readfirstlane(__hip_atomic_load(cnt + 64 * u.pm, __ATOMIC_RELAXED, __HIP_MEMORY_SCOPE_AGENT)) < 32u) { __builtin_amdgcn_s_sleep(2); if (++sp > (1u << 22)) break; }
            __builtin_amdgcn_fence(__ATOMIC_ACQUIRE, "agent");
            if (lane == 0) flag[0] = 1u; }
        asm volatile("s_waitcnt vmcnt(0) lgkmcnt(0)" ::: "memory");
        __syncthreads();
        if (tid < 256) { const unsigned* slot = xbuf + ((size_t)u.pm * 256 + tid) * 4; float s = 0.f;
#pragma unroll
            for (int t = 0; t < 4; ++t) s += __uint_as_float(__hip_atomic_load(slot + t, __ATOMIC_RELAXED, __HIP_MEMORY_SCOPE_AGENT));
            Sr[tid] = rsqrtf(s * (1.0f / 1024.0f) + EPS); }
        __syncthreads();
#pragma unroll
        for (int ai = 0; ai < 2; ++ai)
#pragma unroll
            for (int m = 0; m < 4; ++m) { const int lrow = 128 * ai + 64 * wr + 16 * m + fr; const float r = Sr[lrow];
#pragma unroll
                for (int bj = 0; bj < 2; ++bj) { const int col = u.pn * 256 + bj * 128 + wc * 32 + fq * 8; const size_t off = (size_t)(u.pm * 256 + lrow) * DM + col;
                    const f32x4 g0 = *(const f32x4*)(fnorm + col), g1 = *(const f32x4*)(fnorm + col + 4); const f32x4 a0 = acc[ai][bj][m][0], a1 = acc[ai][bj][m][1];
                    *(f32x4*)(out + off) = (f32x4){a0[0] * r * g0[0], a0[1] * r * g0[1], a0[2] * r * g0[2], a0[3] * r * g0[3]};
                    *(f32x4*)(out + off + 4) = (f32x4){a1[0] * r * g1[0], a1[1] * r * g1[1], a1[2] * r * g1[2], a1[3] * r * g1[3]}; } }
    }
};
template <int MODE> struct EpiBf16 { static constexpr bool PERM = true, AFTER_DRAIN = false; bf16_t* O; const float* ssp; const bf16_t* mul; const bf16_t* add;
    __device__ __forceinline__ void operator()(const Acc& acc, const Unit& u, int wr, int wc, int fr, int fq) const {
        const int row0 = u.pm * 256 + wr * 64 + fr; float rs[2][4];
        if (MODE == 1 || MODE == 4) load_rs(ssp, row0, fq, rs);
#pragma unroll
        for (int ai = 0; ai < 2; ++ai)
#pragma unroll
            for (int m = 0; m < 4; ++m)
#pragma unroll
                for (int bj = 0; bj < 2; ++bj) { const size_t off = (size_t)(row0 + 128 * ai + 16 * m) * DM + u.pn * 256 + bj * 128 + wc * 32 + fq * 8; float v[8];
                    ACC8(v, ai, bj, m, (MODE == 1 ? rs[ai][m] : 1.0f));
                    if (MODE == 1) {
#pragma unroll
                        for (int j = 0; j < 8; ++j) v[j] = fsigmoid(v[j]); }
                    if (MODE == 2 || MODE == 3) { float mv[8]; unpack8(*(const u32x4*)(mul + off), mv);
#pragma unroll
                        for (int j = 0; j < 8; ++j) v[j] *= mv[j]; }
                    if (MODE == 4) { float mv[8]; unpack8(*(const u32x4*)(mul + off), mv);
#pragma unroll
                        for (int j = 0; j < 8; ++j) v[j] *= fsigmoid(mv[j] * rs[ai][m]); }
                    if (MODE == 3 || MODE == 4) { float av[8]; unpack8(*(const u32x4*)(add + off), av);
#pragma unroll
                        for (int j = 0; j < 8; ++j) v[j] += av[j]; }
                    *(u32x4*)(O + off) = pack8(v); }
    }
};
struct EpiCmp1 { static constexpr bool PERM = true, AFTER_DRAIN = false; bf16_t* chid; const float* bias;
    __device__ __forceinline__ void operator()(const Acc& acc, const Unit& u, int wr, int wc, int fr, int fq) const {
        const int row0 = u.pm * 256 + wr * 64 + fr; const float* bs = bias + (u.pm >> 4) * 256;
#pragma unroll
        for (int bj = 0; bj < 2; ++bj) { const int col = bj * 128 + wc * 32 + fq * 8; const f32x4 b0 = *(const f32x4*)(bs + col), b1 = *(const f32x4*)(bs + col + 4);
            const float bb[8] = {b0[0], b0[1], b0[2], b0[3], b1[0], b1[1], b1[2], b1[3]};
#pragma unroll
            for (int ai = 0; ai < 2; ++ai)
#pragma unroll
                for (int m = 0; m < 4; ++m) { float v[8]; ACC8(v, ai, bj, m, 1.0f);
#pragma unroll
                    for (int j = 0; j < 8; ++j) v[j] = fgelu(v[j] + bb[j]);
                    *(u32x4*)(chid + (size_t)(row0 + 128 * ai + 16 * m) * 256 + col) = pack8(v); } }
    }
};
__device__ __forceinline__ void rope8(float (&v)[8], int fq, const float* cs) {
    const f32x4 c0 = *(const f32x4*)(cs), c1 = *(const f32x4*)(cs + 4), c2 = *(const f32x4*)(cs + 8), c3 = *(const f32x4*)(cs + 12);
    const float cc[8] = {c0[0], c0[2], c1[0], c1[2], c2[0], c2[2], c3[0], c3[2]}, sn[8] = {c0[1], c0[3], c1[1], c1[3], c2[1], c2[3], c3[1], c3[3]};
#pragma unroll
    for (int j = 0; j < 8; ++j) { const float other = __shfl_xor(v[j], 16); v[j] = (fq == 0) ? (v[j] * cc[j] - other * sn[j]) : (v[j] * cc[j] + other * sn[j]); }
}
struct EpiProj { static constexpr bool PERM = true, AFTER_DRAIN = false;
    const float* ssp; const float* rope; bf16_t *ub, *gv, *qraw, *qrot, *kc, *vc, *ks, *kw, *vst, *vwt, *ga; float* vstat; float* gate;
    __device__ __forceinline__ void operator()(const Acc& acc, const Unit& u, int wr, int wc, int fr, int fq) const {
        const int row0 = u.pm * 256 + wr * 64 + fr; float rs[2][4]; load_rs(ssp, row0, fq, rs);
        const int pn = u.pn;
        if (pn < 4) {
#pragma unroll
            for (int ai = 0; ai < 2; ++ai)
#pragma unroll
                for (int m = 0; m < 4; ++m)
#pragma unroll
                    for (int bj = 0; bj < 2; ++bj) { float v[8]; ACC8(v, ai, bj, m, rs[ai][m]);
#pragma unroll
                        for (int j = 0; j < 8; ++j) v[j] = fgelu(v[j]);
                        *(u32x4*)(ub + (size_t)(row0 + 128 * ai + 16 * m) * DM + pn * 256 + bj * 128 + wc * 32 + fq * 8) = pack8(v); }
        } else if (pn >= 18 && pn < 22) {
#pragma unroll
            for (int ai = 0; ai < 2; ++ai)
#pragma unroll
                for (int m = 0; m < 4; ++m)
#pragma unroll
                    for (int bj = 0; bj < 2; ++bj) { float v[8]; ACC8(v, ai, bj, m, rs[ai][m]);
#pragma unroll
                        for (int j = 0; j < 8; ++j) v[j] = fsigmoid(v[j]);
                        *(u32x4*)(ga + (size_t)(row0 + 128 * ai + 16 * m) * DM + (pn - 18) * 256 + bj * 128 + wc * 32 + fq * 8) = pack8(v); }
        } else if (pn < 8) {
#pragma unroll
            for (int ai = 0; ai < 2; ++ai)
#pragma unroll
                for (int m = 0; m < 4; ++m) { const int row = row0 + 128 * ai + 16 * m; float s1 = 0.f, s2 = 0.f;
#pragma unroll
                    for (int bj = 0; bj < 2; ++bj) { float v[8]; ACC8(v, ai, bj, m, rs[ai][m]);
#pragma unroll
                        for (int j = 0; j < 8; ++j) { v[j] = fgelu(v[j]); s1 += v[j]; s2 += v[j] * v[j]; }
                        *(u32x4*)(gv + (size_t)row * DM + (pn - 4) * 256 + bj * 128 + wc * 32 + fq * 8) = pack8(v); }
                    s1 += __shfl_xor(s1, 16); s1 += __shfl_xor(s1, 32); s2 += __shfl_xor(s2, 16); s2 += __shfl_xor(s2, 32);
                    if (fq == 0) *(f32x2*)(vstat + ((size_t)row * 16 + (pn - 4) * 4 + wc) * 2) = (f32x2){s1, s2}; }
        } else if (pn < 12) {
#pragma unroll
            for (int ai = 0; ai < 2; ++ai)
#pragma unroll
                for (int m = 0; m < 4; ++m) { const int row = row0 + 128 * ai + 16 * m;
#pragma unroll
                    for (int bj = 0; bj < 2; ++bj) { float v[8]; ACC8(v, ai, bj, m, rs[ai][m] * QSCALE);
                        *(u32x4*)(qraw + (size_t)row * DM + (pn - 8) * 256 + bj * 128 + wc * 32 + fq * 8) = pack8(v);
                        if ((wc & 1) == 0) { rope8(v, fq, rope + (size_t)(row & (SEQ - 1)) * 16);
                            const int head = (pn - 8) * 4 + bj * 2 + (wc >> 1);
                            if (fq < 2) *(u32x4*)(qrot + ((size_t)row * 16 + head) * 16 + fq * 8) = pack8(v); } } }
        } else if (pn == 12 || pn == 13 || pn == 14 || pn == 16) {
            bf16_t* O = pn == 12 ? kc : pn == 13 ? vc : pn == 14 ? ks : kw; const bool rot = pn >= 14;
#pragma unroll
            for (int ai = 0; ai < 2; ++ai)
#pragma unroll
                for (int m = 0; m < 4; ++m) { const int row = row0 + 128 * ai + 16 * m;
#pragma unroll
                    for (int bj = 0; bj < 2; ++bj) { float v[8]; ACC8(v, ai, bj, m, rs[ai][m]);
                        if (rot && (wc & 1) == 0) { float w[8];
#pragma unroll
                            for (int j = 0; j < 8; ++j) w[j] = v[j];
                            rope8(w, fq, rope + (size_t)(row & (SEQ - 1)) * 16);
                            if (fq < 2) {
#pragma unroll
                                for (int j = 0; j < 8; ++j) v[j] = w[j]; } }
                        *(u32x4*)(O + (size_t)row * 256 + bj * 128 + wc * 32 + fq * 8) = pack8(v); } }
        } else if (pn == 15 || pn == 17) {
            bf16_t* O = pn == 15 ? vst : vwt;
#pragma unroll
            for (int ai = 0; ai < 2; ++ai)
#pragma unroll
                for (int m = 0; m < 4; ++m) { const int row = row0 + 128 * ai + 16 * m; const int b = row >> 12, t = row & (SEQ - 1);
#pragma unroll
                    for (int bj = 0; bj < 2; ++bj) { float v[8]; ACC8(v, ai, bj, m, rs[ai][m]); const int kvh = bj * 2 + (wc >> 1), d0 = (wc & 1) * 32 + fq * 8;
                        bf16_t* p = O + ((size_t)(b * 4 + kvh) * 64 + d0) * SEQ + t;
#pragma unroll
                        for (int j = 0; j < 8; j += 2) { const unsigned w = cvt_pk_bf16(v[j], v[j + 1]); p[(size_t)j * SEQ] = (bf16_t)(w & 0xffffu); p[(size_t)(j + 1) * SEQ] = (bf16_t)(w >> 16); } } }
        } else {
            if (wc < 2) {
#pragma unroll
                for (int ai = 0; ai < 2; ++ai)
#pragma unroll
                    for (int m = 0; m < 4; ++m) { const int row = row0 + 128 * ai + 16 * m; float v[8]; ACC8(v, ai, 0, m, rs[ai][m]); const int col = wc * 32 + fq * 8;
                        if (col < 48) {
#pragma unroll
                            for (int j = 0; j < 8; ++j) v[j] = fsigmoid(v[j]);
                            *(f32x4*)(gate + (size_t)row * 48 + col) = (f32x4){v[0], v[1], v[2], v[3]}; *(f32x4*)(gate + (size_t)row * 48 + col + 4) = (f32x4){v[4], v[5], v[6], v[7]}; } }
            }
        }
    }
};
}

struct Ctx { LAS unsigned char* lds; int tid, lane, wave, G, bid; };

__device__ __forceinline__ float wave_sum(float v) {
#pragma unroll
    for (int o = 1; o < 64; o <<= 1) v += __shfl_xor(v, o);
    return v;
}
__device__ __forceinline__ int map_row(int map, int n) {
    if (map == 1) { const int up = n >= FF ? 1 : 0, j = n - up * FF; return (j >> 7) * 256 + up * 128 + (j & 127); }
    if (map == 2) { if (n < 4608) return n; if (n < 4656) return 5632 + (n - 4608); if (n < 5680) return 4608 + (n - 4656); return N3 + (n - 5680); }
    return n;
}
constexpr int TR_SCR = 17408;
__device__ __forceinline__ void transpose_item(const float* W, int K, int N, bf16_t* WT, const float* ks, int map, LAS float* scr, int item, int lane) {
    const int nblk = (N + 63) / 64, kb = item / nblk, nb = item % nblk, k0 = 64 * kb, n0 = 64 * nb;
    const int n4 = (lane & 15) * 4, r0 = lane >> 4;
    f32x4 v[16];
#pragma unroll
    for (int i = 0; i < 16; ++i) { const int kk = r0 + 4 * i; v[i] = (f32x4){0.f, 0.f, 0.f, 0.f}; if (n0 + n4 < N) v[i] = *(const f32x4*)(W + (size_t)(k0 + kk) * N + n0 + n4); }
#pragma unroll
    for (int i = 0; i < 16; ++i) { const int kk = r0 + 4 * i; const float sc = ks ? ks[k0 + kk] : 1.0f; LAS float* d = scr + kk * 65 + n4;
        d[0] = v[i].x * sc; d[1] = v[i].y * sc; d[2] = v[i].z * sc; d[3] = v[i].w * sc; }
    LDS_FENCE();
    const int c = lane >> 3, nl = lane & 7;
#pragma unroll
    for (int j = 0; j < 8; ++j) { const int nn = nl + 8 * j, n = n0 + nn;
        if (n < N) { const LAS float* s0 = scr + (8 * c) * 65 + nn;
            u32x4 o; o.x = cvt_pk_bf16(s0[0 * 65], s0[1 * 65]); o.y = cvt_pk_bf16(s0[2 * 65], s0[3 * 65]); o.z = cvt_pk_bf16(s0[4 * 65], s0[5 * 65]); o.w = cvt_pk_bf16(s0[6 * 65], s0[7 * 65]);
            *(u32x4*)(WT + (size_t)map_row(map, n) * K + k0 + 8 * c) = o; } }
    LDS_FENCE();
}
struct TJob { const float* W; int K, N; bf16_t* dst; const float* ks; int map; };
__device__ __forceinline__ int tjob_items(const TJob& j) { return (j.K / 64) * ((j.N + 63) / 64); }

struct Args {
    const float* in[27]; float* out; unsigned char* ws; int ph_lo, ph_hi;
};
enum { I_X = 0, I_P, I_F1N, I_F1WI, I_F1WO, I_MIXN, I_WIN, I_LNG, I_LNB, I_GWS, I_GBS, I_WA, I_CPK, I_CKW1, I_CKW2, I_CPV, I_CVW1, I_CVW2, I_WB, I_WO,
       I_F2N, I_F2WI, I_F2WO, I_PLEN, I_PLEG, I_PLEP, I_FIN };

__device__ __forceinline__ void run_tjobs(const Ctx& C, const TJob* jobs, int njobs) {
    LAS float* scr = (LAS float*)(C.lds + C.wave * TR_SCR);
    const int gw = C.bid * 8 + C.wave, NGW = C.G * 8;
    int total = 0;
    for (int j = 0; j < njobs; ++j) total += tjob_items(jobs[j]);
    for (int it = gw; it < total; it += NGW) { int r = it;
        for (int j = 0; j < njobs; ++j) { const int n = tjob_items(jobs[j]); if (r < n) { transpose_item(jobs[j].W, jobs[j].K, jobs[j].N, jobs[j].dst, jobs[j].ks, jobs[j].map, scr, r, C.lane); break; } r -= n; } }
}

__device__ __forceinline__ void p0_prologue(const Ctx& C, const Args& a) {
    unsigned char* ws = a.ws;
    {
        const int gw = C.bid * 8 + C.wave, NGW = C.G * 8;
        LAS float* scr = (LAS float*)(C.lds + C.wave * TR_SCR);
        for (int it = gw; it < 5136; it += NGW) { int r = it;
            if (r < 1408) { transpose_item(a.in[I_F1WI], 1024, 5632, (bf16_t*)(ws + WS_WFIN), a.in[I_F1N], 1, scr, r, C.lane); continue; } r -= 1408;
            if (r < 704) { transpose_item(a.in[I_F1WO], 2816, 1024, (bf16_t*)(ws + WS_WFOUT), nullptr, 0, scr, r, C.lane); continue; } r -= 704;
            if (r < 1680) { transpose_item(a.in[I_WIN], 1024, 6704, (bf16_t*)(ws + WS_WIN), a.in[I_MIXN], 2, scr, r, C.lane); continue; } r -= 1680;
            if (r < 256) { transpose_item(a.in[I_WA], 1024, 1024, (bf16_t*)(ws + WS_WA), nullptr, 0, scr, r, C.lane); continue; } r -= 256;
            if (r < 256) { transpose_item(a.in[I_WB], 1024, 1024, (bf16_t*)(ws + WS_WB), nullptr, 0, scr, r, C.lane); continue; } r -= 256;
            if (r < 256) { transpose_item(a.in[I_WO], 1024, 1024, (bf16_t*)(ws + WS_WO), nullptr, 0, scr, r, C.lane); continue; } r -= 256;
            if (r < 256) { transpose_item(a.in[I_PLEG], 1024, 1024, (bf16_t*)(ws + WS_WPG), a.in[I_PLEN], 0, scr, r, C.lane); continue; } r -= 256;
            if (r < 64) { transpose_item(a.in[I_PLEP], 256, 1024, (bf16_t*)(ws + WS_WPP), nullptr, 0, scr, r, C.lane); continue; } r -= 64;
            if (r < 128) { transpose_item(a.in[I_CKW1], 2048, 256, (bf16_t*)(ws + WS_WC1), nullptr, 0, scr, r, C.lane); continue; } r -= 128;
            transpose_item(a.in[I_CVW1], 2048, 256, (bf16_t*)(ws + WS_WC1) + 256 * 2048, nullptr, 0, scr, r, C.lane);
        }
        const float* x = a.in[I_X]; bf16_t* xb = (bf16_t*)(ws + WS_XB); float* ssa = (float*)(ws + WS_SSA);
        for (int r = gw; r < T; r += NGW) { const f32x4* xr = (const f32x4*)(x + (size_t)r * DM) + C.lane; float s = 0.f; f32x4 v[4];
#pragma unroll
            for (int j = 0; j < 4; ++j) { v[j] = xr[64 * j]; s += (v[j].x * v[j].x + v[j].y * v[j].y) + (v[j].z * v[j].z + v[j].w * v[j].w); }
            s = wave_sum(s);
            u32x2* o = (u32x2*)(xb + (size_t)r * DM) + C.lane;
#pragma unroll
            for (int j = 0; j < 4; ++j) o[64 * j] = (u32x2){cvt_pk_bf16(v[j].x, v[j].y), cvt_pk_bf16(v[j].z, v[j].w)};
            if (C.lane < 16) ssa[(size_t)r * 16 + C.lane] = C.lane == 0 ? s : 0.f; }
        float* cb = (float*)(ws + WS_CBIAS);
        for (int it = gw; it < 64; it += NGW) { const int tsr = it >> 5, n0 = (it & 31) * 8; const float* pos = a.in[tsr ? I_CPV : I_CPK]; const float* w1 = a.in[tsr ? I_CVW1 : I_CKW1];
            float acc8[8] = {0.f, 0.f, 0.f, 0.f, 0.f, 0.f, 0.f, 0.f};
            for (int i = 0; i < 32; ++i) { const int k = C.lane + 64 * i; const float pk = pos[k]; const f32x4 w0 = *(const f32x4*)(w1 + (size_t)k * 256 + n0), w4 = *(const f32x4*)(w1 + (size_t)k * 256 + n0 + 4);
                acc8[0] += pk * w0[0]; acc8[1] += pk * w0[1]; acc8[2] += pk * w0[2]; acc8[3] += pk * w0[3]; acc8[4] += pk * w4[0]; acc8[5] += pk * w4[1]; acc8[6] += pk * w4[2]; acc8[7] += pk * w4[3]; }
#pragma unroll
            for (int j = 0; j < 8; ++j) { const float s = wave_sum(acc8[j]); if (C.lane == 0) cb[tsr * 256 + n0 + j] = s; } }
    }
    const int gt = C.bid * 512 + C.tid, NGT = C.G * 512;
    {
        float* rope = (float*)(ws + WS_ROPE);
        for (int e = gt; e < SEQ * 8; e += NGT) { const int t = e >> 3, i = e & 7;
            const float invf = i == 0 ? 1.0f : i == 1 ? 0.1939227432012558f : i == 2 ? 0.03760603070259094f : i == 3 ? 0.007292664609849453f : i == 4 ? 0.0014142135623842478f : i == 5 ? 0.00027424818836152554f : i == 6 ? 5.318296098266728e-05f : 1.0313386155758053e-05f;
            const float angf = (float)t * invf; const double ang = (double)angf;
            const double qd = __builtin_rint(ang * 0.63661977236758134308); const double r = (ang - qd * 1.5707963267948966192) - qd * 6.123233995736766e-17; const int qi = ((int)qd) & 3;
            const double r2 = r * r;
            const double sr = r * (1.0 + r2 * (-1.0 / 6 + r2 * (1.0 / 120 + r2 * (-1.0 / 5040 + r2 * (1.0 / 362880 + r2 * (-1.0 / 39916800 + r2 * (1.0 / 6227020800.0)))))));
            const double cr = 1.0 + r2 * (-0.5 + r2 * (1.0 / 24 + r2 * (-1.0 / 720 + r2 * (1.0 / 40320 + r2 * (-1.0 / 3628800 + r2 * (1.0 / 479001600.0 + r2 * (-1.0 / 87178291200.0)))))));
            const double sn = qi == 0 ? sr : qi == 1 ? cr : qi == 2 ? -sr : -cr, cs = qi == 0 ? cr : qi == 1 ? -sr : qi == 2 ? -cr : sr;
            rope[e * 2] = (float)cs; rope[e * 2 + 1] = (float)sn; }
    }
    {
        const float* w = a.in[I_GWS]; bf16_t* o = (bf16_t*)(ws + WS_GMW);
        for (int e = gt; e < 8 * 128 * 128; e += NGT) { const int t = (e >> 7) & 127, s = e & 127; const float v = s <= t ? w[e] : 0.f; o[e] = (bf16_t)(cvt_pk_bf16(v, 0.f) & 0xffffu); }
    }
}

__device__ __forceinline__ void p8_extras(const Ctx& C, const Args& a) {
    unsigned char* ws = a.ws; const int gw = C.bid * 8 + C.wave, NGW = C.G * 8;
    LAS float* scr = (LAS float*)(C.lds + C.wave * TR_SCR);
    for (int it = gw; it < 2112; it += NGW) { int r = it;
        if (r < 1408) { transpose_item(a.in[I_F2WI], 1024, 5632, (bf16_t*)(ws + WS_WFIN), a.in[I_F2N], 1, scr, r, C.lane); continue; } r -= 1408;
        transpose_item(a.in[I_F2WO], 2816, 1024, (bf16_t*)(ws + WS_WFOUT), nullptr, 0, scr, r, C.lane); }
    const float* p = a.in[I_P]; bf16_t* pb = (bf16_t*)(ws + WS_PB);
    for (int r = gw; r < T; r += NGW) { const f32x4 v = ((const f32x4*)(p + (size_t)r * PLE))[C.lane]; ((u32x2*)(pb + (size_t)r * PLE))[C.lane] = (u32x2){cvt_pk_bf16(v.x, v.y), cvt_pk_bf16(v.z, v.w)}; }
}

__device__ __forceinline__ void gmlp_job(const Ctx& C, const Args& a, int job) {
    unsigned char* ws = a.ws; const int g = job & 7, chunk = job >> 3; const int tok0 = chunk * 128;
    const bf16_t* gv = (const bf16_t*)(ws + WS_GV); bf16_t* ub = (bf16_t*)(ws + WS_UB); const float* vstat = (const float*)(ws + WS_VSTAT); const bf16_t* gmw = (const bf16_t*)(ws + WS_GMW);
    LAS bf16_t* vnT = (LAS bf16_t*)C.lds;
    const int wr = C.wave >> 1, wc = C.wave & 1, n = C.lane & 31, hi = C.lane >> 5;
    bf16x8 af[8];
    {   const bf16_t* wrow = gmw + ((size_t)g * 128 + wr * 32 + n) * 128 + 8 * hi;
#pragma unroll
        for (int k0 = 0; k0 < 8; ++k0) af[k0] = *(const bf16x8*)(wrow + 16 * k0); }
    {   const int s = C.tid >> 2, cq = C.tid & 3; const size_t row = (size_t)tok0 + s;
        float s1 = 0.f, s2 = 0.f;
#pragma unroll
        for (int k = 0; k < 8; ++k) { const f32x4 p = *(const f32x4*)(vstat + row * 32 + 4 * k); s1 += p.x + p.z; s2 += p.y + p.w; }
        const float mean = s1 * (1.0f / 1024.0f), var = s2 * (1.0f / 1024.0f) - mean * mean, rstd = rsqrtf(var + EPS);
        const float* lng = a.in[I_LNG] + g * 128 + cq * 32; const float* lnb = a.in[I_LNB] + g * 128 + cq * 32;
#pragma unroll
        for (int c8 = 0; c8 < 4; ++c8) { float v[8]; unpack8(*(const u32x4*)(gv + row * DM + g * 128 + cq * 32 + c8 * 8), v);
#pragma unroll
            for (int j = 0; j < 8; ++j) { const float y = (v[j] - mean) * rstd * lng[c8 * 8 + j] + lnb[c8 * 8 + j]; vnT[(cq * 32 + c8 * 8 + j) * 136 + s] = (bf16_t)(cvt_pk_bf16(y, 0.f) & 0xffffu); } }
    }
    __syncthreads();
    {   f32x16 acc0 = {}, acc1 = {};
        const LAS bf16_t* b0p = vnT + (wc * 64 + n) * 136 + 8 * hi; const LAS bf16_t* b1p = b0p + 32 * 136;
#pragma unroll
        for (int k0 = 0; k0 < 8; ++k0) if (k0 < 2 * (wr + 1)) { const bf16x8 bf0 = *(const LAS bf16x8*)(b0p + 16 * k0), bf1 = *(const LAS bf16x8*)(b1p + 16 * k0);
            acc0 = __builtin_amdgcn_mfma_f32_32x32x16_bf16(af[k0], bf0, acc0, 0, 0, 0); acc1 = __builtin_amdgcn_mfma_f32_32x32x16_bf16(af[k0], bf1, acc1, 0, 0, 0); }
        const float* bs = a.in[I_GBS] + g * 128 + wr * 32;
#pragma unroll
        for (int r = 0; r < 16; ++r) { const int tl = (r & 3) + 8 * (r >> 2) + 4 * hi; const float bias = bs[tl]; const size_t off = ((size_t)tok0 + wr * 32 + tl) * DM + g * 128 + wc * 64 + n;
            const float u0 = bf2f(ub[off]), u1 = bf2f(ub[off + 32]);
            ub[off] = (bf16_t)(cvt_pk_bf16(u0 * (acc0[r] + bias), 0.f) & 0xffffu); ub[off + 32] = (bf16_t)(cvt_pk_bf16(u1 * (acc1[r] + bias), 0.f) & 0xffffu); }
    }
    __syncthreads();
}

__device__ __forceinline__ void cmp2_phase(const Ctx& C, const Args& a) {
    unsigned char* ws = a.ws; const bf16_t* chid = (const bf16_t*)(ws + WS_CHID); bf16_t* kcmp = (bf16_t*)(ws + WS_KCMP); bf16_t* vcmpT = (bf16_t*)(ws + WS_VCMPT);
    const int gw = C.bid * 8 + C.wave, NGW = C.G * 8;
    for (int it = gw; it < 2048; it += NGW) { const int tsr = it >> 10, R0 = (it & 1023) * 4;
        const float* w2 = a.in[tsr ? I_CVW2 : I_CKW2]; const bf16_t* hr = chid + ((size_t)tsr * 4096 + R0) * 256;
        float acc[4] = {0.f, 0.f, 0.f, 0.f};
        for (int k8 = 0; k8 < 32; ++k8) { float wv[8];
#pragma unroll
            for (int j = 0; j < 8; ++j) wv[j] = w2[(k8 * 8 + j) * 64 + C.lane];
#pragma unroll
            for (int rr = 0; rr < 4; ++rr) { float hv[8]; unpack8(*(const u32x4*)(hr + rr * 256 + k8 * 8), hv);
#pragma unroll
                for (int j = 0; j < 8; ++j) acc[rr] += hv[j] * wv[j]; } }
#pragma unroll
        for (int rr = 0; rr < 4; ++rr) { const int R = R0 + rr; const int h = R >> 10, b = (R >> 8) & 3, i = R & 255;
            const bf16_t o = (bf16_t)(cvt_pk_bf16(i == 255 ? 0.f : acc[rr], 0.f) & 0xffffu);
            if (tsr == 0) kcmp[((size_t)(b * 4 + h) * 256 + i) * 64 + C.lane] = o; else vcmpT[((size_t)(b * 4 + h) * 64 + C.lane) * 256 + i] = o; } }
}

__device__ __forceinline__ void final_phase(const Ctx& C, const Args& a) {
    const float* ssa = (const float*)(a.ws + WS_SSA); const float* fn = a.in[I_FIN]; const int gw = C.bid * 8 + C.wave, NGW = C.G * 8;
    for (int r = gw; r < T; r += NGW) { float s = C.lane < 16 ? ssa[(size_t)r * 16 + C.lane] : 0.f; s = wave_sum(s); const float rstd = rsqrtf(s * (1.0f / 1024.0f) + EPS);
        f32x4* o = (f32x4*)(a.out + (size_t)r * DM) + C.lane; const f32x4* gp = (const f32x4*)fn + C.lane;
#pragma unroll
        for (int j = 0; j < 4; ++j) { const f32x4 v = o[64 * j], gg = gp[64 * j]; o[64 * j] = (f32x4){v.x * rstd * gg.x, v.y * rstd * gg.y, v.z * rstd * gg.z, v.w * rstd * gg.w}; } }
}

namespace att {
constexpr int ROWB = 144;
constexpr int TILEB = 64 * ROWB;
constexpr int OFF_K = 0, OFF_V = 2 * TILEB, OFF_PC = 4 * TILEB, PCROW = 260, OFF_WSF = OFF_PC + 64 * PCROW * 4, OFF_SELM = OFF_WSF + 8 * 64 * 4, LDS_END = OFF_SELM + 64 * 8;
static_assert(LDS_END <= 131072, "attention LDS");
__device__ __forceinline__ int crow(int r, int hi) { return (r & 3) + 8 * (r >> 2) + 4 * hi; }

struct Stream { const bf16_t* K; size_t kstride; const bf16_t* V; size_t vstride; };

struct State { float m, l; f32x16 o0, o1; };

struct Pre { u32x4 k0, v0, k1; };
__device__ __forceinline__ Pre prefetch(int tid, const Stream& S, int t0, int nt, bool needv) {
    const int lr = tid >> 3, lc = tid & 7; Pre p;
    const bf16_t* kg = S.K + (size_t)(t0 * 64 + lr) * S.kstride + lc * 8;
    p.k0 = *(const u32x4*)kg; p.v0 = (u32x4){0u, 0u, 0u, 0u}; p.k1 = p.v0;
    if (needv) p.v0 = *(const u32x4*)(S.V + (size_t)lr * S.vstride + (size_t)t0 * 64 + lc * 8);
    if (nt > 1) p.k1 = *(const u32x4*)(kg + (size_t)64 * S.kstride);
    return p;
}
template <int MODE>
__device__ __forceinline__ void run_branch(int tid, LAS unsigned char* lds, const Stream& S, const Pre& pre, int t0, int nt, const bf16x8 (&qf)[4], int klo, int khi, unsigned long long selbits,
                                           State& st, float inv_l, int tokl, int g) {
    const int lane = tid & 63, q = lane & 31, hi = lane >> 5, wid = __builtin_amdgcn_readfirstlane(tid >> 6);
    const int lr = tid >> 3, lc = tid & 7;
    const int pim = 16 * (q >> 4) + 8 * ((q >> 2) & 1) + 4 * ((q >> 3) & 1) + (q & 3);
    LAS float* wsf = (LAS float*)(lds + OFF_WSF) + wid * 64;
    LAS float* pc = (LAS float*)(lds + OFF_PC);
    const bf16_t* kg = S.K + (size_t)(t0 * 64 + lr) * S.kstride + lc * 8;
    const bf16_t* vg = S.V + (size_t)lr * S.vstride + (size_t)t0 * 64 + lc * 8;
    const unsigned sto = lr * ROWB + lc * 16;
    u32x4 kreg = pre.k1, vreg = pre.v0;
    *(LAS u32x4*)(lds + OFF_K + sto) = pre.k0; if (MODE != 1) *(LAS u32x4*)(lds + OFF_V + sto) = pre.v0;
    if (nt > 1) *(LAS u32x4*)(lds + OFF_K + TILEB + sto) = pre.k1;
    __syncthreads();
    const LAS unsigned char* kfb = lds + OFF_K + pim * ROWB + hi * 16;
    f32x16 p0 = {}, p1 = {};
#pragma unroll
    for (int d0 = 0; d0 < 4; ++d0) { const bf16x8 a0 = *(const LAS bf16x8*)(kfb + d0 * 32), a1 = *(const LAS bf16x8*)(kfb + 32 * ROWB + d0 * 32);
        p0 = __builtin_amdgcn_mfma_f32_32x32x16_bf16(a0, qf[d0], p0, 0, 0, 0); p1 = __builtin_amdgcn_mfma_f32_32x32x16_bf16(a1, qf[d0], p1, 0, 0, 0); }
    f32x16 q0 = {}, q1 = {};
    for (int t = 0; t < nt; t += 2) {
        {   const int jt = t0 + t; constexpr int buf = 0;
        if (t + 2 < nt) kreg = *(const u32x4*)(kg + (size_t)(t + 2) * 64 * S.kstride);
        if (MODE != 1 && t + 1 < nt) vreg = *(const u32x4*)(vg + (size_t)(t + 1) * 64);
        const int kb0 = jt * 64;
        const bool bit = (selbits >> jt) & 1ull;
        const bool none = !bit || kb0 > khi || kb0 + 63 < klo;
        const bool allv = bit && kb0 >= klo && kb0 + 63 <= khi;
        const bool colv = !none;
        if (__any(colv && !allv)) {
            const int hr = khi - kb0 - 8 * hi, lrr = klo - kb0 - 8 * hi;
#pragma unroll
            for (int r = 0; r < 16; ++r) { const int c = 16 * (r >> 3) + (r & 7);
                if (!(c <= hr && c >= lrr)) p0[r] = -__builtin_inff();
                if (!(c + 32 <= hr && c + 32 >= lrr)) p1[r] = -__builtin_inff(); }
        }
        float tm = fmaxf(fmaxf(p0[0], p0[1]), p0[2]);
#pragma unroll
        for (int r = 3; r < 15; r += 2) tm = fmaxf(fmaxf(tm, p0[r]), p0[r + 1]);
        tm = fmaxf(tm, p0[15]);
#pragma unroll
        for (int r = 0; r < 16; r += 2) tm = fmaxf(fmaxf(tm, p1[r]), p1[r + 1]);
        tm = fmaxf(tm, __shfl_xor(tm, 32));
        if (!colv) tm = -__builtin_inff();
        float mref;
        if (MODE == 2) { mref = st.m; }
        else {
            if (__any(tm > st.m + 8.0f)) {
                const float mn = fmaxf(st.m, tm); const float alpha = __builtin_amdgcn_exp2f(st.m - mn); st.l *= alpha; st.m = mn;
                if (MODE == 0) { if (hi == 0) wsf[q] = alpha; LDS_FENCE();
#pragma unroll
                    for (int r = 0; r < 16; ++r) { const float f = wsf[crow(r, hi)]; st.o0[r] *= f; st.o1[r] *= f; }
                    LDS_FENCE(); }
            }
            mref = st.m;
        }
        const float msub = colv ? mref : __builtin_inff();
        q0 = (f32x16){}; q1 = (f32x16){};
        {   const LAS unsigned char* kb = kfb + (buf ^ 1) * TILEB;
#pragma unroll
            for (int d0 = 0; d0 < 4; ++d0) { const bf16x8 a0 = *(const LAS bf16x8*)(kb + d0 * 32), a1 = *(const LAS bf16x8*)(kb + 32 * ROWB + d0 * 32);
                q0 = __builtin_amdgcn_mfma_f32_32x32x16_bf16(a0, qf[d0], q0, 0, 0, 0); q1 = __builtin_amdgcn_mfma_f32_32x32x16_bf16(a1, qf[d0], q1, 0, 0, 0); } }
        float ls = 0.f;
#pragma unroll
        for (int r = 0; r < 16; ++r) { p0[r] = __builtin_amdgcn_exp2f(p0[r] - msub); p1[r] = __builtin_amdgcn_exp2f(p1[r] - msub); ls += p0[r] + p1[r]; }
        if (MODE != 2) st.l += ls;
        if (MODE == 2) {
#pragma unroll
            for (int r = 0; r < 16; ++r) { p0[r] *= inv_l; p1[r] *= inv_l; }
            float hs0[16], hs1[16];
#pragma unroll
            for (int r = 0; r < 16; ++r) { hs0[r] = quad_sum(p0[r]); hs1[r] = quad_sum(p1[r]); }
            if (g == 0) { LAS float* pr = pc + tokl * PCROW + kb0 + 8 * hi;
#pragma unroll
                for (int r = 0; r < 16; ++r) { pr[16 * (r >> 3) + (r & 7)] = hs0[r]; pr[16 * (r >> 3) + (r & 7) + 32] = hs1[r]; } }
        }
        if (MODE != 1) {
            bf16x8 pa[4];
            {   u32x4 w;
                w.x = cvt_pk_bf16(p0[0], p0[1]); w.y = cvt_pk_bf16(p0[2], p0[3]); w.z = cvt_pk_bf16(p0[4], p0[5]); w.w = cvt_pk_bf16(p0[6], p0[7]); pa[0] = __builtin_bit_cast(bf16x8, w);
                w.x = cvt_pk_bf16(p0[8], p0[9]); w.y = cvt_pk_bf16(p0[10], p0[11]); w.z = cvt_pk_bf16(p0[12], p0[13]); w.w = cvt_pk_bf16(p0[14], p0[15]); pa[1] = __builtin_bit_cast(bf16x8, w);
                w.x = cvt_pk_bf16(p1[0], p1[1]); w.y = cvt_pk_bf16(p1[2], p1[3]); w.z = cvt_pk_bf16(p1[4], p1[5]); w.w = cvt_pk_bf16(p1[6], p1[7]); pa[2] = __builtin_bit_cast(bf16x8, w);
                w.x = cvt_pk_bf16(p1[8], p1[9]); w.y = cvt_pk_bf16(p1[10], p1[11]); w.z = cvt_pk_bf16(p1[12], p1[13]); w.w = cvt_pk_bf16(p1[14], p1[15]); pa[3] = __builtin_bit_cast(bf16x8, w); }
            const LAS unsigned char* vb = lds + OFF_V + buf * TILEB + q * ROWB + hi * 16;
#pragma unroll
            for (int c = 0; c < 4; ++c) { const bf16x8 v0 = *(const LAS bf16x8*)(vb + c * 32), v1 = *(const LAS bf16x8*)(vb + 32 * ROWB + c * 32);
                st.o0 = __builtin_amdgcn_mfma_f32_32x32x16_bf16(pa[c], v0, st.o0, 0, 0, 0); st.o1 = __builtin_amdgcn_mfma_f32_32x32x16_bf16(pa[c], v1, st.o1, 0, 0, 0); }
        }
        if (t + 2 < nt) *(LAS u32x4*)(lds + OFF_K + buf * TILEB + sto) = kreg;
        if (MODE != 1 && t + 1 < nt) *(LAS u32x4*)(lds + OFF_V + (buf ^ 1) * TILEB + sto) = vreg;
        __syncthreads();
        }
        if (t + 1 < nt) { const int t_ = t; { const int t = t_ + 1; const int jt = t0 + t; constexpr int buf = 1;
        if (t + 2 < nt) kreg = *(const u32x4*)(kg + (size_t)(t + 2) * 64 * S.kstride);
        if (MODE != 1 && t + 1 < nt) vreg = *(const u32x4*)(vg + (size_t)(t + 1) * 64);
        const int kb0 = jt * 64;
        const bool bit = (selbits >> jt) & 1ull;
        const bool none = !bit || kb0 > khi || kb0 + 63 < klo;
        const bool allv = bit && kb0 >= klo && kb0 + 63 <= khi;
        const bool colv = !none;
        if (__any(colv && !allv)) {
            const int hr = khi - kb0 - 8 * hi, lrr = klo - kb0 - 8 * hi;
#pragma unroll
            for (int r = 0; r < 16; ++r) { const int c = 16 * (r >> 3) + (r & 7);
                if (!(c <= hr && c >= lrr)) q0[r] = -__builtin_inff();
                if (!(c + 32 <= hr && c + 32 >= lrr)) q1[r] = -__builtin_inff(); }
        }
        float tm = fmaxf(fmaxf(q0[0], q0[1]), q0[2]);
#pragma unroll
        for (int r = 3; r < 15; r += 2) tm = fmaxf(fmaxf(tm, q0[r]), q0[r + 1]);
        tm = fmaxf(tm, q0[15]);
#pragma unroll
        for (int r = 0; r < 16; r += 2) tm = fmaxf(fmaxf(tm, q1[r]), q1[r + 1]);
        tm = fmaxf(tm, __shfl_xor(tm, 32));
        if (!colv) tm = -__builtin_inff();
        float mref;
        if (MODE == 2) { mref = st.m; }
        else {
            if (__any(tm > st.m + 8.0f)) {
                const float mn = fmaxf(st.m, tm); const float alpha = __builtin_amdgcn_exp2f(st.m - mn); st.l *= alpha; st.m = mn;
                if (MODE == 0) { if (hi == 0) wsf[q] = alpha; LDS_FENCE();
#pragma unroll
                    for (int r = 0; r < 16; ++r) { const float f = wsf[crow(r, hi)]; st.o0[r] *= f; st.o1[r] *= f; }
                    LDS_FENCE(); }
            }
            mref = st.m;
        }
        const float msub = colv ? mref : __builtin_inff();
        p0 = (f32x16){}; p1 = (f32x16){};
        {   const LAS unsigned char* kb = kfb + (buf ^ 1) * TILEB;
#pragma unroll
            for (int d0 = 0; d0 < 4; ++d0) { const bf16x8 a0 = *(const LAS bf16x8*)(kb + d0 * 32), a1 = *(const LAS bf16x8*)(kb + 32 * ROWB + d0 * 32);
                p0 = __builtin_amdgcn_mfma_f32_32x32x16_bf16(a0, qf[d0], p0, 0, 0, 0); p1 = __builtin_amdgcn_mfma_f32_32x32x16_bf16(a1, qf[d0], p1, 0, 0, 0); } }
        float ls = 0.f;
#pragma unroll
        for (int r = 0; r < 16; ++r) { q0[r] = __builtin_amdgcn_exp2f(q0[r] - msub); q1[r] = __builtin_amdgcn_exp2f(q1[r] - msub); ls += q0[r] + q1[r]; }
        if (MODE != 2) st.l += ls;
        if (MODE == 2) {
#pragma unroll
            for (int r = 0; r < 16; ++r) { q0[r] *= inv_l; q1[r] *= inv_l; }
            float hs0[16], hs1[16];
#pragma unroll
            for (int r = 0; r < 16; ++r) { hs0[r] = quad_sum(q0[r]); hs1[r] = quad_sum(q1[r]); }
            if (g == 0) { LAS float* pr = pc + tokl * PCROW + kb0 + 8 * hi;
#pragma unroll
                for (int r = 0; r < 16; ++r) { pr[16 * (r >> 3) + (r & 7)] = hs0[r]; pr[16 * (r >> 3) + (r & 7) + 32] = hs1[r]; } }
        }
        if (MODE != 1) {
            bf16x8 pa[4];
            {   u32x4 w;
                w.x = cvt_pk_bf16(q0[0], q0[1]); w.y = cvt_pk_bf16(q0[2], q0[3]); w.z = cvt_pk_bf16(q0[4], q0[5]); w.w = cvt_pk_bf16(q0[6], q0[7]); pa[0] = __builtin_bit_cast(bf16x8, w);
                w.x = cvt_pk_bf16(q0[8], q0[9]); w.y = cvt_pk_bf16(q0[10], q0[11]); w.z = cvt_pk_bf16(q0[12], q0[13]); w.w = cvt_pk_bf16(q0[14], q0[15]); pa[1] = __builtin_bit_cast(bf16x8, w);
                w.x = cvt_pk_bf16(q1[0], q1[1]); w.y = cvt_pk_bf16(q1[2], q1[3]); w.z = cvt_pk_bf16(q1[4], q1[5]); w.w = cvt_pk_bf16(q1[6], q1[7]); pa[2] = __builtin_bit_cast(bf16x8, w);
                w.x = cvt_pk_bf16(q1[8], q1[9]); w.y = cvt_pk_bf16(q1[10], q1[11]); w.z = cvt_pk_bf16(q1[12], q1[13]); w.w = cvt_pk_bf16(q1[14], q1[15]); pa[3] = __builtin_bit_cast(bf16x8, w); }
            const LAS unsigned char* vb = lds + OFF_V + buf * TILEB + q * ROWB + hi * 16;
#pragma unroll
            for (int c = 0; c < 4; ++c) { const bf16x8 v0 = *(const LAS bf16x8*)(vb + c * 32), v1 = *(const LAS bf16x8*)(vb + 32 * ROWB + c * 32);
                st.o0 = __builtin_amdgcn_mfma_f32_32x32x16_bf16(pa[c], v0, st.o0, 0, 0, 0); st.o1 = __builtin_amdgcn_mfma_f32_32x32x16_bf16(pa[c], v1, st.o1, 0, 0, 0); }
        }
        if (t + 2 < nt) *(LAS u32x4*)(lds + OFF_K + buf * TILEB + sto) = kreg;
        if (MODE != 1 && t + 1 < nt) *(LAS u32x4*)(lds + OFF_V + (buf ^ 1) * TILEB + sto) = vreg;
        __syncthreads();
        } }
    }
}

struct Tensors { const bf16_t *qraw, *qrot, *ks, *kw, *vst, *vwt, *kcmp, *vcmpT; const float* gate; bf16_t* ob; };

template <bool FIRST>
__device__ __forceinline__ void fold(LAS float* wsf, LAS float* oacc, int q, int hi, float fac, const State& st) {
    if (hi == 0) wsf[q] = fac; LDS_FENCE();
#pragma unroll
    for (int r = 0; r < 16; ++r) { const int row = crow(r, hi); const float f = wsf[row]; LAS float* p = oacc + row * 64 + q;
        if (FIRST) { p[0] = st.o0[r] * f; p[32] = st.o1[r] * f; } else { p[0] += st.o0[r] * f; p[32] += st.o1[r] * f; } }
    LDS_FENCE();
}

__device__ __forceinline__ void job(LAS unsigned char* lds, const Tensors& X, int b, int kvh, int qb) {
    int tid_ = threadIdx.x; asm volatile("" : "+v"(tid_));
    const int tid = tid_, lane = tid & 63, q = lane & 31, hi = lane >> 5, wid = __builtin_amdgcn_readfirstlane(tid >> 6);
    const int tokl = 8 * wid + (q >> 2), g = q & 3, tq = 64 * qb + tokl, head = 4 * kvh + g;
    const size_t trow = (size_t)b * SEQ + tq;
    LAS float* wsf = (LAS float*)(lds + OFF_WSF) + wid * 64;
    LAS float* pc = (LAS float*)(lds + OFF_PC);
    LAS unsigned long long* selm = (LAS unsigned long long*)(lds + OFF_SELM);
    bf16x8 qf[4];
    {   const bf16_t* qp = X.qraw + trow * DM + head * 64 + 8 * hi;
#pragma unroll
        for (int d0 = 0; d0 < 4; ++d0) qf[d0] = *(const bf16x8*)(qp + 16 * d0); }
    const float g0 = X.gate[trow * 48 + head * 3 + 0], g1 = X.gate[trow * 48 + head * 3 + 1], g2 = X.gate[trow * 48 + head * 3 + 2];
    LAS float* oacc = pc + 8 * wid * PCROW;
    const size_t bk = (size_t)b * 4 + kvh;
    const Stream Ssel{X.ks + (size_t)b * SEQ * 256 + kvh * 64, 256, X.vst + bk * 64 * SEQ, SEQ};
    Pre prs;
    {   const Stream S{X.kcmp + bk * 256 * 64, 64, X.vcmpT + bk * 64 * 256, 256};
        const int nct = (qb >> 4) + 1; const int mmax = tq >= 31 ? ((tq - 31) >> 4) : -1;
        State st; st.m = -1e30f; st.l = 0.f; st.o0 = (f32x16){}; st.o1 = (f32x16){};
        const Pre prc = prefetch(tid, S, 0, nct, true);
        run_branch<1>(tid, lds, S, prc, 0, nct, qf, -(1 << 30), mmax, ~0ull, st, 0.f, tokl, g);
        float lt = st.l + __shfl_xor(st.l, 32); const float inv_l = lt > 0.f ? 1.0f / lt : 0.f;
        run_branch<2>(tid, lds, S, prc, 0, nct, qf, -(1 << 30), mmax, ~0ull, st, inv_l, tokl, g);
    prs = prefetch(tid, Ssel, 0, qb + 1, true);
    {
        if (qb < 16) { if (lane < 8) selm[8 * wid + lane] = (2ull << qb) - 1ull; }
        else
#pragma unroll 1
        for (int i = 0; i < 4; ++i) { const int j = lane; unsigned keyA, keyB;
            if (j == 0 || j == qb || j == qb - 1) { keyA = 0xffffffc0u; keyB = 0xffffffc0u; } else if (j > qb) { keyA = 0u; keyB = 0u; }
            else { const LAS float* pa_ = pc + (8 * wid + i) * PCROW + 4 * j; const LAS float* pb_ = pa_ + 4 * PCROW;
                const float sa = (((pa_[-1] + pa_[0]) + pa_[1]) + pa_[2]) + pa_[3], sb = (((pb_[-1] + pb_[0]) + pb_[1]) + pb_[2]) + pb_[3];
                keyA = (__float_as_uint(sa) & 0x7fffffc0u) + 64u; keyB = (__float_as_uint(sb) & 0x7fffffc0u) + 64u; }
            keyA |= (unsigned)(63 - j); keyB |= (unsigned)(63 - j);
            unsigned thrA = 0u, thrB = 0u;
#pragma unroll
            for (int bpos = 29; bpos >= 0; --bpos) { const unsigned cA = thrA | (1u << bpos), cB = thrB | (1u << bpos);
                const unsigned long long mA = __ballot(keyA >= cA), mB = __ballot(keyB >= cB); if (__popcll(mA) >= 16) thrA = cA; if (__popcll(mB) >= 16) thrB = cB; }
            const unsigned long long maskA = __ballot(keyA >= thrA), maskB = __ballot(keyB >= thrB);
            if (lane == 0) { selm[8 * wid + i] = maskA; selm[8 * wid + i + 4] = maskB; } }
        LDS_FENCE();
        fold<true>(wsf, oacc, q, hi, g0, st);
    }
    }
    const unsigned long long mysel = selm[tokl];
    qf[0] = *(const bf16x8*)(X.qrot + (trow * 16 + head) * 16 + 8 * hi);
    const Stream Swin{X.kw + (size_t)b * SEQ * 256 + kvh * 64, 256, X.vwt + bk * 64 * SEQ, SEQ};
    const int tw0 = qb >= 8 ? qb - 8 : 0;
    Pre prw;
    {   State st; st.m = -1e30f; st.l = 0.f; st.o0 = (f32x16){}; st.o1 = (f32x16){};
        run_branch<0>(tid, lds, Ssel, prs, 0, qb + 1, qf, -(1 << 30), tq, mysel, st, 0.f, tokl, g);
        prw = prefetch(tid, Swin, tw0, qb + 1 - tw0, true);
        const float lt = st.l + __shfl_xor(st.l, 32); fold<false>(wsf, oacc, q, hi, lt > 0.f ? g1 / lt : 0.f, st);
    }
    {   State st; st.m = -1e30f; st.l = 0.f; st.o0 = (f32x16){}; st.o1 = (f32x16){};
        run_branch<0>(tid, lds, Swin, prw, tw0, qb + 1 - tw0, qf, tq - 511, tq, ~0ull, st, 0.f, tokl, g);
        const float lt = st.l + __shfl_xor(st.l, 32); fold<false>(wsf, oacc, q, hi, lt > 0.f ? g2 / lt : 0.f, st);
    }
    {   const int qq = lane >> 1, ch = lane & 1; const LAS float* src = oacc + qq * 64 + ch * 32;
        bf16_t* op = X.ob + ((size_t)b * SEQ + 64 * qb + 8 * wid + (qq >> 2)) * DM + (4 * kvh + (qq & 3)) * 64 + ch * 32;
#pragma unroll
        for (int c = 0; c < 4; ++c) { const f32x4 x0 = *(const LAS f32x4*)(src + c * 8), x1 = *(const LAS f32x4*)(src + c * 8 + 4);
            *(u32x4*)(op + c * 8) = (u32x4){cvt_pk_bf16(x0[0], x0[1]), cvt_pk_bf16(x0[2], x0[3]), cvt_pk_bf16(x1[0], x1[1]), cvt_pk_bf16(x1[2], x1[3])}; }
        LDS_FENCE(); }
}
}


#define XB_TMO      128
#define XB_XCNT(j)  (256  + 64 * (j))
#define XB_XSUB(j)  (1280 + 64 * (j))
#define XB_XGEN(j)  (2304 + 64 * (j))
#define XB_TOP      3328
#define XB_TOPGEN   3392
#define XCD_BAR_WORDS 3456
#define XB_SPIN_CAP (1u << 20)
__device__ __forceinline__ unsigned xb_ld(unsigned* p)              { return __hip_atomic_load(p, __ATOMIC_RELAXED, __HIP_MEMORY_SCOPE_AGENT); }
__device__ __forceinline__ unsigned xb_add(unsigned* p, unsigned v) { return __hip_atomic_fetch_add(p, v, __ATOMIC_RELAXED, __HIP_MEMORY_SCOPE_AGENT); }
__device__ __forceinline__ unsigned xb_xcc_id() { return (unsigned)__builtin_amdgcn_s_getreg((3 << 11) | 20) & 0xFu; }
#define XB_SPIN(cond, bar) do { unsigned _sp = 0; while (cond) { __builtin_amdgcn_s_sleep(1); \
    if ((++_sp & 255u) == 0u) { if (xb_ld(&(bar)[XB_TMO])) break; if (_sp > XB_SPIN_CAP) { atomicAdd(&(bar)[XB_TMO], 1u); break; } } } } while (0)
struct XcdBarrier { unsigned* bar; unsigned x; volatile LAS unsigned* st; };
__device__ __forceinline__ XcdBarrier xcd_barrier_post(unsigned* bar, volatile LAS unsigned* st) {
    XcdBarrier b; b.bar = bar; b.x = xb_xcc_id(); b.st = st;
    if (threadIdx.x == 0) (void)xb_add(&bar[XB_XCNT(b.x)], 1u);
    return b;
}
__device__ __forceinline__ void xcd_barrier_complete(unsigned* bar, unsigned x, unsigned& nloc, unsigned& nx) {
    const unsigned G = gridDim.x * gridDim.y * gridDim.z;
    unsigned sum, cnt, mine, sp = 0u;
    for (;;) {
        sum = 0u; cnt = 0u; mine = 0u;
#pragma unroll
        for (unsigned j = 0; j < 16; ++j) { const unsigned c = xb_ld(&bar[XB_XCNT(j)]); sum += c; cnt += (c > 0u) ? 1u : 0u; mine = (j == x) ? c : mine; }
        if (sum == G) break;
        __builtin_amdgcn_s_sleep(1);
        if ((++sp & 255u) == 0u) { if (xb_ld(&bar[XB_TMO])) break; if (sp > XB_SPIN_CAP) { atomicAdd(&bar[XB_TMO], 1u); break; } }
    }
    nloc = mine > 0u ? mine : 1u; nx = cnt > 0u ? cnt : 1u;
}
__device__ __forceinline__ void xcd_barrier(const XcdBarrier& b) {
    asm volatile("s_waitcnt vmcnt(0)" ::: "memory");
    __syncthreads();
    if (threadIdx.x == 0) {
        unsigned* bar = b.bar;
        __builtin_amdgcn_s_waitcnt(0);
        unsigned nloc = b.st[0], nx = b.st[1];
        if (nloc == 0u) { xcd_barrier_complete(bar, b.x, nloc, nx); b.st[0] = nloc; b.st[1] = nx; }
        const unsigned old = xb_add(&bar[XB_XSUB(b.x)], 1u);
        const unsigned gen = old / nloc;
        if (old + 1u == (gen + 1u) * nloc) {
            __builtin_amdgcn_fence(__ATOMIC_RELEASE, "agent");
            asm volatile("s_waitcnt vmcnt(0)" ::: "memory");
            const unsigned og = xb_add(&bar[XB_TOP], 1u);
            const unsigned tg = og / nx;
            if (og + 1u == (tg + 1u) * nx) xb_add(&bar[XB_TOPGEN], 1u);
            else XB_SPIN(xb_ld(&bar[XB_TOPGEN]) == tg, bar);
            __builtin_amdgcn_fence(__ATOMIC_ACQUIRE, "agent");
            xb_add(&bar[XB_XGEN(b.x)], 1u);
            asm volatile("s_waitcnt vmcnt(0)" ::: "memory");
        } else {
            XB_SPIN(xb_ld(&bar[XB_XGEN(b.x)]) == gen, bar);
            __builtin_amdgcn_fence(__ATOMIC_ACQUIRE, "agent");
            asm volatile("s_waitcnt vmcnt(0)" ::: "memory");
        }
    }
    __syncthreads();
}

constexpr int LDS_BYTES = 147456;
typedef const __attribute__((address_space(4))) Args* KArgP;
#define KARGS() (*(const Args*)({ KArgP p_ = (KArgP)__builtin_amdgcn_kernarg_segment_ptr(); asm volatile("" : "+s"(p_)); p_; }))
__global__ void __launch_bounds__(512, 2) mk_fwd(Args a_unused) {
    extern __shared__ __attribute__((aligned(16))) unsigned char lds_raw[];
    Ctx C; C.lds = (LAS unsigned char*)lds_raw; C.tid = threadIdx.x; C.lane = C.tid & 63; C.wave = __builtin_amdgcn_readfirstlane(C.tid >> 6); C.G = gridDim.x; C.bid = blockIdx.x;
    const int lo = KARGS().ph_lo, hi = KARGS().ph_hi;
    volatile LAS unsigned* xst = (volatile LAS unsigned*)(C.lds + LDS_BYTES - 64);
    if (C.tid < 2) xst[C.tid] = 0u;
    __syncthreads();
    if (lo > NPHASE) cg::this_grid().sync();
    const XcdBarrier xbar = xcd_barrier_post((unsigned*)(KARGS().ws + WS_BAR), xst);
#ifdef ONLY_PHASE
#define IN(k) ((k) == ONLY_PHASE && lo <= (k) && (k) < hi)
#else
#define IN(k) (lo <= (k) && (k) < hi)
#endif
#define SEAM(k) do { if (IN(k) && IN((k) + 1)) { xcd_barrier(xbar); } } while (0)
    using namespace pg8;
    const int NT = T / 256;
#define PHASE_VARS const Args& a = KARGS(); unsigned char* ws = a.ws; float* ssA = (float*)(ws + WS_SSA); float* ssB = (float*)(ws + WS_SSB); bf16_t* hb = (bf16_t*)(ws + WS_HB); bf16_t* hid = (bf16_t*)(ws + WS_HID); float* ssC = (float*)(ws + WS_SSC); float* ssD = (float*)(ws + WS_SSD); (void)ssC; (void)ssD; \
    (void)ssA; (void)ssB; (void)hb; (void)hid;

    if (IN(0)) { PHASE_VARS p0_prologue(C, a);
#ifdef PROBE_P0X2
        __syncthreads(); p0_prologue(C, a);
#endif
    } SEAM(0);
    if (IN(1)) { PHASE_VARS
        Gemm g{(const char*)(ws + WS_XB), (const char*)(ws + WS_WFIN), DM, 128, DM, NT, 22, 0}; StaticOrder S; S.init(NT, 22, C.G, C.bid);
        EpiSwiGLU E{ssA, hid}; gemm_phase<EpiSwiGLU, StaticOrder>(C.lds, g, S, E);
#ifdef PROBE_G1X2
        gemm_phase<EpiSwiGLU, StaticOrder>(C.lds, g, S, E);
#endif
    } SEAM(1);
    if (IN(2)) { PHASE_VARS
        Gemm g{(const char*)hid, (const char*)(ws + WS_WFOUT), FF, 128, FF, NT, 4, 0}; StaticOrder S; S.init(NT, 4, C.G, C.bid);
        EpiResid E{(const bf16_t*)(ws + WS_XB), 0.5f, hb, ssB}; gemm_phase<EpiResid, StaticOrder>(C.lds, g, S, E);
    } SEAM(2);
    if (IN(3)) { PHASE_VARS
        Gemm g{(const char*)hb, (const char*)(ws + WS_WIN), DM, 128, DM, NT, 23, 0}; StaticOrder S; S.init(NT, 23, C.G, C.bid);
        EpiProj E{ssB, (const float*)(ws + WS_ROPE), (bf16_t*)(ws + WS_UB), (bf16_t*)(ws + WS_GV), (bf16_t*)(ws + WS_QRAW), (bf16_t*)(ws + WS_QROT), (bf16_t*)(ws + WS_KC), (bf16_t*)(ws + WS_VC),
                  (bf16_t*)(ws + WS_KS), (bf16_t*)(ws + WS_KW), (bf16_t*)(ws + WS_VST), (bf16_t*)(ws + WS_VWT), (bf16_t*)(ws + WS_GA), (float*)(ws + WS_VSTAT), (float*)(ws + WS_GATE)};
        gemm_phase<EpiProj, StaticOrder>(C.lds, g, S, E);
#ifdef PROBE_G3X2
        gemm_phase<EpiProj, StaticOrder>(C.lds, g, S, E);
#endif
    } SEAM(3);
    if (IN(4)) { PHASE_VARS
#ifndef NO_CMP
        {   Gemm g{(const char*)(ws + WS_KC), (const char*)(ws + WS_WC1), 4096, 512, 2048, 32, 1, 1}; StaticOrder S; S.init(32, 1, C.G, C.bid);
            EpiCmp1 E{(bf16_t*)(ws + WS_CHID), (const float*)(ws + WS_CBIAS)}; gemm_phase<EpiCmp1, StaticOrder>(C.lds, g, S, E); }
#endif
        __syncthreads();
#ifndef NO_GMLP
        if (C.G == 256) { if (C.bid >= 32) for (int j = C.bid - 32; j < 1024; j += 224) gmlp_job(C, a, j); }
        else for (int j = C.bid; j < 1024; j += C.G) gmlp_job(C, a, j);
#endif
    } SEAM(4);
    if (IN(5)) { PHASE_VARS
        {   Gemm g{(const char*)(ws + WS_UB), (const char*)(ws + WS_WA), DM, 128, DM, NT, 4, 0}; StaticOrder S; S.init(NT, 4, C.G, C.bid);
            EpiBf16<2> E{(bf16_t*)(ws + WS_GV), nullptr, (const bf16_t*)(ws + WS_GA), nullptr}; gemm_phase<EpiBf16<2>, StaticOrder>(C.lds, g, S, E); }
#ifndef NO_CMP
        cmp2_phase(C, a);
#endif
    } SEAM(5);
    if (IN(6)) { PHASE_VARS
        att::Tensors X{(const bf16_t*)(ws + WS_QRAW), (const bf16_t*)(ws + WS_QROT), (const bf16_t*)(ws + WS_KS), (const bf16_t*)(ws + WS_KW), (const bf16_t*)(ws + WS_VST), (const bf16_t*)(ws + WS_VWT),
                       (const bf16_t*)(ws + WS_KCMP), (const bf16_t*)(ws + WS_VCMPT), (const float*)(ws + WS_GATE), (bf16_t*)(ws + WS_QRAW)};
#ifndef NO_ATTN
#ifdef PROBE_ATTN2
        { att::Tensors X0 = X; X0.ob = (bf16_t*)(ws + WS_UB);
        if (C.G == 256) { const int vcu = (C.bid & 7) * 32 + (C.bid >> 3); const int bkv = vcu >> 4, s = vcu & 15;
#pragma unroll 1
            for (int i = 0; i < 4; ++i) { const int qb = i == 0 ? 63 - s : i == 1 ? 32 + s : i == 2 ? 31 - s : s; att::job(C.lds, X0, bkv >> 2, bkv & 3, qb); }
        } else { for (int j = C.bid; j < 1024; j += C.G) { const int bkv = j & 15, qb = 63 - (j >> 4); att::job(C.lds, X0, bkv >> 2, bkv & 3, qb); } }
        __syncthreads(); }
#endif
        if (C.G == 256) { const int vcu = (C.bid & 7) * 32 + (C.bid >> 3); const int bkv = vcu >> 4, s = vcu & 15;
#pragma unroll 1
            for (int i = 0; i < 4; ++i) { const int qb = i == 0 ? 63 - s : i == 1 ? 32 + s : i == 2 ? 31 - s : s; att::job(C.lds, X, bkv >> 2, bkv & 3, qb); }
        } else { for (int j = C.bid; j < 1024; j += C.G) { const int bkv = j & 15, qb = 63 - (j >> 4); att::job(C.lds, X, bkv >> 2, bkv & 3, qb); } }
#endif
        __syncthreads();
#ifndef NO_GB
        {   Gemm g{(const char*)hb, (const char*)(ws + WS_WGB), DM, 128, DM, NT, 4, 0}; StaticOrder S; S.init(NT, 4, C.G, C.bid);
            EpiBf16<0> E{(bf16_t*)(ws + WS_UB), nullptr, nullptr, nullptr}; gemm_phase<EpiBf16<0>, StaticOrder>(C.lds, g, S, E); }
#endif
    } SEAM(6);
    if (IN(7)) { PHASE_VARS
        Gemm g{(const char*)(ws + WS_QRAW), (const char*)(ws + WS_WB), DM, 128, DM, NT, 4, 0}; StaticOrder S; S.init(NT, 4, C.G, C.bid);
        EpiBf16<4> E{(bf16_t*)(ws + WS_GV), ssB, (const bf16_t*)(ws + WS_UB), (const bf16_t*)(ws + WS_GV)}; gemm_phase<EpiBf16<4>, StaticOrder>(C.lds, g, S, E);
    } SEAM(7);
    if (IN(8)) { PHASE_VARS
        {   Gemm g{(const char*)(ws + WS_GV), (const char*)(ws + WS_WO), DM, 128, DM, NT, 4, 0}; StaticOrder S; S.init(NT, 4, C.G, C.bid);
            EpiResid E{hb, 1.0f, hb, ssC}; gemm_phase<EpiResid, StaticOrder>(C.lds, g, S, E); }
        __syncthreads();
        p8_extras(C, a);
    } SEAM(8);
    if (IN(9)) { PHASE_VARS
        {   Gemm g{(const char*)hb, (const char*)(ws + WS_WFIN), DM, 128, DM, NT, 22, 0}; StaticOrder S; S.init(NT, 22, C.G, C.bid);
            EpiSwiGLU E{ssC, hid}; gemm_phase<EpiSwiGLU, StaticOrder>(C.lds, g, S, E); }
        int opq = 0; asm volatile("" : "+s"(opq));
        if (opq == 0) {   int kple = PLE; asm volatile("" : "+s"(kple));
            Gemm g{(const char*)(ws + WS_PB), (const char*)(ws + WS_WPP), PLE, 128, kple, NT, 4, 0}; StaticOrder S;
            if (C.G == 256) S.init(NT, 4, 128, C.bid >= 128 ? C.bid - 128 : -1); else S.init(NT, 4, C.G, C.bid);
            EpiBf16<0> E{(bf16_t*)(ws + WS_PP), nullptr, nullptr, nullptr}; gemm_phase<EpiBf16<0>, StaticOrder>(C.lds, g, S, E); }
    } SEAM(9);
    if (IN(10)) { PHASE_VARS
        Gemm g{(const char*)hid, (const char*)(ws + WS_WFOUT), FF, 128, FF, NT, 4, 0}; StaticOrder S; S.init(NT, 4, C.G, C.bid);
        EpiResid E{hb, 0.5f, hb, ssD}; gemm_phase<EpiResid, StaticOrder>(C.lds, g, S, E);
    } SEAM(10);
    if (IN(11)) { PHASE_VARS
        Gemm g{(const char*)hb, (const char*)(ws + WS_WPG), DM, 128, DM, NT, 4, 0}; StaticOrder S; S.init(NT, 4, C.G, C.bid);
        if (C.G == 256) { EpiPleFinal E{ssD, (const bf16_t*)(ws + WS_PP), hb, a.out, a.in[I_FIN], (unsigned*)(ws + WS_BAR + 32768), (unsigned*)(ws + WS_BAR + 16384)};
            gemm_phase<EpiPleFinal, StaticOrder>(C.lds, g, S, E); }
        else { EpiPle E{ssD, (const bf16_t*)(ws + WS_PP), hb, a.out, ssA}; gemm_phase<EpiPle, StaticOrder>(C.lds, g, S, E); }
    }
    if (C.G != 256) { SEAM(11); if (IN(12)) { PHASE_VARS final_phase(C, a); } }
#undef IN
#undef SEAM
}

extern "C" void kernel_launch(void* const* d_in, const int* in_sizes, int n_in, void* d_out, int out_size, void* d_ws, size_t ws_size, hipStream_t stream) {
    static int grid = 0;
    if (grid == 0) {
        if (n_in != 27 || out_size != T * DM || ws_size < WS_END) { fprintf(stderr, "kernel_launch: unexpected problem (n_in %d, out %d, ws %zu)\n", n_in, out_size, ws_size); grid = -1; return; }
        int dev = 0, cus = 0, per_cu = 0;
        hipGetDevice(&dev); hipDeviceGetAttribute(&cus, hipDeviceAttributeMultiprocessorCount, dev);
        hipFuncSetAttribute((const void*)mk_fwd, hipFuncAttributeMaxDynamicSharedMemorySize, LDS_BYTES);
        hipOccupancyMaxActiveBlocksPerMultiprocessor(&per_cu, (const void*)mk_fwd, 512, LDS_BYTES);
        if (per_cu < 1) { fprintf(stderr, "kernel_launch: occupancy query says %d blocks per CU\n", per_cu); per_cu = 1; }
        (void)hipGetLastError();
        grid = cus * 1;
    }
    if (grid < 0) return;
    Args a{};
    for (int i = 0; i < 27; ++i) a.in[i] = (const float*)d_in[i];
    a.out = (float*)d_out; a.ws = (unsigned char*)d_ws;
#if MK_SINGLE
    hipMemsetAsync((char*)d_ws + WS_BAR, 0, 32768, stream);
    a.ph_lo = 0; a.ph_hi = NPHASE;
    void* args[] = {&a};
    hipError_t e = hipLaunchCooperativeKernel((const void*)mk_fwd, dim3(grid), dim3(512), args, LDS_BYTES, stream);
    if (e != hipSuccess) fprintf(stderr, "cooperative launch failed: %s (grid %d)\n", hipGetErrorString(e), grid);
#else
    for (int k = 0; k < NPHASE; ++k) { a.ph_lo = k; a.ph_hi = k + 1; hipLaunchKernelGGL(mk_fwd, dim3(grid), dim3(512), LDS_BYTES, stream, a); }
#endif
}
```

```cpp
#include <hip/hip_runtime.h>
#include <hip/hip_cooperative_groups.h>
#include <cstdint>
#include <cstdio>
namespace cg = cooperative_groups;

#ifndef MK_SINGLE
#define MK_SINGLE 1
#endif

#define LAS __attribute__((address_space(3)))
typedef unsigned short bf16_t;
typedef short bf16x8 __attribute__((ext_vector_type(8)));
typedef float f32x4 __attribute__((ext_vector_type(4)));
typedef float f32x2 __attribute__((ext_vector_type(2)));
typedef float f32x16 __attribute__((ext_vector_type(16)));
typedef unsigned u32x4 __attribute__((ext_vector_type(4)));
typedef unsigned u32x2 __attribute__((ext_vector_type(2)));

constexpr int T = 16384, SEQ = 4096, DM = 1024, FF = 2816, PLE = 256;
constexpr int N3 = 5888;
constexpr float EPS = 1e-6f;
constexpr float LOG2E = 1.4426950408889634f;
constexpr float QSCALE = 0.125f * LOG2E;
constexpr int NPHASE = 13;

constexpr size_t MiB = 1u << 20;
constexpr size_t WS_SSA = 0, WS_SSB = 1 * MiB, WS_VSTAT = 2 * MiB, WS_ROPE = 4 * MiB, WS_GMW = 4 * MiB + 256 * 1024,
                 WS_KCMP = 4 * MiB + 512 * 1024, WS_VCMPT = 5 * MiB, WS_CBIAS = 5 * MiB + 512 * 1024, WS_GATE = 6 * MiB, WS_SSC = 9 * MiB, WS_SSD = 10 * MiB;
constexpr size_t WS_WIN = 11 * MiB;
constexpr size_t WS_WGB = WS_WIN + (size_t)N3 * 1024 * 2;
constexpr size_t WS_WA = WS_WGB + 2 * MiB, WS_WB = WS_WA + 2 * MiB, WS_WO = WS_WB + 2 * MiB, WS_WPG = WS_WO + 2 * MiB, WS_WPP = WS_WPG + 2 * MiB,
                 WS_WC1 = 33 * MiB;
constexpr size_t WS_WFIN = 35 * MiB, WS_WFOUT = 46 * MiB;
constexpr size_t WS_KC = 35 * MiB, WS_VC = 43 * MiB;
constexpr size_t WS_HID = 52 * MiB;
constexpr size_t WS_QRAW = 52 * MiB, WS_QROT = 84 * MiB, WS_KS = 92 * MiB, WS_KW = 100 * MiB, WS_VST = 108 * MiB, WS_VWT = 116 * MiB,
                 WS_GA = 124 * MiB, WS_UB = 156 * MiB, WS_HB = 188 * MiB, WS_GV = 220 * MiB, WS_CHID = 252 * MiB;
constexpr size_t WS_XB = 140 * MiB, WS_PB = 140 * MiB, WS_PP = 148 * MiB;
constexpr size_t WS_BAR = 51 * MiB + 512 * 1024;
constexpr size_t WS_END = 256 * MiB;
static_assert(WS_WPP + 512 * 1024 <= WS_WC1 && WS_WC1 + 2 * MiB <= WS_WFIN, "weight map");

typedef __bf16 bf16x2_t __attribute__((ext_vector_type(2)));
__device__ __forceinline__ unsigned cvt_pk_bf16(float lo, float hi) { f32x2 v = {lo, hi}; bf16x2_t b = __builtin_convertvector(v, bf16x2_t); return __builtin_bit_cast(unsigned, b); }
__device__ __forceinline__ float bf2f(unsigned short b) { return __uint_as_float((unsigned)b << 16); }
__device__ __forceinline__ float bflo(unsigned w) { return __uint_as_float(w << 16); }
__device__ __forceinline__ float bfhi(unsigned w) { return __uint_as_float(w & 0xffff0000u); }
__device__ __forceinline__ float fsigmoid(float x) { return __builtin_amdgcn_rcpf(1.0f + __builtin_amdgcn_exp2f(-x * LOG2E)); }
__device__ __forceinline__ float fsilu(float x) { return x * fsigmoid(x); }
__device__ __forceinline__ float fgelu(float x) { return x * fsigmoid(1.5957691216057308f * (x + 0.044715f * x * x * x)); }
__device__ __forceinline__ void sigmoid8(float (&v)[8]) {
#pragma unroll
    for (int i = 0; i < 8; i += 2) { f32x2 x = {v[i], v[i + 1]}; const f32x2 z = x * (-LOG2E); f32x2 e = {__builtin_amdgcn_exp2f(z.x), __builtin_amdgcn_exp2f(z.y)}; const f32x2 d = e + 1.0f;
        v[i] = __builtin_amdgcn_rcpf(d.x); v[i + 1] = __builtin_amdgcn_rcpf(d.y); }
}
__device__ __forceinline__ void silu8(float (&v)[8]) {
#pragma unroll
    for (int i = 0; i < 8; i += 2) { f32x2 x = {v[i], v[i + 1]}; const f32x2 z = x * (-LOG2E); f32x2 e = {__builtin_amdgcn_exp2f(z.x), __builtin_amdgcn_exp2f(z.y)}; const f32x2 d = e + 1.0f;
        const f32x2 r = {__builtin_amdgcn_rcpf(d.x), __builtin_amdgcn_rcpf(d.y)}; x = x * r; v[i] = x.x; v[i + 1] = x.y; }
}
__device__ __forceinline__ void gelu8(float (&v)[8]) {
    constexpr float c0 = -1.5957691216057308f * LOG2E, c1 = c0 * 0.044715f;
#pragma unroll
    for (int i = 0; i < 8; i += 2) { f32x2 x = {v[i], v[i + 1]}; const f32x2 w = (x * x) * c1 + c0; const f32x2 z = x * w; f32x2 e = {__builtin_amdgcn_exp2f(z.x), __builtin_amdgcn_exp2f(z.y)}; const f32x2 d = e + 1.0f;
        const f32x2 r = {__builtin_amdgcn_rcpf(d.x), __builtin_amdgcn_rcpf(d.y)}; x = x * r; v[i] = x.x; v[i + 1] = x.y; }
}
__device__ __forceinline__ u32x4 pack8(const float (&v)[8]) { u32x4 w; w.x = cvt_pk_bf16(v[0], v[1]); w.y = cvt_pk_bf16(v[2], v[3]); w.z = cvt_pk_bf16(v[4], v[5]); w.w = cvt_pk_bf16(v[6], v[7]); return w; }
__device__ __forceinline__ void unpack8(const u32x4 w, float (&v)[8]) { v[0] = bflo(w.x); v[1] = bfhi(w.x); v[2] = bflo(w.y); v[3] = bfhi(w.y); v[4] = bflo(w.z); v[5] = bfhi(w.z); v[6] = bflo(w.w); v[7] = bfhi(w.w); }
#define LDS_FENCE() asm volatile("s_waitcnt lgkmcnt(0)" ::: "memory")
__device__ __forceinline__ float quad_sum(float v) {
    v += __int_as_float(__builtin_amdgcn_update_dpp(0, __float_as_int(v), 0xB1, 0xF, 0xF, true));
    v += __int_as_float(__builtin_amdgcn_update_dpp(0, __float_as_int(v), 0x4E, 0xF, 0xF, true));
    return v;
}

namespace pg8 {
constexpr int BM = 256, BK = 64, HALF = 128, HTB = HALF * BK * 2, STAGE_BYTES = 8 * HTB, NXCD = 8, WGM = 4;
__host__ __device__ __forceinline__ int lds_byte(int r, int c) { const int st = (r >> 4) * 2 + (c >> 5), rr = r & 15, cc = c & 31, ob = rr * 64 + cc * 2; return st * 1024 + (ob ^ (((ob >> 9) & 1) << 5)); }
__host__ __device__ __forceinline__ void stage_rc(int b, int& R, int& C) { const int st = b / 1024, sb = b % 1024, swz = sb ^ (((sb >> 9) & 1) << 5); R = (st >> 1) * 16 + swz / 64; C = (st & 1) * 32 + (swz % 64) / 2; }
__host__ __device__ __forceinline__ int perm32(int rho) { const int n = rho >> 4, i = rho & 15; return 8 * (i >> 2) + 4 * n + (i & 3); }

struct Unit { int pm, pn; };
struct Gemm { const char* A; const char* Bt; int lda; int kstepA; int K; int nM, nN; int mode; };
__device__ __forceinline__ const char* abase(const Gemm& g, const Unit& u) {
    if (g.mode == 1) { const int pm = u.pm; return g.A + ((size_t)(pm >> 4) * ((size_t)T * 256) + (size_t)((pm & 15) >> 2) * 64 + (size_t)(pm & 3) * 256 * 4096) * 2; }
    return g.A + (size_t)u.pm * ((size_t)BM * g.lda * 2);
}
__device__ __forceinline__ const char* bbase(const Gemm& g, const Unit& u) {
    if (g.mode == 1) return g.Bt + (size_t)(u.pm >> 4) * ((size_t)256 * 2048 * 2);
    return g.Bt + (size_t)u.pn * ((size_t)BM * g.K * 2);
}

struct StaticOrder {
    int nM, nN, nwg, G, c;
    __device__ void init(int nM_, int nN_, int G_, int c_) { nM = nM_; nN = nN_; nwg = nM * nN; G = G_; c = c_; }
    __device__ bool next(int i, Unit& u) const {
        if (c < 0) return false;
        const long L = (long)i * G + c; if (L >= nwg) return false;
        int wgid = (int)L; { const int q = nwg / NXCD, r = nwg % NXCD, xcd = wgid % NXCD, off = wgid / NXCD; wgid = (xcd < r ? xcd * (q + 1) : r * (q + 1) + (xcd - r) * q) + off; }
        const int nig = WGM * nN, gid = wgid / nig, fm = gid * WGM, gsz = (nM - fm) < WGM ? (nM - fm) : WGM;
        u.pm = fm + ((wgid % nig) % gsz); u.pn = (wgid % nig) / gsz; return true;
    }
};

template <class Epi, class Sched, bool ALIGN_EPI = true, bool SP2 = true>
__device__ __forceinline__ void gemm_phase(LAS unsigned char* lds, const Gemm g, const Sched& S, const Epi& E) {
    const int tid = threadIdx.x, wid = __builtin_amdgcn_readfirstlane(tid >> 6), lane = tid & 63, wr = wid >> 2, wc = wid & 3, fr = lane & 15, fq = lane >> 4;
    const int K = g.K, nt = K / BK;
    unsigned voffA[2], voffB[2];
#pragma unroll
    for (int i = 0; i < 2; ++i) { int R, C; stage_rc(tid * 16 + i * 8192, R, C); const int Rb = Epi::PERM ? ((R & ~31) + perm32(R & 31)) : R;
        voffA[i] = (unsigned)(R * g.lda + C) * 2u; voffB[i] = (unsigned)(Rb * K + C) * 2u; }
    const size_t kstepA = (size_t)g.kstepA, kstepB = (size_t)(BK * 2);
    const size_t hstepA = (size_t)HALF * g.lda * 2, hstepB = (size_t)HALF * K * 2;
    const unsigned ldsw = (unsigned)wid * 1024u;
    const int aoff = lds_byte(wr * 64 + fr, fq * 8), boff = lds_byte(wc * 32 + fr, fq * 8);
#define PG8_SA(b, h) (((b) * 2 + (h)) * HTB)
#define PG8_SB(b, h) ((4 + (b) * 2 + (h)) * HTB)
#define PG8_STAGE(bufoff, gbase, voff) do { _Pragma("unroll") for (int _i = 0; _i < 2; ++_i) \
        __builtin_amdgcn_global_load_lds((const unsigned*)((const char*)(gbase) + (voff)[_i]), (LAS unsigned*)(lds + (bufoff) + ldsw + _i * 8192), 16, 0, 0); } while (0)
#define PG8_LDA(dst, b, h) do { _Pragma("unroll") for (int m = 0; m < 4; ++m) _Pragma("unroll") for (int k = 0; k < 2; ++k) dst[m][k] = *(const LAS bf16x8*)(lds + PG8_SA(b, h) + aoff + m * 2048 + k * 1024); } while (0)
#define PG8_LDB(dst, b, h) do { _Pragma("unroll") for (int n = 0; n < 2; ++n) _Pragma("unroll") for (int k = 0; k < 2; ++k) dst[n][k] = *(const LAS bf16x8*)(lds + PG8_SB(b, h) + boff + n * 2048 + k * 1024); } while (0)
#define PG8_MMA(ai, bj, At, Bt) do { __builtin_amdgcn_s_setprio(1); _Pragma("unroll") for (int m = 0; m < 4; ++m) _Pragma("unroll") for (int n = 0; n < 2; ++n) _Pragma("unroll") for (int k = 0; k < 2; ++k) \
        acc[ai][bj][m][n] = __builtin_amdgcn_mfma_f32_16x16x32_bf16(Bt[n][k], At[m][k], acc[ai][bj][m][n], 0, 0, 0); __builtin_amdgcn_s_setprio(0); } while (0)
#define PG8_WAIT_V(n) asm volatile("s_waitcnt vmcnt(" #n ")" ::: "memory")
#define PG8_WAIT_L(n) asm volatile("s_waitcnt lgkmcnt(" #n ")" ::: "memory")
#define PG8_BAR __builtin_amdgcn_s_barrier()
#define PG8_SCHED __builtin_amdgcn_sched_barrier(0)
    Unit cur, nxt; int ui = 0;
    if (!S.next(0, cur)) return;
    f32x4 acc[2][2][4][2];
#pragma unroll
    for (int a = 0; a < 2; ++a)
#pragma unroll
        for (int b = 0; b < 2; ++b)
#pragma unroll
            for (int m = 0; m < 4; ++m)
#pragma unroll
                for (int n = 0; n < 2; ++n) acc[a][b][m][n] = (f32x4){0.f, 0.f, 0.f, 0.f};
    bf16x8 At[4][2], B0[2][2], B1[2][2];
    const char* cA = abase(g, cur); const char* cB = bbase(g, cur);
    if constexpr (SP2) {
        PG8_STAGE(PG8_SB(0, 0), cB, voffB); PG8_STAGE(PG8_SB(0, 1), cB + hstepB, voffB); PG8_STAGE(PG8_SA(0, 0), cA, voffA); PG8_STAGE(PG8_SA(0, 1), cA + hstepA, voffA);
        if (wr == 1) PG8_BAR;
        PG8_WAIT_V(2); PG8_BAR;
        PG8_STAGE(PG8_SB(1, 0), cB + kstepB, voffB); PG8_STAGE(PG8_SA(1, 0), cA + kstepA, voffA); PG8_STAGE(PG8_SB(1, 1), cB + hstepB + kstepB, voffB);
        PG8_WAIT_V(6); PG8_BAR;
    } else {
        PG8_STAGE(PG8_SB(0, 0), cB, voffB); PG8_STAGE(PG8_SA(0, 0), cA, voffA); PG8_STAGE(PG8_SB(0, 1), cB + hstepB, voffB); PG8_STAGE(PG8_SA(0, 1), cA + hstepA, voffA);
        if (wr == 1) PG8_BAR;
        PG8_WAIT_V(4); PG8_BAR;
        PG8_STAGE(PG8_SB(1, 0), cB + kstepB, voffB); PG8_STAGE(PG8_SA(1, 0), cA + kstepA, voffA); PG8_STAGE(PG8_SB(1, 1), cB + hstepB + kstepB, voffB);
        PG8_WAIT_V(6); PG8_BAR;
    }
    for (;;) {
        const bool has_next = S.next(ui + 1, nxt);
        const char* nA = has_next ? abase(g, nxt) : cA + (size_t)(nt - 2) * kstepA; const char* nB = has_next ? bbase(g, nxt) : cB + (size_t)(nt - 2) * kstepB;
        for (int t = 0; t < nt; t += 2) {
            const bool last = (t == nt - 2);
            const char* a1 = cA + (size_t)(t + 1) * kstepA;
            const char* a2 = last ? nA : cA + (size_t)(t + 2) * kstepA; const char* b2 = last ? nB : cB + (size_t)(t + 2) * kstepB;
            const char* a3 = a2 + kstepA; const char* b3 = b2 + kstepB;
            if constexpr (SP2) {
            PG8_LDB(B0, 0, 0); PG8_LDB(B1, 0, 1); PG8_SCHED; PG8_LDA(At, 0, 0); PG8_STAGE(PG8_SA(1, 1), a1 + hstepA, voffA);
            PG8_WAIT_V(8); PG8_WAIT_L(0); PG8_BAR; PG8_MMA(0, 0, At, B0); PG8_MMA(0, 1, At, B1); PG8_BAR; PG8_SCHED;
            PG8_LDA(At, 0, 1); PG8_STAGE(PG8_SB(0, 0), b2, voffB); PG8_STAGE(PG8_SB(0, 1), b2 + hstepB, voffB); PG8_STAGE(PG8_SA(0, 0), a2, voffA);
            PG8_WAIT_V(8); PG8_WAIT_L(0); PG8_BAR; PG8_MMA(1, 0, At, B0); PG8_MMA(1, 1, At, B1); PG8_BAR; PG8_SCHED;
            PG8_LDB(B0, 1, 0); PG8_LDB(B1, 1, 1); PG8_SCHED; PG8_LDA(At, 1, 0); PG8_STAGE(PG8_SA(0, 1), a2 + hstepA, voffA);
            PG8_WAIT_V(8); PG8_WAIT_L(0); PG8_BAR; PG8_MMA(0, 0, At, B0); PG8_MMA(0, 1, At, B1); PG8_BAR; PG8_SCHED;
            PG8_LDA(At, 1, 1); PG8_STAGE(PG8_SB(1, 0), b3, voffB); PG8_STAGE(PG8_SB(1, 1), b3 + hstepB, voffB); PG8_STAGE(PG8_SA(1, 0), a3, voffA);
            PG8_WAIT_V(8); PG8_WAIT_L(0); PG8_BAR; PG8_MMA(1, 0, At, B0); PG8_MMA(1, 1, At, B1); PG8_BAR; PG8_SCHED;
            } else {
            PG8_LDB(B0, 0, 0); PG8_SCHED; PG8_LDA(At, 0, 0); PG8_STAGE(PG8_SA(1, 1), a1 + hstepA, voffA);
            PG8_WAIT_L(8); PG8_BAR; PG8_WAIT_L(0); PG8_MMA(0, 0, At, B0); PG8_BAR; PG8_SCHED;
            PG8_LDB(B1, 0, 1); PG8_STAGE(PG8_SB(0, 0), b2, voffB);
            PG8_BAR; PG8_WAIT_L(0); PG8_MMA(0, 1, At, B1); PG8_BAR;
            PG8_LDA(At, 0, 1); PG8_STAGE(PG8_SA(0, 0), a2, voffA);
            PG8_BAR; PG8_WAIT_L(0); PG8_MMA(1, 0, At, B0); PG8_BAR; PG8_SCHED;
            PG8_STAGE(PG8_SB(0, 1), b2 + hstepB, voffB);
            PG8_WAIT_V(6); PG8_BAR; PG8_MMA(1, 1, At, B1); PG8_BAR;
            PG8_LDB(B0, 1, 0); PG8_SCHED; PG8_LDA(At, 1, 0); PG8_STAGE(PG8_SA(0, 1), a2 + hstepA, voffA);
            PG8_WAIT_L(8); PG8_BAR; PG8_WAIT_L(0); PG8_MMA(0, 0, At, B0); PG8_BAR; PG8_SCHED;
            PG8_LDB(B1, 1, 1); PG8_STAGE(PG8_SB(1, 0), b3, voffB);
            PG8_BAR; PG8_WAIT_L(0); PG8_MMA(0, 1, At, B1); PG8_BAR;
            PG8_LDA(At, 1, 1); PG8_STAGE(PG8_SA(1, 0), a3, voffA);
            PG8_BAR; PG8_WAIT_L(0); PG8_MMA(1, 0, At, B0); PG8_BAR; PG8_SCHED;
            PG8_STAGE(PG8_SB(1, 1), b3 + hstepB, voffB);
            PG8_WAIT_V(6); PG8_BAR; PG8_MMA(1, 1, At, B1); PG8_BAR;
            }
        }
        if constexpr (ALIGN_EPI) { if (wr == 0) PG8_BAR; }
        if constexpr (!Epi::AFTER_DRAIN) E(acc, cur, wr, wc, fr, fq);
        if (!has_next) break;
#pragma unroll
        for (int a = 0; a < 2; ++a)
#pragma unroll
            for (int b = 0; b < 2; ++b)
#pragma unroll
                for (int m = 0; m < 4; ++m)
#pragma unroll
                    for (int n = 0; n < 2; ++n) acc[a][b][m][n] = (f32x4){0.f, 0.f, 0.f, 0.f};
        cur = nxt; cA = nA; cB = nB; ++ui;
        if constexpr (ALIGN_EPI) { if (wr == 1) PG8_BAR; }
    }
    PG8_WAIT_V(0);
    if constexpr (!ALIGN_EPI) { if (wr == 0) PG8_BAR; }
    PG8_BAR;
    if constexpr (Epi::AFTER_DRAIN) E.fused(acc, cur, wr, wc, fr, fq, lds, wid, lane);
#undef PG8_SA
#undef PG8_SB
#undef PG8_STAGE
#undef PG8_LDA
#undef PG8_LDB
#undef PG8_MMA
#undef PG8_WAIT_V
#undef PG8_WAIT_L
#undef PG8_BAR
#undef PG8_SCHED
}

typedef f32x4 Acc[2][2][4][2];
__device__ __forceinline__ void load_rs(const float* ssp, int row0, int fq, float (&rs)[2][4]) {
#pragma unroll
    for (int ai = 0; ai < 2; ++ai)
#pragma unroll
        for (int m = 0; m < 4; ++m) { const f32x4* pp = (const f32x4*)(ssp + (size_t)(row0 + 128 * ai + 16 * m) * 16); const f32x4 p0 = pp[0], p1 = pp[1], p2 = pp[2], p3 = pp[3];
            const float s = (((p0.x + p0.y) + (p0.z + p0.w)) + ((p1.x + p1.y) + (p1.z + p1.w))) + (((p2.x + p2.y) + (p2.z + p2.w)) + ((p3.x + p3.y) + (p3.z + p3.w)));
            rs[ai][m] = rsqrtf(s * (1.0f / 1024.0f) + EPS); asm volatile("" : "+v"(rs[ai][m]) :: "memory"); }
}
#define ACC8(v, ai, bj, m, sc) do { const f32x4 a0_ = acc[ai][bj][m][0], a1_ = acc[ai][bj][m][1]; v[0] = a0_[0] * (sc); v[1] = a0_[1] * (sc); v[2] = a0_[2] * (sc); v[3] = a0_[3] * (sc); \
        v[4] = a1_[0] * (sc); v[5] = a1_[1] * (sc); v[6] = a1_[2] * (sc); v[7] = a1_[3] * (sc); } while (0)

struct EpiSwiGLU { static constexpr bool PERM = true, AFTER_DRAIN = false; const float* ssp; bf16_t* hid;
    __device__ __forceinline__ void operator()(const Acc& acc, const Unit& u, int wr, int wc, int fr, int fq) const {
        const int row0 = u.pm * 256 + wr * 64 + fr; float rs[2][4]; load_rs(ssp, row0, fq, rs);
#pragma unroll
        for (int ai = 0; ai < 2; ++ai)
#pragma unroll
            for (int m = 0; m < 4; ++m) { float gt[8], up[8], o[8]; ACC8(gt, ai, 0, m, rs[ai][m]); ACC8(up, ai, 1, m, rs[ai][m]);
#pragma unroll
                for (int j = 0; j < 8; ++j) o[j] = gt[j];
                silu8(o);
#pragma unroll
                for (int j = 0; j < 8; ++j) o[j] *= up[j];
                *(u32x4*)(hid + (size_t)(row0 + 128 * ai + 16 * m) * FF + u.pn * 128 + wc * 32 + fq * 8) = pack8(o); }
    }
};
struct EpiResid { static constexpr bool PERM = true, AFTER_DRAIN = false; const bf16_t* baseb; float coef; bf16_t* hb; float* ssp;
    __device__ __forceinline__ void operator()(const Acc& acc, const Unit& u, int wr, int wc, int fr, int fq) const {
        const int row0 = u.pm * 256 + wr * 64 + fr;
#pragma unroll
        for (int ai = 0; ai < 2; ++ai)
#pragma unroll
            for (int m = 0; m < 4; ++m) { const int row = row0 + 128 * ai + 16 * m; float ss = 0.f;
#pragma unroll
                for (int bj = 0; bj < 2; ++bj) { const size_t off = (size_t)row * DM + u.pn * 256 + bj * 128 + wc * 32 + fq * 8; float v[8], bb[8]; ACC8(v, ai, bj, m, coef);
                    unpack8(*(const u32x4*)(baseb + off), bb);
#pragma unroll
                    for (int j = 0; j < 8; ++j) { v[j] += bb[j]; ss += v[j] * v[j]; }
                    *(u32x4*)(hb + off) = pack8(v); }
                ss += __shfl_xor(ss, 16); ss += __shfl_xor(ss, 32);
                if (fq == 0) ssp[(size_t)row * 16 + u.pn * 4 + wc] = ss; }
    }
};
struct EpiPle { static constexpr bool PERM = true, AFTER_DRAIN = false; const float* ssp_in; const bf16_t* pp; const bf16_t* hb; float* out; float* ssp;
    __device__ __forceinline__ void operator()(const Acc& acc, const Unit& u, int wr, int wc, int fr, int fq) const {
        const int row0 = u.pm * 256 + wr * 64 + fr; float rs[2][4]; load_rs(ssp_in, row0, fq, rs);
#pragma unroll
        for (int ai = 0; ai < 2; ++ai)
#pragma unroll
            for (int m = 0; m < 4; ++m) { const int row = row0 + 128 * ai + 16 * m; float ss = 0.f;
#pragma unroll
                for (int bj = 0; bj < 2; ++bj) { const size_t off = (size_t)row * DM + u.pn * 256 + bj * 128 + wc * 32 + fq * 8; float v[8], pv[8], bb[8]; ACC8(v, ai, bj, m, rs[ai][m]);
                    unpack8(*(const u32x4*)(pp + off), pv); unpack8(*(const u32x4*)(hb + off), bb);
#pragma unroll
                    for (int j = 0; j < 8; ++j) { v[j] = bb[j] + fsigmoid(v[j]) * pv[j]; ss += v[j] * v[j]; }
                    *(f32x4*)(out + off) = (f32x4){v[0], v[1], v[2], v[3]}; *(f32x4*)(out + off + 4) = (f32x4){v[4], v[5], v[6], v[7]}; }
                ss += __shfl_xor(ss, 16); ss += __shfl_xor(ss, 32);
                if (fq == 0) ssp[(size_t)row * 16 + u.pn * 4 + wc] = ss; }
    }
};
struct EpiPleFinal { static constexpr bool PERM = true, AFTER_DRAIN = true; const float* ssp_in; const bf16_t* pp; const bf16_t* hb; float* out; const float* fnorm; unsigned* xbuf; unsigned* cnt;
    __device__ __forceinline__ void operator()(const Acc&, const Unit&, int, int, int, int) const {}
    __device__ __forceinline__ void fused(Acc& acc, const Unit& u, int wr, int wc, int fr, int fq, LAS unsigned char* lds, int wid, int lane) const {
        const int row0 = u.pm * 256 + wr * 64 + fr; float rs[2][4]; load_rs(ssp_in, row0, fq, rs);
        LAS float* P = (LAS float*)lds;
        LAS float* Sr = (LAS float*)(lds + 4096);
        LAS unsigned* flag = (LAS unsigned*)(lds + 4096 + 1024);
#pragma unroll
        for (int ai = 0; ai < 2; ++ai)
#pragma unroll
            for (int m = 0; m < 4; ++m) { const int row = row0 + 128 * ai + 16 * m; float ss = 0.f;
#pragma unroll
                for (int bj = 0; bj < 2; ++bj) { const size_t off = (size_t)row * DM + u.pn * 256 + bj * 128 + wc * 32 + fq * 8; float v[8], pv[8], bb[8]; ACC8(v, ai, bj, m, rs[ai][m]);
                    unpack8(*(const u32x4*)(pp + off), pv); unpack8(*(const u32x4*)(hb + off), bb);
#pragma unroll
                    for (int j = 0; j < 8; ++j) { v[j] = bb[j] + fsigmoid(v[j]) * pv[j]; ss += v[j] * v[j]; }
                    acc[ai][bj][m][0] = (f32x4){v[0], v[1], v[2], v[3]}; acc[ai][bj][m][1] = (f32x4){v[4], v[5], v[6], v[7]}; }
                ss += __shfl_xor(ss, 16); ss += __shfl_xor(ss, 32);
                if (fq == 0) P[(128 * ai + 64 * wr + 16 * m + fr) * 4 + wc] = ss; }
        __syncthreads();
        const int tid = wid * 64 + lane;
        if (tid < 256) { const float sum = (P[tid * 4 + 0] + P[tid * 4 + 1]) + (P[tid * 4 + 2] + P[tid * 4 + 3]);
            __hip_atomic_store(xbuf + ((size_t)u.pm * 256 + tid) * 4 + u.pn, __float_as_uint(sum), __ATOMIC_RELAXED, __HIP_MEMORY_SCOPE_AGENT); }
        asm volatile("s_waitcnt vmcnt(0)" ::: "memory");
        if (lane == 0) __hip_atomic_fetch_add(cnt + 64 * u.pm, 1u, __ATOMIC_RELAXED, __HIP_MEMORY_SCOPE_AGENT);
        if (wid == 0) { unsigned sp = 0;
            while ((unsigned)__builtin_amdgcn_readfirstlane(__hip_atomic_load(cnt + 64 * u.pm, __ATOMIC_RELAXED, __HIP_MEMORY_SCOPE_AGENT)) < 32u) { __builtin_amdgcn_s_sleep(2); if (++sp > (1u << 22)) break; }
            __builtin_amdgcn_fence(__ATOMIC_ACQUIRE, "agent");
            if (lane == 0) flag[0] = 1u; }
        asm volatile("s_waitcnt vmcnt(0) lgkmcnt(0)" ::: "memory");
        __syncthreads();
        if (tid < 256) { const unsigned* slot = xbuf + ((size_t)u.pm * 256 + tid) * 4; float s = 0.f;
#pragma unroll
            for (int t = 0; t < 4; ++t) s += __uint_as_float(__hip_atomic_load(slot + t, __ATOMIC_RELAXED, __HIP_MEMORY_SCOPE_AGENT));
            Sr[tid] = rsqrtf(s * (1.0f / 1024.0f) + EPS); }
        __syncthreads();
#pragma unroll
        for (int ai = 0; ai < 2; ++ai)
#pragma unroll
            for (int m = 0; m < 4; ++m) { const int lrow = 128 * ai + 64 * wr + 16 * m + fr; const float r = Sr[lrow];
#pragma unroll
                for (int bj = 0; bj < 2; ++bj) { const int col = u.pn * 256 + bj * 128 + wc * 32 + fq * 8; const size_t off = (size_t)(u.pm * 256 + lrow) * DM + col;
                    const f32x4 g0 = *(const f32x4*)(fnorm + col), g1 = *(const f32x4*)(fnorm + col + 4); const f32x4 a0 = acc[ai][bj][m][0], a1 = acc[ai][bj][m][1];
                    *(f32x4*)(out + off) = (f32x4){a0[0] * r * g0[0], a0[1] * r * g0[1], a0[2] * r * g0[2], a0[3] * r * g0[3]};
                    *(f32x4*)(out + off + 4) = (f32x4){a1[0] * r * g1[0], a1[1] * r * g1[1], a1[2] * r * g1[2], a1[3] * r * g1[3]}; } }
    }
};
template <int MODE> struct EpiBf16 { static constexpr bool PERM = true, AFTER_DRAIN = false; bf16_t* O; const float* ssp; const bf16_t* mul; const bf16_t* add;
    __device__ __forceinline__ void operator()(const Acc& acc, const Unit& u, int wr, int wc, int fr, int fq) const {
        const int row0 = u.pm * 256 + wr * 64 + fr; float rs[2][4];
        if (MODE == 1 || MODE == 4) load_rs(ssp, row0, fq, rs);
#pragma unroll
        for (int ai = 0; ai < 2; ++ai)
#pragma unroll
            for (int m = 0; m < 4; ++m)
#pragma unroll
                for (int bj = 0; bj < 2; ++bj) { const size_t off = (size_t)(row0 + 128 * ai + 16 * m) * DM + u.pn * 256 + bj * 128 + wc * 32 + fq * 8; float v[8];
                    ACC8(v, ai, bj, m, (MODE == 1 ? rs[ai][m] : 1.0f));
                    if (MODE == 1) {
#pragma unroll
                        for (int j = 0; j < 8; ++j) v[j] = fsigmoid(v[j]); }
                    if (MODE == 2 || MODE == 3) { float mv[8]; unpack8(*(const u32x4*)(mul + off), mv);
#pragma unroll
                        for (int j = 0; j < 8; ++j) v[j] *= mv[j]; }
                    if (MODE == 4) { float mv[8]; unpack8(*(const u32x4*)(mul + off), mv);
#pragma unroll
                        for (int j = 0; j < 8; ++j) mv[j] *= rs[ai][m];
                        sigmoid8(mv);
#pragma unroll
                        for (int j = 0; j < 8; ++j) v[j] *= mv[j]; }
                    if (MODE == 3 || MODE == 4) { float av[8]; unpack8(*(const u32x4*)(add + off), av);
#pragma unroll
                        for (int j = 0; j < 8; ++j) v[j] += av[j]; }
                    *(u32x4*)(O + off) = pack8(v); }
    }
};
struct EpiCmp1 { static constexpr bool PERM = true, AFTER_DRAIN = false; bf16_t* chid; const float* bias;
    __device__ __forceinline__ void operator()(const Acc& acc, const Unit& u, int wr, int wc, int fr, int fq) const {
        const int row0 = u.pm * 256 + wr * 64 + fr; const float* bs = bias + (u.pm >> 4) * 256;
#pragma unroll
        for (int bj = 0; bj < 2; ++bj) { const int col = bj * 128 + wc * 32 + fq * 8; const f32x4 b0 = *(const f32x4*)(bs + col), b1 = *(const f32x4*)(bs + col + 4);
            const float bb[8] = {b0[0], b0[1], b0[2], b0[3], b1[0], b1[1], b1[2], b1[3]};
#pragma unroll
            for (int ai = 0; ai < 2; ++ai)
#pragma unroll
                for (int m = 0; m < 4; ++m) { float v[8]; ACC8(v, ai, bj, m, 1.0f);
#pragma unroll
                    for (int j = 0; j < 8; ++j) v[j] = fgelu(v[j] + bb[j]);
                    *(u32x4*)(chid + (size_t)(row0 + 128 * ai + 16 * m) * 256 + col) = pack8(v); } }
    }
};
__device__ __forceinline__ void rope8(float (&v)[8], int fq, const float* cs) {
    const f32x4 c0 = *(const f32x4*)(cs), c1 = *(const f32x4*)(cs + 4), c2 = *(const f32x4*)(cs + 8), c3 = *(const f32x4*)(cs + 12);
    const float cc[8] = {c0[0], c0[2], c1[0], c1[2], c2[0], c2[2], c3[0], c3[2]}, sn[8] = {c0[1], c0[3], c1[1], c1[3], c2[1], c2[3], c3[1], c3[3]};
#pragma unroll
    for (int j = 0; j < 8; ++j) { const float other = __shfl_xor(v[j], 16); v[j] = (fq == 0) ? (v[j] * cc[j] - other * sn[j]) : (v[j] * cc[j] + other * sn[j]); }
}
struct EpiProj { static constexpr bool PERM = true, AFTER_DRAIN = false;
    const float* ssp; const float* rope; bf16_t *ub, *gv, *qraw, *qrot, *kc, *vc, *ks, *kw, *vst, *vwt, *ga; float* vstat; float* gate;
    __device__ __forceinline__ void operator()(const Acc& acc, const Unit& u, int wr, int wc, int fr, int fq) const {
        const int row0 = u.pm * 256 + wr * 64 + fr; float rs[2][4]; load_rs(ssp, row0, fq, rs);
        const int pn = u.pn;
        if (pn < 4) {
#pragma unroll
            for (int ai = 0; ai < 2; ++ai)
#pragma unroll
                for (int m = 0; m < 4; ++m)
#pragma unroll
                    for (int bj = 0; bj < 2; ++bj) { float v[8]; ACC8(v, ai, bj, m, rs[ai][m]);
#pragma unroll
                        for (int j = 0; j < 1; ++j) {}
                        gelu8(v);
                        *(u32x4*)(ub + (size_t)(row0 + 128 * ai + 16 * m) * DM + pn * 256 + bj * 128 + wc * 32 + fq * 8) = pack8(v); }
        } else if (pn >= 18 && pn < 22) {
#pragma unroll
            for (int ai = 0; ai < 2; ++ai)
#pragma unroll
                for (int m = 0; m < 4; ++m)
#pragma unroll
                    for (int bj = 0; bj < 2; ++bj) { float v[8]; ACC8(v, ai, bj, m, rs[ai][m]);
#pragma unroll
                        for (int j = 0; j < 1; ++j) {}
                        sigmoid8(v);
                        *(u32x4*)(ga + (size_t)(row0 + 128 * ai + 16 * m) * DM + (pn - 18) * 256 + bj * 128 + wc * 32 + fq * 8) = pack8(v); }
        } else if (pn < 8) {
#pragma unroll
            for (int ai = 0; ai < 2; ++ai)
#pragma unroll
                for (int m = 0; m < 4; ++m) { const int row = row0 + 128 * ai + 16 * m; float s1 = 0.f, s2 = 0.f;
#pragma unroll
                    for (int bj = 0; bj < 2; ++bj) { float v[8]; ACC8(v, ai, bj, m, rs[ai][m]);
#pragma unroll
                        for (int j = 0; j < 1; ++j) {}
                        gelu8(v);
#pragma unroll
                        for (int j = 0; j < 8; ++j) { s1 += v[j]; s2 += v[j] * v[j]; }
                        *(u32x4*)(gv + (size_t)row * DM + (pn - 4) * 256 + bj * 128 + wc * 32 + fq * 8) = pack8(v); }
                    s1 += __shfl_xor(s1, 16); s1 += __shfl_xor(s1, 32); s2 += __shfl_xor(s2, 16); s2 += __shfl_xor(s2, 32);
                    if (fq == 0) *(f32x2*)(vstat + ((size_t)row * 16 + (pn - 4) * 4 + wc) * 2) = (f32x2){s1, s2}; }
        } else if (pn < 12) {
#pragma unroll
            for (int ai = 0; ai < 2; ++ai)
#pragma unroll
                for (int m = 0; m < 4; ++m) { const int row = row0 + 128 * ai + 16 * m;
#pragma unroll
                    for (int bj = 0; bj < 2; ++bj) { float v[8]; ACC8(v, ai, bj, m, rs[ai][m] * QSCALE);
                        *(u32x4*)(qraw + (size_t)row * DM + (pn - 8) * 256 + bj * 128 + wc * 32 + fq * 8) = pack8(v);
                        if ((wc & 1) == 0) { rope8(v, fq, rope + (size_t)(row & (SEQ - 1)) * 16);
                            const int head = (pn - 8) * 4 + bj * 2 + (wc >> 1);
                            if (fq < 2) *(u32x4*)(qrot + ((size_t)row * 16 + head) * 16 + fq * 8) = pack8(v); } } }
        } else if (pn == 12 || pn == 13 || pn == 14 || pn == 16) {
            bf16_t* O = pn == 12 ? kc : pn == 13 ? vc : pn == 14 ? ks : kw; const bool rot = pn >= 14;
#pragma unroll
            for (int ai = 0; ai < 2; ++ai)
#pragma unroll
                for (int m = 0; m < 4; ++m) { const int row = row0 + 128 * ai + 16 * m;
#pragma unroll
                    for (int bj = 0; bj < 2; ++bj) { float v[8]; ACC8(v, ai, bj, m, rs[ai][m]);
                        if (rot && (wc & 1) == 0) { float w[8];
#pragma unroll
                            for (int j = 0; j < 8; ++j) w[j] = v[j];
                            rope8(w, fq, rope + (size_t)(row & (SEQ - 1)) * 16);
                            if (fq < 2) {
#pragma unroll
                                for (int j = 0; j < 8; ++j) v[j] = w[j]; } }
                        *(u32x4*)(O + (size_t)row * 256 + bj * 128 + wc * 32 + fq * 8) = pack8(v); } }
        } else if (pn == 15 || pn == 17) {
            bf16_t* O = pn == 15 ? vst : vwt;
#pragma unroll
            for (int ai = 0; ai < 2; ++ai)
#pragma unroll
                for (int m = 0; m < 4; ++m) { const int row = row0 + 128 * ai + 16 * m; const int b = row >> 12, t = row & (SEQ - 1);
#pragma unroll
                    for (int bj = 0; bj < 2; ++bj) { float v[8]; ACC8(v, ai, bj, m, rs[ai][m]); const int kvh = bj * 2 + (wc >> 1), d0 = (wc & 1) * 32 + fq * 8;
                        bf16_t* p = O + ((size_t)(b * 4 + kvh) * 64 + d0) * SEQ + t;
#pragma unroll
                        for (int j = 0; j < 8; j += 2) { const unsigned w = cvt_pk_bf16(v[j], v[j + 1]); p[(size_t)j * SEQ] = (bf16_t)(w & 0xffffu); p[(size_t)(j + 1) * SEQ] = (bf16_t)(w >> 16); } } }
        } else {
            if (wc < 2) {
#pragma unroll
                for (int ai = 0; ai < 2; ++ai)
#pragma unroll
                    for (int m = 0; m < 4; ++m) { const int row = row0 + 128 * ai + 16 * m; float v[8]; ACC8(v, ai, 0, m, rs[ai][m]); const int col = wc * 32 + fq * 8;
                        if (col < 48) {
#pragma unroll
                            for (int j = 0; j < 8; ++j) v[j] = fsigmoid(v[j]);
                            *(f32x4*)(gate + (size_t)row * 48 + col) = (f32x4){v[0], v[1], v[2], v[3]}; *(f32x4*)(gate + (size_t)row * 48 + col + 4) = (f32x4){v[4], v[5], v[6], v[7]}; } }
            }
        }
    }
};
}

struct Ctx { LAS unsigned char* lds; int tid, lane, wave, G, bid; };

__device__ __forceinline__ float wave_sum(float v) {
#pragma unroll
    for (int o = 1; o < 64; o <<= 1) v += __shfl_xor(v, o);
    return v;
}
__device__ __forceinline__ int map_row(int map, int n) {
    if (map == 1) { const int up = n >= FF ? 1 : 0, j = n - up * FF; return (j >> 7) * 256 + up * 128 + (j & 127); }
    if (map == 2) { if (n < 4608) return n; if (n < 4656) return 5632 + (n - 4608); if (n < 5680) return 4608 + (n - 4656); return N3 + (n - 5680); }
    return n;
}
constexpr int TR_SCR = 17408;
__device__ __forceinline__ void transpose_item(const float* W, int K, int N, bf16_t* WT, const float* ks, int map, LAS float* scr, int item, int lane) {
    const int nblk = (N + 63) / 64, kb = item / nblk, nb = item % nblk, k0 = 64 * kb, n0 = 64 * nb;
    const int n4 = (lane & 15) * 4, r0 = lane >> 4;
    f32x4 v[16];
#pragma unroll
    for (int i = 0; i < 16; ++i) { const int kk = r0 + 4 * i; v[i] = (f32x4){0.f, 0.f, 0.f, 0.f}; if (n0 + n4 < N) v[i] = *(const f32x4*)(W + (size_t)(k0 + kk) * N + n0 + n4); }
#pragma unroll
    for (int i = 0; i < 16; ++i) { const int kk = r0 + 4 * i; const float sc = ks ? ks[k0 + kk] : 1.0f; LAS float* d = scr + kk * 65 + n4;
        d[0] = v[i].x * sc; d[1] = v[i].y * sc; d[2] = v[i].z * sc; d[3] = v[i].w * sc; }
    LDS_FENCE();
    const int c = lane >> 3, nl = lane & 7;
#pragma unroll
    for (int j = 0; j < 8; ++j) { const int nn = nl + 8 * j, n = n0 + nn;
        if (n < N) { const LAS float* s0 = scr + (8 * c) * 65 + nn;
            u32x4 o; o.x = cvt_pk_bf16(s0[0 * 65], s0[1 * 65]); o.y = cvt_pk_bf16(s0[2 * 65], s0[3 * 65]); o.z = cvt_pk_bf16(s0[4 * 65], s0[5 * 65]); o.w = cvt_pk_bf16(s0[6 * 65], s0[7 * 65]);
            *(u32x4*)(WT + (size_t)map_row(map, n) * K + k0 + 8 * c) = o; } }
    LDS_FENCE();
}
struct TJob { const float* W; int K, N; bf16_t* dst; const float* ks; int map; };
__device__ __forceinline__ int tjob_items(const TJob& j) { return (j.K / 64) * ((j.N + 63) / 64); }

struct Args {
    const float* in[27]; float* out; unsigned char* ws; int ph_lo, ph_hi;
};
enum { I_X = 0, I_P, I_F1N, I_F1WI, I_F1WO, I_MIXN, I_WIN, I_LNG, I_LNB, I_GWS, I_GBS, I_WA, I_CPK, I_CKW1, I_CKW2, I_CPV, I_CVW1, I_CVW2, I_WB, I_WO,
       I_F2N, I_F2WI, I_F2WO, I_PLEN, I_PLEG, I_PLEP, I_FIN };

__device__ __forceinline__ void run_tjobs(const Ctx& C, const TJob* jobs, int njobs) {
    LAS float* scr = (LAS float*)(C.lds + C.wave * TR_SCR);
    const int gw = C.bid * 8 + C.wave, NGW = C.G * 8;
    int total = 0;
    for (int j = 0; j < njobs; ++j) total += tjob_items(jobs[j]);
    for (int it = gw; it < total; it += NGW) { int r = it;
        for (int j = 0; j < njobs; ++j) { const int n = tjob_items(jobs[j]); if (r < n) { transpose_item(jobs[j].W, jobs[j].K, jobs[j].N, jobs[j].dst, jobs[j].ks, jobs[j].map, scr, r, C.lane); break; } r -= n; } }
}

__device__ __forceinline__ void p0_prologue(const Ctx& C, const Args& a) {
    unsigned char* ws = a.ws;
    {
        const int gw = C.bid * 8 + C.wave, NGW = C.G * 8;
        LAS float* scr = (LAS float*)(C.lds + C.wave * TR_SCR);
        for (int it = gw; it < 5136; it += NGW) { int r = it;
            if (r < 1408) { transpose_item(a.in[I_F1WI], 1024, 5632, (bf16_t*)(ws + WS_WFIN), a.in[I_F1N], 1, scr, r, C.lane); continue; } r -= 1408;
            if (r < 704) { transpose_item(a.in[I_F1WO], 2816, 1024, (bf16_t*)(ws + WS_WFOUT), nullptr, 0, scr, r, C.lane); continue; } r -= 704;
            if (r < 1680) { transpose_item(a.in[I_WIN], 1024, 6704, (bf16_t*)(ws + WS_WIN), a.in[I_MIXN], 2, scr, r, C.lane); continue; } r -= 1680;
            if (r < 256) { transpose_item(a.in[I_WA], 1024, 1024, (bf16_t*)(ws + WS_WA), nullptr, 0, scr, r, C.lane); continue; } r -= 256;
            if (r < 256) { transpose_item(a.in[I_WB], 1024, 1024, (bf16_t*)(ws + WS_WB), nullptr, 0, scr, r, C.lane); continue; } r -= 256;
            if (r < 256) { transpose_item(a.in[I_WO], 1024, 1024, (bf16_t*)(ws + WS_WO), nullptr, 0, scr, r, C.lane); continue; } r -= 256;
            if (r < 256) { transpose_item(a.in[I_PLEG], 1024, 1024, (bf16_t*)(ws + WS_WPG), a.in[I_PLEN], 0, scr, r, C.lane); continue; } r -= 256;
            if (r < 64) { transpose_item(a.in[I_PLEP], 256, 1024, (bf16_t*)(ws + WS_WPP), nullptr, 0, scr, r, C.lane); continue; } r -= 64;
            if (r < 128) { transpose_item(a.in[I_CKW1], 2048, 256, (bf16_t*)(ws + WS_WC1), nullptr, 0, scr, r, C.lane); continue; } r -= 128;
            transpose_item(a.in[I_CVW1], 2048, 256, (bf16_t*)(ws + WS_WC1) + 256 * 2048, nullptr, 0, scr, r, C.lane);
        }
        const float* x = a.in[I_X]; bf16_t* xb = (bf16_t*)(ws + WS_XB); float* ssa = (float*)(ws + WS_SSA);
        for (int r = gw; r < T; r += NGW) { const f32x4* xr = (const f32x4*)(x + (size_t)r * DM) + C.lane; float s = 0.f; f32x4 v[4];
#pragma unroll
            for (int j = 0; j < 4; ++j) { v[j] = xr[64 * j]; s += (v[j].x * v[j].x + v[j].y * v[j].y) + (v[j].z * v[j].z + v[j].w * v[j].w); }
            s = wave_sum(s);
            u32x2* o = (u32x2*)(xb + (size_t)r * DM) + C.lane;
#pragma unroll
            for (int j = 0; j < 4; ++j) o[64 * j] = (u32x2){cvt_pk_bf16(v[j].x, v[j].y), cvt_pk_bf16(v[j].z, v[j].w)};
            if (C.lane < 16) ssa[(size_t)r * 16 + C.lane] = C.lane == 0 ? s : 0.f; }
        float* cb = (float*)(ws + WS_CBIAS);
        for (int it = gw; it < 64; it += NGW) { const int tsr = it >> 5, n0 = (it & 31) * 8; const float* pos = a.in[tsr ? I_CPV : I_CPK]; const float* w1 = a.in[tsr ? I_CVW1 : I_CKW1];
            float acc8[8] = {0.f, 0.f, 0.f, 0.f, 0.f, 0.f, 0.f, 0.f};
            for (int i = 0; i < 32; ++i) { const int k = C.lane + 64 * i; const float pk = pos[k]; const f32x4 w0 = *(const f32x4*)(w1 + (size_t)k * 256 + n0), w4 = *(const f32x4*)(w1 + (size_t)k * 256 + n0 + 4);
                acc8[0] += pk * w0[0]; acc8[1] += pk * w0[1]; acc8[2] += pk * w0[2]; acc8[3] += pk * w0[3]; acc8[4] += pk * w4[0]; acc8[5] += pk * w4[1]; acc8[6] += pk * w4[2]; acc8[7] += pk * w4[3]; }
#pragma unroll
            for (int j = 0; j < 8; ++j) { const float s = wave_sum(acc8[j]); if (C.lane == 0) cb[tsr * 256 + n0 + j] = s; } }
    }
    const int gt = C.bid * 512 + C.tid, NGT = C.G * 512;
    {
        float* rope = (float*)(ws + WS_ROPE);
        for (int e = gt; e < SEQ * 8; e += NGT) { const int t = e >> 3, i = e & 7;
            const float invf = i == 0 ? 1.0f : i == 1 ? 0.1939227432012558f : i == 2 ? 0.03760603070259094f : i == 3 ? 0.007292664609849453f : i == 4 ? 0.0014142135623842478f : i == 5 ? 0.00027424818836152554f : i == 6 ? 5.318296098266728e-05f : 1.0313386155758053e-05f;
            const float angf = (float)t * invf; const double ang = (double)angf;
            const double qd = __builtin_rint(ang * 0.63661977236758134308); const double r = (ang - qd * 1.5707963267948966192) - qd * 6.123233995736766e-17; const int qi = ((int)qd) & 3;
            const double r2 = r * r;
            const double sr = r * (1.0 + r2 * (-1.0 / 6 + r2 * (1.0 / 120 + r2 * (-1.0 / 5040 + r2 * (1.0 / 362880 + r2 * (-1.0 / 39916800 + r2 * (1.0 / 6227020800.0)))))));
            const double cr = 1.0 + r2 * (-0.5 + r2 * (1.0 / 24 + r2 * (-1.0 / 720 + r2 * (1.0 / 40320 + r2 * (-1.0 / 3628800 + r2 * (1.0 / 479001600.0 + r2 * (-1.0 / 87178291200.0)))))));
            const double sn = qi == 0 ? sr : qi == 1 ? cr : qi == 2 ? -sr : -cr, cs = qi == 0 ? cr : qi == 1 ? -sr : qi == 2 ? -cr : sr;
            rope[e * 2] = (float)cs; rope[e * 2 + 1] = (float)sn; }
    }
    {
        const float* w = a.in[I_GWS]; bf16_t* o = (bf16_t*)(ws + WS_GMW);
        for (int e = gt; e < 8 * 128 * 128; e += NGT) { const int t = (e >> 7) & 127, s = e & 127; const float v = s <= t ? w[e] : 0.f; o[e] = (bf16_t)(cvt_pk_bf16(v, 0.f) & 0xffffu); }
    }
}

__device__ __forceinline__ void p8_extras(const Ctx& C, const Args& a) {
    unsigned char* ws = a.ws; const int gw = C.bid * 8 + C.wave, NGW = C.G * 8;
    LAS float* scr = (LAS float*)(C.lds + C.wave * TR_SCR);
    for (int it = gw; it < 2112; it += NGW) { int r = it;
        if (r < 1408) { transpose_item(a.in[I_F2WI], 1024, 5632, (bf16_t*)(ws + WS_WFIN), a.in[I_F2N], 1, scr, r, C.lane); continue; } r -= 1408;
        transpose_item(a.in[I_F2WO], 2816, 1024, (bf16_t*)(ws + WS_WFOUT), nullptr, 0, scr, r, C.lane); }
    const float* p = a.in[I_P]; bf16_t* pb = (bf16_t*)(ws + WS_PB);
    for (int r = gw; r < T; r += NGW) { const f32x4 v = ((const f32x4*)(p + (size_t)r * PLE))[C.lane]; ((u32x2*)(pb + (size_t)r * PLE))[C.lane] = (u32x2){cvt_pk_bf16(v.x, v.y), cvt_pk_bf16(v.z, v.w)}; }
}

__device__ __forceinline__ void gmlp_job(const Ctx& C, const Args& a, int job) {
    unsigned char* ws = a.ws; const int g = job & 7, chunk = job >> 3; const int tok0 = chunk * 128;
    const bf16_t* gv = (const bf16_t*)(ws + WS_GV); bf16_t* ub = (bf16_t*)(ws + WS_UB); const float* vstat = (const float*)(ws + WS_VSTAT); const bf16_t* gmw = (const bf16_t*)(ws + WS_GMW);
    LAS bf16_t* vnT = (LAS bf16_t*)C.lds;
    const int wr = C.wave >> 1, wc = C.wave & 1, n = C.lane & 31, hi = C.lane >> 5;
    bf16x8 af[8];
    {   const bf16_t* wrow = gmw + ((size_t)g * 128 + wr * 32 + n) * 128 + 8 * hi;
#pragma unroll
        for (int k0 = 0; k0 < 8; ++k0) af[k0] = *(const bf16x8*)(wrow + 16 * k0); }
    {   const int s = C.tid >> 2, cq = C.tid & 3; const size_t row = (size_t)tok0 + s;
        float s1 = 0.f, s2 = 0.f;
#pragma unroll
        for (int k = 0; k < 8; ++k) { const f32x4 p = *(const f32x4*)(vstat + row * 32 + 4 * k); s1 += p.x + p.z; s2 += p.y + p.w; }
        const float mean = s1 * (1.0f / 1024.0f), var = s2 * (1.0f / 1024.0f) - mean * mean, rstd = rsqrtf(var + EPS);
        const float* lng = a.in[I_LNG] + g * 128 + cq * 32; const float* lnb = a.in[I_LNB] + g * 128 + cq * 32;
#pragma unroll
        for (int c8 = 0; c8 < 4; ++c8) { float v[8]; unpack8(*(const u32x4*)(gv + row * DM + g * 128 + cq * 32 + c8 * 8), v);
#pragma unroll
            for (int j = 0; j < 8; ++j) { const float y = (v[j] - mean) * rstd * lng[c8 * 8 + j] + lnb[c8 * 8 + j]; vnT[(cq * 32 + c8 * 8 + j) * 136 + s] = (bf16_t)(cvt_pk_bf16(y, 0.f) & 0xffffu); } }
    }
    __syncthreads();
    {   f32x16 acc0 = {}, acc1 = {};
        const LAS bf16_t* b0p = vnT + (wc * 64 + n) * 136 + 8 * hi; const LAS bf16_t* b1p = b0p + 32 * 136;
#pragma unroll
        for (int k0 = 0; k0 < 8; ++k0) if (k0 < 2 * (wr + 1)) { const bf16x8 bf0 = *(const LAS bf16x8*)(b0p + 16 * k0), bf1 = *(const LAS bf16x8*)(b1p + 16 * k0);
            acc0 = __builtin_amdgcn_mfma_f32_32x32x16_bf16(af[k0], bf0, acc0, 0, 0, 0); acc1 = __builtin_amdgcn_mfma_f32_32x32x16_bf16(af[k0], bf1, acc1, 0, 0, 0); }
        const float* bs = a.in[I_GBS] + g * 128 + wr * 32;
#pragma unroll
        for (int r = 0; r < 16; ++r) { const int tl = (r & 3) + 8 * (r >> 2) + 4 * hi; const float bias = bs[tl]; const size_t off = ((size_t)tok0 + wr * 32 + tl) * DM + g * 128 + wc * 64 + n;
            const float u0 = bf2f(ub[off]), u1 = bf2f(ub[off + 32]);
            ub[off] = (bf16_t)(cvt_pk_bf16(u0 * (acc0[r] + bias), 0.f) & 0xffffu); ub[off + 32] = (bf16_t)(cvt_pk_bf16(u1 * (acc1[r] + bias), 0.f) & 0xffffu); }
    }
    __syncthreads();
}

__device__ __forceinline__ void cmp2_phase(const Ctx& C, const Args& a) {
    unsigned char* ws = a.ws; const bf16_t* chid = (const bf16_t*)(ws + WS_CHID); bf16_t* kcmp = (bf16_t*)(ws + WS_KCMP); bf16_t* vcmpT = (bf16_t*)(ws + WS_VCMPT);
    const int gw = C.bid * 8 + C.wave, NGW = C.G * 8;
    for (int it = gw; it < 2048; it += NGW) { const int tsr = it >> 10, R0 = (it & 1023) * 4;
        const float* w2 = a.in[tsr ? I_CVW2 : I_CKW2]; const bf16_t* hr = chid + ((size_t)tsr * 4096 + R0) * 256;
        float acc[4] = {0.f, 0.f, 0.f, 0.f};
        for (int k8 = 0; k8 < 32; ++k8) { float wv[8];
#pragma unroll
            for (int j = 0; j < 8; ++j) wv[j] = w2[(k8 * 8 + j) * 64 + C.lane];
#pragma unroll
            for (int rr = 0; rr < 4; ++rr) { float hv[8]; unpack8(*(const u32x4*)(hr + rr * 256 + k8 * 8), hv);
#pragma unroll
                for (int j = 0; j < 8; ++j) acc[rr] += hv[j] * wv[j]; } }
#pragma unroll
        for (int rr = 0; rr < 4; ++rr) { const int R = R0 + rr; const int h = R >> 10, b = (R >> 8) & 3, i = R & 255;
            const bf16_t o = (bf16_t)(cvt_pk_bf16(i == 255 ? 0.f : acc[rr], 0.f) & 0xffffu);
            if (tsr == 0) kcmp[((size_t)(b * 4 + h) * 256 + i) * 64 + C.lane] = o; else vcmpT[((size_t)(b * 4 + h) * 64 + C.lane) * 256 + i] = o; } }
}

__device__ __forceinline__ void final_phase(const Ctx& C, const Args& a) {
    const float* ssa = (const float*)(a.ws + WS_SSA); const float* fn = a.in[I_FIN]; const int gw = C.bid * 8 + C.wave, NGW = C.G * 8;
    for (int r = gw; r < T; r += NGW) { float s = C.lane < 16 ? ssa[(size_t)r * 16 + C.lane] : 0.f; s = wave_sum(s); const float rstd = rsqrtf(s * (1.0f / 1024.0f) + EPS);
        f32x4* o = (f32x4*)(a.out + (size_t)r * DM) + C.lane; const f32x4* gp = (const f32x4*)fn + C.lane;
#pragma unroll
        for (int j = 0; j < 4; ++j) { const f32x4 v = o[64 * j], gg = gp[64 * j]; o[64 * j] = (f32x4){v.x * rstd * gg.x, v.y * rstd * gg.y, v.z * rstd * gg.z, v.w * rstd * gg.w}; } }
}

namespace att {
constexpr int ROWB = 144;
constexpr int TILEB = 64 * ROWB;
constexpr int OFF_K = 0, OFF_V = 2 * TILEB, OFF_PC = 4 * TILEB, PCROW = 260, OFF_WSF = OFF_PC + 64 * PCROW * 4, OFF_SELM = OFF_WSF + 8 * 64 * 4, LDS_END = OFF_SELM + 64 * 8;
static_assert(LDS_END <= 131072, "attention LDS");
__device__ __forceinline__ int crow(int r, int hi) { return (r & 3) + 8 * (r >> 2) + 4 * hi; }

struct Stream { const bf16_t* K; size_t kstride; const bf16_t* V; size_t vstride; };

struct State { float m, l; f32x16 o0, o1; };

struct Pre { u32x4 k0, v0, k1; };
__device__ __forceinline__ Pre prefetch(int tid, const Stream& S, int t0, int nt, bool needv) {
    const int lr = tid >> 3, lc = tid & 7; Pre p;
    const bf16_t* kg = S.K + (size_t)(t0 * 64 + lr) * S.kstride + lc * 8;
    p.k0 = *(const u32x4*)kg; p.v0 = (u32x4){0u, 0u, 0u, 0u}; p.k1 = p.v0;
    if (needv) p.v0 = *(const u32x4*)(S.V + (size_t)lr * S.vstride + (size_t)t0 * 64 + lc * 8);
    if (nt > 1) p.k1 = *(const u32x4*)(kg + (size_t)64 * S.kstride);
    return p;
}
template <int MODE>
__device__ __forceinline__ void run_branch(int tid, LAS unsigned char* lds, const Stream& S, const Pre& pre, int t0, int nt, const bf16x8 (&qf)[4], int klo, int khi, unsigned long long selbits,
                                           State& st, float inv_l, int tokl, int g) {
    const int lane = tid & 63, q = lane & 31, hi = lane >> 5, wid = __builtin_amdgcn_readfirstlane(tid >> 6);
    const int lr = tid >> 3, lc = tid & 7;
    const int pim = 16 * (q >> 4) + 8 * ((q >> 2) & 1) + 4 * ((q >> 3) & 1) + (q & 3);
    LAS float* wsf = (LAS float*)(lds + OFF_WSF) + wid * 64;
    LAS float* pc = (LAS float*)(lds + OFF_PC);
    const bf16_t* kg = S.K + (size_t)(t0 * 64 + lr) * S.kstride + lc * 8;
    const bf16_t* vg = S.V + (size_t)lr * S.vstride + (size_t)t0 * 64 + lc * 8;
    const unsigned sto = lr * ROWB + lc * 16;
    u32x4 kreg = pre.k1, vreg = pre.v0;
    *(LAS u32x4*)(lds + OFF_K + sto) = pre.k0; if (MODE != 1) *(LAS u32x4*)(lds + OFF_V + sto) = pre.v0;
    if (nt > 1) *(LAS u32x4*)(lds + OFF_K + TILEB + sto) = pre.k1;
    __syncthreads();
    const LAS unsigned char* kfb = lds + OFF_K + pim * ROWB + hi * 16;
    f32x16 p0 = {}, p1 = {};
#pragma unroll
    for (int d0 = 0; d0 < 4; ++d0) { const bf16x8 a0 = *(const LAS bf16x8*)(kfb + d0 * 32), a1 = *(const LAS bf16x8*)(kfb + 32 * ROWB + d0 * 32);
        p0 = __builtin_amdgcn_mfma_f32_32x32x16_bf16(a0, qf[d0], p0, 0, 0, 0); p1 = __builtin_amdgcn_mfma_f32_32x32x16_bf16(a1, qf[d0], p1, 0, 0, 0); }
    f32x16 q0 = {}, q1 = {};
    for (int t = 0; t < nt; t += 2) {
        {   const int jt = t0 + t; constexpr int buf = 0;
        if (t + 2 < nt) kreg = *(const u32x4*)(kg + (size_t)(t + 2) * 64 * S.kstride);
        if (MODE != 1 && t + 1 < nt) vreg = *(const u32x4*)(vg + (size_t)(t + 1) * 64);
        const int kb0 = jt * 64;
        const bool bit = (selbits >> jt) & 1ull;
        const bool none = !bit || kb0 > khi || kb0 + 63 < klo;
        const bool allv = bit && kb0 >= klo && kb0 + 63 <= khi;
        const bool colv = !none;
        if (__any(colv && !allv)) {
            const int hr = khi - kb0 - 8 * hi, lrr = klo - kb0 - 8 * hi;
#pragma unroll
            for (int r = 0; r < 16; ++r) { const int c = 16 * (r >> 3) + (r & 7);
                if (!(c <= hr && c >= lrr)) p0[r] = -__builtin_inff();
                if (!(c + 32 <= hr && c + 32 >= lrr)) p1[r] = -__builtin_inff(); }
        }
        float tm = fmaxf(fmaxf(p0[0], p0[1]), p0[2]);
#pragma unroll
        for (int r = 3; r < 15; r += 2) tm = fmaxf(fmaxf(tm, p0[r]), p0[r + 1]);
        tm = fmaxf(tm, p0[15]);
#pragma unroll
        for (int r = 0; r < 16; r += 2) tm = fmaxf(fmaxf(tm, p1[r]), p1[r + 1]);
        tm = fmaxf(tm, __shfl_xor(tm, 32));
        if (!colv) tm = -__builtin_inff();
        float mref;
        if (MODE == 2) { mref = st.m; }
        else {
            if (__any(tm > st.m + 8.0f)) {
                const float mn = fmaxf(st.m, tm); const float alpha = __builtin_amdgcn_exp2f(st.m - mn); st.l *= alpha; st.m = mn;
                if (MODE == 0) { if (hi == 0) wsf[q] = alpha; LDS_FENCE();
#pragma unroll
                    for (int r = 0; r < 16; ++r) { const float f = wsf[crow(r, hi)]; st.o0[r] *= f; st.o1[r] *= f; }
                    LDS_FENCE(); }
            }
            mref = st.m;
        }
        const float msub = colv ? mref : __builtin_inff();
        q0 = (f32x16){}; q1 = (f32x16){};
        {   const LAS unsigned char* kb = kfb + (buf ^ 1) * TILEB;
#pragma unroll
            for (int d0 = 0; d0 < 4; ++d0) { const bf16x8 a0 = *(const LAS bf16x8*)(kb + d0 * 32), a1 = *(const LAS bf16x8*)(kb + 32 * ROWB + d0 * 32);
                q0 = __builtin_amdgcn_mfma_f32_32x32x16_bf16(a0, qf[d0], q0, 0, 0, 0); q1 = __builtin_amdgcn_mfma_f32_32x32x16_bf16(a1, qf[d0], q1, 0, 0, 0); } }
        float ls = 0.f;
#pragma unroll
        for (int r = 0; r < 16; ++r) { p0[r] = __builtin_amdgcn_exp2f(p0[r] - msub); p1[r] = __builtin_amdgcn_exp2f(p1[r] - msub); ls += p0[r] + p1[r]; }
        if (MODE != 2) st.l += ls;
        if (MODE == 2) {
#pragma unroll
            for (int r = 0; r < 16; ++r) { p0[r] *= inv_l; p1[r] *= inv_l; }
            float hs0[16], hs1[16];
#pragma unroll
            for (int r = 0; r < 16; ++r) { hs0[r] = quad_sum(p0[r]); hs1[r] = quad_sum(p1[r]); }
            if (g == 0) { LAS float* pr = pc + tokl * PCROW + kb0 + 8 * hi;
#pragma unroll
                for (int r = 0; r < 16; ++r) { pr[16 * (r >> 3) + (r & 7)] = hs0[r]; pr[16 * (r >> 3) + (r & 7) + 32] = hs1[r]; } }
        }
        if (MODE != 1) {
            bf16x8 pa[4];
            {   u32x4 w;
                w.x = cvt_pk_bf16(p0[0], p0[1]); w.y = cvt_pk_bf16(p0[2], p0[3]); w.z = cvt_pk_bf16(p0[4], p0[5]); w.w = cvt_pk_bf16(p0[6], p0[7]); pa[0] = __builtin_bit_cast(bf16x8, w);
                w.x = cvt_pk_bf16(p0[8], p0[9]); w.y = cvt_pk_bf16(p0[10], p0[11]); w.z = cvt_pk_bf16(p0[12], p0[13]); w.w = cvt_pk_bf16(p0[14], p0[15]); pa[1] = __builtin_bit_cast(bf16x8, w);
                w.x = cvt_pk_bf16(p1[0], p1[1]); w.y = cvt_pk_bf16(p1[2], p1[3]); w.z = cvt_pk_bf16(p1[4], p1[5]); w.w = cvt_pk_bf16(p1[6], p1[7]); pa[2] = __builtin_bit_cast(bf16x8, w);
                w.x = cvt_pk_bf16(p1[8], p1[9]); w.y = cvt_pk_bf16(p1[10], p1[11]); w.z = cvt_pk_bf16(p1[12], p1[13]); w.w = cvt_pk_bf16(p1[14], p1[15]); pa[3] = __builtin_bit_cast(bf16x8, w); }
            const LAS unsigned char* vb = lds + OFF_V + buf * TILEB + q * ROWB + hi * 16;
#pragma unroll
            for (int c = 0; c < 4; ++c) { const bf16x8 v0 = *(const LAS bf16x8*)(vb + c * 32), v1 = *(const LAS bf16x8*)(vb + 32 * ROWB + c * 32);
                st.o0 = __builtin_amdgcn_mfma_f32_32x32x16_bf16(pa[c], v0, st.o0, 0, 0, 0); st.o1 = __builtin_amdgcn_mfma_f32_32x32x16_bf16(pa[c], v1, st.o1, 0, 0, 0); }
        }
        if (t + 2 < nt) *(LAS u32x4*)(lds + OFF_K + buf * TILEB + sto) = kreg;
        if (MODE != 1 && t + 1 < nt) *(LAS u32x4*)(lds + OFF_V + (buf ^ 1) * TILEB + sto) = vreg;
        __syncthreads();
        }
        if (t + 1 < nt) { const int t_ = t; { const int t = t_ + 1; const int jt = t0 + t; constexpr int buf = 1;
        if (t + 2 < nt) kreg = *(const u32x4*)(kg + (size_t)(t + 2) * 64 * S.kstride);
        if (MODE != 1 && t + 1 < nt) vreg = *(const u32x4*)(vg + (size_t)(t + 1) * 64);
        const int kb0 = jt * 64;
        const bool bit = (selbits >> jt) & 1ull;
        const bool none = !bit || kb0 > khi || kb0 + 63 < klo;
        const bool allv = bit && kb0 >= klo && kb0 + 63 <= khi;
        const bool colv = !none;
        if (__any(colv && !allv)) {
            const int hr = khi - kb0 - 8 * hi, lrr = klo - kb0 - 8 * hi;
#pragma unroll
            for (int r = 0; r < 16; ++r) { const int c = 16 * (r >> 3) + (r & 7);
                if (!(c <= hr && c >= lrr)) q0[r] = -__builtin_inff();
                if (!(c + 32 <= hr && c + 32 >= lrr)) q1[r] = -__builtin_inff(); }
        }
        float tm = fmaxf(fmaxf(q0[0], q0[1]), q0[2]);
#pragma unroll
        for (int r = 3; r < 15; r += 2) tm = fmaxf(fmaxf(tm, q0[r]), q0[r + 1]);
        tm = fmaxf(tm, q0[15]);
#pragma unroll
        for (int r = 0; r < 16; r += 2) tm = fmaxf(fmaxf(tm, q1[r]), q1[r + 1]);
        tm = fmaxf(tm, __shfl_xor(tm, 32));
        if (!colv) tm = -__builtin_inff();
        float mref;
        if (MODE == 2) { mref = st.m; }
        else {
            if (__any(tm > st.m + 8.0f)) {
                const float mn = fmaxf(st.m, tm); const float alpha = __builtin_amdgcn_exp2f(st.m - mn); st.l *= alpha; st.m = mn;
                if (MODE == 0) { if (hi == 0) wsf[q] = alpha; LDS_FENCE();
#pragma unroll
                    for (int r = 0; r < 16; ++r) { const float f = wsf[crow(r, hi)]; st.o0[r] *= f; st.o1[r] *= f; }
                    LDS_FENCE(); }
            }
            mref = st.m;
        }
        const float msub = colv ? mref : __builtin_inff();
        p0 = (f32x16){}; p1 = (f32x16){};
        {   const LAS unsigned char* kb = kfb + (buf ^ 1) * TILEB;
#pragma unroll
            for (int d0 = 0; d0 < 4; ++d0) { const bf16x8 a0 = *(const LAS bf16x8*)(kb + d0 * 32), a1 = *(const LAS bf16x8*)(kb + 32 * ROWB + d0 * 32);
                p0 = __builtin_amdgcn_mfma_f32_32x32x16_bf16(a0, qf[d0], p0, 0, 0, 0); p1 = __builtin_amdgcn_mfma_f32_32x32x16_bf16(a1, qf[d0], p1, 0, 0, 0); } }
        float ls = 0.f;
#pragma unroll
        for (int r = 0; r < 16; ++r) { q0[r] = __builtin_amdgcn_exp2f(q0[r] - msub); q1[r] = __builtin_amdgcn_exp2f(q1[r] - msub); ls += q0[r] + q1[r]; }
        if (MODE != 2) st.l += ls;
        if (MODE == 2) {
#pragma unroll
            for (int r = 0; r < 16; ++r) { q0[r] *= inv_l; q1[r] *= inv_l; }
            float hs0[16], hs1[16];
#pragma unroll
            for (int r = 0; r < 16; ++r) { hs0[r] = quad_sum(q0[r]); hs1[r] = quad_sum(q1[r]); }
            if (g == 0) { LAS float* pr = pc + tokl * PCROW + kb0 + 8 * hi;
#pragma unroll
                for (int r = 0; r < 16; ++r) { pr[16 * (r >> 3) + (r & 7)] = hs0[r]; pr[16 * (r >> 3) + (r & 7) + 32] = hs1[r]; } }
        }
        if (MODE != 1) {
            bf16x8 pa[4];
            {   u32x4 w;
                w.x = cvt_pk_bf16(q0[0], q0[1]); w.y = cvt_pk_bf16(q0[2], q0[3]); w.z = cvt_pk_bf16(q0[4], q0[5]); w.w = cvt_pk_bf16(q0[6], q0[7]); pa[0] = __builtin_bit_cast(bf16x8, w);
                w.x = cvt_pk_bf16(q0[8], q0[9]); w.y = cvt_pk_bf16(q0[10], q0[11]); w.z = cvt_pk_bf16(q0[12], q0[13]); w.w = cvt_pk_bf16(q0[14], q0[15]); pa[1] = __builtin_bit_cast(bf16x8, w);
                w.x = cvt_pk_bf16(q1[0], q1[1]); w.y = cvt_pk_bf16(q1[2], q1[3]); w.z = cvt_pk_bf16(q1[4], q1[5]); w.w = cvt_pk_bf16(q1[6], q1[7]); pa[2] = __builtin_bit_cast(bf16x8, w);
                w.x = cvt_pk_bf16(q1[8], q1[9]); w.y = cvt_pk_bf16(q1[10], q1[11]); w.z = cvt_pk_bf16(q1[12], q1[13]); w.w = cvt_pk_bf16(q1[14], q1[15]); pa[3] = __builtin_bit_cast(bf16x8, w); }
            const LAS unsigned char* vb = lds + OFF_V + buf * TILEB + q * ROWB + hi * 16;
#pragma unroll
            for (int c = 0; c < 4; ++c) { const bf16x8 v0 = *(const LAS bf16x8*)(vb + c * 32), v1 = *(const LAS bf16x8*)(vb + 32 * ROWB + c * 32);
                st.o0 = __builtin_amdgcn_mfma_f32_32x32x16_bf16(pa[c], v0, st.o0, 0, 0, 0); st.o1 = __builtin_amdgcn_mfma_f32_32x32x16_bf16(pa[c], v1, st.o1, 0, 0, 0); }
        }
        if (t + 2 < nt) *(LAS u32x4*)(lds + OFF_K + buf * TILEB + sto) = kreg;
        if (MODE != 1 && t + 1 < nt) *(LAS u32x4*)(lds + OFF_V + (buf ^ 1) * TILEB + sto) = vreg;
        __syncthreads();
        } }
    }
}

struct Tensors { const bf16_t *qraw, *qrot, *ks, *kw, *vst, *vwt, *kcmp, *vcmpT; const float* gate; bf16_t* ob; };

template <bool FIRST>
__device__ __forceinline__ void fold(LAS float* wsf, LAS float* oacc, int q, int hi, float fac, const State& st) {
    if (hi == 0) wsf[q] = fac; LDS_FENCE();
#pragma unroll
    for (int r = 0; r < 16; ++r) { const int row = crow(r, hi); const float f = wsf[row]; LAS float* p = oacc + row * 64 + q;
        if (FIRST) { p[0] = st.o0[r] * f; p[32] = st.o1[r] * f; } else { p[0] += st.o0[r] * f; p[32] += st.o1[r] * f; } }
    LDS_FENCE();
}

__device__ __forceinline__ void job(LAS unsigned char* lds, const Tensors& X, int b, int kvh, int qb) {
    int tid_ = threadIdx.x; asm volatile("" : "+v"(tid_));
    const int tid = tid_, lane = tid & 63, q = lane & 31, hi = lane >> 5, wid = __builtin_amdgcn_readfirstlane(tid >> 6);
    const int tokl = 8 * wid + (q >> 2), g = q & 3, tq = 64 * qb + tokl, head = 4 * kvh + g;
    const size_t trow = (size_t)b * SEQ + tq;
    LAS float* wsf = (LAS float*)(lds + OFF_WSF) + wid * 64;
    LAS float* pc = (LAS float*)(lds + OFF_PC);
    LAS unsigned long long* selm = (LAS unsigned long long*)(lds + OFF_SELM);
    bf16x8 qf[4];
    {   const bf16_t* qp = X.qraw + trow * DM + head * 64 + 8 * hi;
#pragma unroll
        for (int d0 = 0; d0 < 4; ++d0) qf[d0] = *(const bf16x8*)(qp + 16 * d0); }
    const float g0 = X.gate[trow * 48 + head * 3 + 0], g1 = X.gate[trow * 48 + head * 3 + 1], g2 = X.gate[trow * 48 + head * 3 + 2];
    LAS float* oacc = pc + 8 * wid * PCROW;
    const size_t bk = (size_t)b * 4 + kvh;
    const Stream Ssel{X.ks + (size_t)b * SEQ * 256 + kvh * 64, 256, X.vst + bk * 64 * SEQ, SEQ};
    Pre prs;
    {   const Stream S{X.kcmp + bk * 256 * 64, 64, X.vcmpT + bk * 64 * 256, 256};
        const int nct = (qb >> 4) + 1; const int mmax = tq >= 31 ? ((tq - 31) >> 4) : -1;
        State st; st.m = -1e30f; st.l = 0.f; st.o0 = (f32x16){}; st.o1 = (f32x16){};
        const Pre prc = prefetch(tid, S, 0, nct, true);
        run_branch<1>(tid, lds, S, prc, 0, nct, qf, -(1 << 30), mmax, ~0ull, st, 0.f, tokl, g);
        float lt = st.l + __shfl_xor(st.l, 32); const float inv_l = lt > 0.f ? 1.0f / lt : 0.f;
        run_branch<2>(tid, lds, S, prc, 0, nct, qf, -(1 << 30), mmax, ~0ull, st, inv_l, tokl, g);
    prs = prefetch(tid, Ssel, 0, qb + 1, true);
    {
        if (qb < 16) { if (lane < 8) selm[8 * wid + lane] = (2ull << qb) - 1ull; }
        else
#pragma unroll 1
        for (int i = 0; i < 4; ++i) { const int j = lane; unsigned keyA, keyB;
            if (j == 0 || j == qb || j == qb - 1) { keyA = 0xffffffc0u; keyB = 0xffffffc0u; } else if (j > qb) { keyA = 0u; keyB = 0u; }
            else { const LAS float* pa_ = pc + (8 * wid + i) * PCROW + 4 * j; const LAS float* pb_ = pa_ + 4 * PCROW;
                const float sa = (((pa_[-1] + pa_[0]) + pa_[1]) + pa_[2]) + pa_[3], sb = (((pb_[-1] + pb_[0]) + pb_[1]) + pb_[2]) + pb_[3];
                keyA = (__float_as_uint(sa) & 0x7fffffc0u) + 64u; keyB = (__float_as_uint(sb) & 0x7fffffc0u) + 64u; }
            keyA |= (unsigned)(63 - j); keyB |= (unsigned)(63 - j);
            unsigned thrA = 0u, thrB = 0u;
#pragma unroll
            for (int bpos = 29; bpos >= 0; --bpos) { const unsigned cA = thrA | (1u << bpos), cB = thrB | (1u << bpos);
                const unsigned long long mA = __ballot(keyA >= cA), mB = __ballot(keyB >= cB); if (__popcll(mA) >= 16) thrA = cA; if (__popcll(mB) >= 16) thrB = cB; }
            const unsigned long long maskA = __ballot(keyA >= thrA), maskB = __ballot(keyB >= thrB);
            if (lane == 0) { selm[8 * wid + i] = maskA; selm[8 * wid + i + 4] = maskB; } }
        LDS_FENCE();
        fold<true>(wsf, oacc, q, hi, g0, st);
    }
    }
    const unsigned long long mysel = selm[tokl];
    qf[0] = *(const bf16x8*)(X.qrot + (trow * 16 + head) * 16 + 8 * hi);
    const Stream Swin{X.kw + (size_t)b * SEQ * 256 + kvh * 64, 256, X.vwt + bk * 64 * SEQ, SEQ};
    const int tw0 = qb >= 8 ? qb - 8 : 0;
    Pre prw;
    {   State st; st.m = -1e30f; st.l = 0.f; st.o0 = (f32x16){}; st.o1 = (f32x16){};
        run_branch<0>(tid, lds, Ssel, prs, 0, qb + 1, qf, -(1 << 30), tq, mysel, st, 0.f, tokl, g);
        prw = prefetch(tid, Swin, tw0, qb + 1 - tw0, true);
        const float lt = st.l + __shfl_xor(st.l, 32); fold<false>(wsf, oacc, q, hi, lt > 0.f ? g1 / lt : 0.f, st);
    }
    {   State st; st.m = -1e30f; st.l = 0.f; st.o0 = (f32x16){}; st.o1 = (f32x16){};
        run_branch<0>(tid, lds, Swin, prw, tw0, qb + 1 - tw0, qf, tq - 511, tq, ~0ull, st, 0.f, tokl, g);
        const float lt = st.l + __shfl_xor(st.l, 32); fold<false>(wsf, oacc, q, hi, lt > 0.f ? g2 / lt : 0.f, st);
    }
    {   const int qq = lane >> 1, ch = lane & 1; const LAS float* src = oacc + qq * 64 + ch * 32;
        bf16_t* op = X.ob + ((size_t)b * SEQ + 64 * qb + 8 * wid + (qq >> 2)) * DM + (4 * kvh + (qq & 3)) * 64 + ch * 32;
#pragma unroll
        for (int c = 0; c < 4; ++c) { const f32x4 x0 = *(const LAS f32x4*)(src + c * 8), x1 = *(const LAS f32x4*)(src + c * 8 + 4);
            *(u32x4*)(op + c * 8) = (u32x4){cvt_pk_bf16(x0[0], x0[1]), cvt_pk_bf16(x0[2], x0[3]), cvt_pk_bf16(x1[0], x1[1]), cvt_pk_bf16(x1[2], x1[3])}; }
        LDS_FENCE(); }
}
}


#define XB_TMO      128
#define XB_XCNT(j)  (256  + 64 * (j))
#define XB_XSUB(j)  (1280 + 64 * (j))
#define XB_XGEN(j)  (2304 + 64 * (j))
#define XB_TOP      3328
#define XB_TOPGEN   3392
#define XCD_BAR_WORDS 3456
#define XB_SPIN_CAP (1u << 20)
__device__ __forceinline__ unsigned xb_ld(unsigned* p)              { return __hip_atomic_load(p, __ATOMIC_RELAXED, __HIP_MEMORY_SCOPE_AGENT); }
__device__ __forceinline__ unsigned xb_add(unsigned* p, unsigned v) { return __hip_atomic_fetch_add(p, v, __ATOMIC_RELAXED, __HIP_MEMORY_SCOPE_AGENT); }
__device__ __forceinline__ unsigned xb_xcc_id() { return (unsigned)__builtin_amdgcn_s_getreg((3 << 11) | 20) & 0xFu; }
#define XB_SPIN(cond, bar) do { unsigned _sp = 0; while (cond) { __builtin_amdgcn_s_sleep(1); \
    if ((++_sp & 255u) == 0u) { if (xb_ld(&(bar)[XB_TMO])) break; if (_sp > XB_SPIN_CAP) { atomicAdd(&(bar)[XB_TMO], 1u); break; } } } } while (0)
struct XcdBarrier { unsigned* bar; unsigned x; volatile LAS unsigned* st; };
__device__ __forceinline__ XcdBarrier xcd_barrier_post(unsigned* bar, volatile LAS unsigned* st) {
    XcdBarrier b; b.bar = bar; b.x = xb_xcc_id(); b.st = st;
    if (threadIdx.x == 0) (void)xb_add(&bar[XB_XCNT(b.x)], 1u);
    return b;
}
__device__ __forceinline__ void xcd_barrier_complete(unsigned* bar, unsigned x, unsigned& nloc, unsigned& nx) {
    const unsigned G = gridDim.x * gridDim.y * gridDim.z;
    unsigned sum, cnt, mine, sp = 0u;
    for (;;) {
        sum = 0u; cnt = 0u; mine = 0u;
#pragma unroll
        for (unsigned j = 0; j < 16; ++j) { const unsigned c = xb_ld(&bar[XB_XCNT(j)]); sum += c; cnt += (c > 0u) ? 1u : 0u; mine = (j == x) ? c : mine; }
        if (sum == G) break;
        __builtin_amdgcn_s_sleep(1);
        if ((++sp & 255u) == 0u) { if (xb_ld(&bar[XB_TMO])) break; if (sp > XB_SPIN_CAP) { atomicAdd(&bar[XB_TMO], 1u); break; } }
    }
    nloc = mine > 0u ? mine : 1u; nx = cnt > 0u ? cnt : 1u;
}
__device__ __forceinline__ void xcd_barrier(const XcdBarrier& b) {
    asm volatile("s_waitcnt vmcnt(0)" ::: "memory");
    __syncthreads();
    if (threadIdx.x == 0) {
        unsigned* bar = b.bar;
        __builtin_amdgcn_s_waitcnt(0);
        unsigned nloc = b.st[0], nx = b.st[1];
        if (nloc == 0u) { xcd_barrier_complete(bar, b.x, nloc, nx); b.st[0] = nloc; b.st[1] = nx; }
        const unsigned old = xb_add(&bar[XB_XSUB(b.x)], 1u);
        const unsigned gen = old / nloc;
        if (old + 1u == (gen + 1u) * nloc) {
            __builtin_amdgcn_fence(__ATOMIC_RELEASE, "agent");
            asm volatile("s_waitcnt vmcnt(0)" ::: "memory");
            const unsigned og = xb_add(&bar[XB_TOP], 1u);
            const unsigned tg = og / nx;
            if (og + 1u == (tg + 1u) * nx) xb_add(&bar[XB_TOPGEN], 1u);
            else XB_SPIN(xb_ld(&bar[XB_TOPGEN]) == tg, bar);
            __builtin_amdgcn_fence(__ATOMIC_ACQUIRE, "agent");
            xb_add(&bar[XB_XGEN(b.x)], 1u);
            asm volatile("s_waitcnt vmcnt(0)" ::: "memory");
        } else {
            XB_SPIN(xb_ld(&bar[XB_XGEN(b.x)]) == gen, bar);
            __builtin_amdgcn_fence(__ATOMIC_ACQUIRE, "agent");
            asm volatile("s_waitcnt vmcnt(0)" ::: "memory");
        }
    }
    __syncthreads();
}

constexpr int LDS_BYTES = 147456;
typedef const __attribute__((address_space(4))) Args* KArgP;
#define KARGS() (*(const Args*)({ KArgP p_ = (KArgP)__builtin_amdgcn_kernarg_segment_ptr(); asm volatile("" : "+s"(p_)); p_; }))
__global__ void __launch_bounds__(512, 2) mk_fwd(Args a_unused) {
    extern __shared__ __attribute__((aligned(16))) unsigned char lds_raw[];
    Ctx C; C.lds = (LAS unsigned char*)lds_raw; C.tid = threadIdx.x; C.lane = C.tid & 63; C.wave = __builtin_amdgcn_readfirstlane(C.tid >> 6); C.G = gridDim.x; C.bid = blockIdx.x;
    const int lo = KARGS().ph_lo, hi = KARGS().ph_hi;
    volatile LAS unsigned* xst = (volatile LAS unsigned*)(C.lds + LDS_BYTES - 64);
    if (C.tid < 2) xst[C.tid] = 0u;
    __syncthreads();
    if (lo > NPHASE) cg::this_grid().sync();
    const XcdBarrier xbar = xcd_barrier_post((unsigned*)(KARGS().ws + WS_BAR), xst);
#ifdef ONLY_PHASE
#define IN(k) ((k) == ONLY_PHASE && lo <= (k) && (k) < hi)
#else
#define IN(k) (lo <= (k) && (k) < hi)
#endif
#define SEAM(k) do { if (IN(k) && IN((k) + 1)) { xcd_barrier(xbar); } } while (0)
    using namespace pg8;
    const int NT = T / 256;
#define PHASE_VARS const Args& a = KARGS(); unsigned char* ws = a.ws; float* ssA = (float*)(ws + WS_SSA); float* ssB = (float*)(ws + WS_SSB); bf16_t* hb = (bf16_t*)(ws + WS_HB); bf16_t* hid = (bf16_t*)(ws + WS_HID); float* ssC = (float*)(ws + WS_SSC); float* ssD = (float*)(ws + WS_SSD); (void)ssC; (void)ssD; \
    (void)ssA; (void)ssB; (void)hb; (void)hid;

    if (IN(0)) { PHASE_VARS p0_prologue(C, a);
#ifdef PROBE_P0X2
        __syncthreads(); p0_prologue(C, a);
#endif
    } SEAM(0);
    if (IN(1)) { PHASE_VARS
        Gemm g{(const char*)(ws + WS_XB), (const char*)(ws + WS_WFIN), DM, 128, DM, NT, 22, 0}; StaticOrder S; S.init(NT, 22, C.G, C.bid);
        EpiSwiGLU E{ssA, hid}; gemm_phase<EpiSwiGLU, StaticOrder>(C.lds, g, S, E);
#ifdef PROBE_G1X2
        gemm_phase<EpiSwiGLU, StaticOrder>(C.lds, g, S, E);
#endif
    } SEAM(1);
    if (IN(2)) { PHASE_VARS
        Gemm g{(const char*)hid, (const char*)(ws + WS_WFOUT), FF, 128, FF, NT, 4, 0}; StaticOrder S; S.init(NT, 4, C.G, C.bid);
        EpiResid E{(const bf16_t*)(ws + WS_XB), 0.5f, hb, ssB}; gemm_phase<EpiResid, StaticOrder>(C.lds, g, S, E);
    } SEAM(2);
    if (IN(3)) { PHASE_VARS
        Gemm g{(const char*)hb, (const char*)(ws + WS_WIN), DM, 128, DM, NT, 23, 0}; StaticOrder S; S.init(NT, 23, C.G, C.bid);
        EpiProj E{ssB, (const float*)(ws + WS_ROPE), (bf16_t*)(ws + WS_UB), (bf16_t*)(ws + WS_GV), (bf16_t*)(ws + WS_QRAW), (bf16_t*)(ws + WS_QROT), (bf16_t*)(ws + WS_KC), (bf16_t*)(ws + WS_VC),
                  (bf16_t*)(ws + WS_KS), (bf16_t*)(ws + WS_KW), (bf16_t*)(ws + WS_VST), (bf16_t*)(ws + WS_VWT), (bf16_t*)(ws + WS_GA), (float*)(ws + WS_VSTAT), (float*)(ws + WS_GATE)};
        gemm_phase<EpiProj, StaticOrder>(C.lds, g, S, E);
#ifdef PROBE_G3X2
        gemm_phase<EpiProj, StaticOrder>(C.lds, g, S, E);
#endif
    } SEAM(3);
    if (IN(4)) { PHASE_VARS
#ifndef NO_CMP
        {   Gemm g{(const char*)(ws + WS_KC), (const char*)(ws + WS_WC1), 4096, 512, 2048, 32, 1, 1}; StaticOrder S; S.init(32, 1, C.G, C.bid);
            EpiCmp1 E{(bf16_t*)(ws + WS_CHID), (const float*)(ws + WS_CBIAS)}; gemm_phase<EpiCmp1, StaticOrder>(C.lds, g, S, E); }
#endif
        __syncthreads();
#ifndef NO_GMLP
        if (C.G == 256) { if (C.bid >= 32) for (int j = C.bid - 32; j < 1024; j += 224) gmlp_job(C, a, j); }
        else for (int j = C.bid; j < 1024; j += C.G) gmlp_job(C, a, j);
#endif
    } SEAM(4);
    if (IN(5)) { PHASE_VARS
        {   Gemm g{(const char*)(ws + WS_UB), (const char*)(ws + WS_WA), DM, 128, DM, NT, 4, 0}; StaticOrder S; S.init(NT, 4, C.G, C.bid);
            EpiBf16<2> E{(bf16_t*)(ws + WS_GV), nullptr, (const bf16_t*)(ws + WS_GA), nullptr}; gemm_phase<EpiBf16<2>, StaticOrder>(C.lds, g, S, E); }
#ifndef NO_CMP
        cmp2_phase(C, a);
#endif
    } SEAM(5);
    if (IN(6)) { PHASE_VARS
        att::Tensors X{(const bf16_t*)(ws + WS_QRAW), (const bf16_t*)(ws + WS_QROT), (const bf16_t*)(ws + WS_KS), (const bf16_t*)(ws + WS_KW), (const bf16_t*)(ws + WS_VST), (const bf16_t*)(ws + WS_VWT),
                       (const bf16_t*)(ws + WS_KCMP), (const bf16_t*)(ws + WS_VCMPT), (const float*)(ws + WS_GATE), (bf16_t*)(ws + WS_QRAW)};
#ifndef NO_ATTN
#ifdef PROBE_ATTN2
        { att::Tensors X0 = X; X0.ob = (bf16_t*)(ws + WS_UB);
        if (C.G == 256) { const int vcu = (C.bid & 7) * 32 + (C.bid >> 3); const int bkv = vcu >> 4, s = vcu & 15;
#pragma unroll 1
            for (int i = 0; i < 4; ++i) { const int qb = i == 0 ? 63 - s : i == 1 ? 32 + s : i == 2 ? 31 - s : s; att::job(C.lds, X0, bkv >> 2, bkv & 3, qb); }
        } else { for (int j = C.bid; j < 1024; j += C.G) { const int bkv = j & 15, qb = 63 - (j >> 4); att::job(C.lds, X0, bkv >> 2, bkv & 3, qb); } }
        __syncthreads(); }
#endif
        if (C.G == 256) { const int vcu = (C.bid & 7) * 32 + (C.bid >> 3); const int bkv = vcu >> 4, s = vcu & 15;
#pragma unroll 1
            for (int i = 0; i < 4; ++i) { const int qb = i == 0 ? 63 - s : i == 1 ? 32 + s : i == 2 ? 31 - s : s; att::job(C.lds, X, bkv >> 2, bkv & 3, qb); }
        } else { for (int j = C.bid; j < 1024; j += C.G) { const int bkv = j & 15, qb = 63 - (j >> 4); att::job(C.lds, X, bkv >> 2, bkv & 3, qb); } }
#endif
        __syncthreads();
#ifndef NO_GB
        {   Gemm g{(const char*)hb, (const char*)(ws + WS_WGB), DM, 128, DM, NT, 4, 0}; StaticOrder S; S.init(NT, 4, C.G, C.bid);
            EpiBf16<0> E{(bf16_t*)(ws + WS_UB), nullptr, nullptr, nullptr}; gemm_phase<EpiBf16<0>, StaticOrder>(C.lds, g, S, E); }
#endif
    } SEAM(6);
    if (IN(7)) { PHASE_VARS
        Gemm g{(const char*)(ws + WS_QRAW), (const char*)(ws + WS_WB), DM, 128, DM, NT, 4, 0}; StaticOrder S; S.init(NT, 4, C.G, C.bid);
        EpiBf16<4> E{(bf16_t*)(ws + WS_GV), ssB, (const bf16_t*)(ws + WS_UB), (const bf16_t*)(ws + WS_GV)}; gemm_phase<EpiBf16<4>, StaticOrder>(C.lds, g, S, E);
    } SEAM(7);
    if (IN(8)) { PHASE_VARS
        {   Gemm g{(const char*)(ws + WS_GV), (const char*)(ws + WS_WO), DM, 128, DM, NT, 4, 0}; StaticOrder S; S.init(NT, 4, C.G, C.bid);
            EpiResid E{hb, 1.0f, hb, ssC}; gemm_phase<EpiResid, StaticOrder>(C.lds, g, S, E); }
        __syncthreads();
        p8_extras(C, a);
    } SEAM(8);
    if (IN(9)) { PHASE_VARS
        {   Gemm g{(const char*)hb, (const char*)(ws + WS_WFIN), DM, 128, DM, NT, 22, 0}; StaticOrder S; S.init(NT, 22, C.G, C.bid);
            EpiSwiGLU E{ssC, hid}; gemm_phase<EpiSwiGLU, StaticOrder>(C.lds, g, S, E); }
        int opq = 0; asm volatile("" : "+s"(opq));
        if (opq == 0) {   int kple = PLE; asm volatile("" : "+s"(kple));
            Gemm g{(const char*)(ws + WS_PB), (const char*)(ws + WS_WPP), PLE, 128, kple, NT, 4, 0}; StaticOrder S;
            if (C.G == 256) S.init(NT, 4, 128, C.bid >= 128 ? C.bid - 128 : -1); else S.init(NT, 4, C.G, C.bid);
            EpiBf16<0> E{(bf16_t*)(ws + WS_PP), nullptr, nullptr, nullptr}; gemm_phase<EpiBf16<0>, StaticOrder>(C.lds, g, S, E); }
    } SEAM(9);
    if (IN(10)) { PHASE_VARS
        Gemm g{(const char*)hid, (const char*)(ws + WS_WFOUT), FF, 128, FF, NT, 4, 0}; StaticOrder S; S.init(NT, 4, C.G, C.bid);
        EpiResid E{hb, 0.5f, hb, ssD}; gemm_phase<EpiResid, StaticOrder>(C.lds, g, S, E);
    } SEAM(10);
    if (IN(11)) { PHASE_VARS
        Gemm g{(const char*)hb, (const char*)(ws + WS_WPG), DM, 128, DM, NT, 4, 0}; StaticOrder S; S.init(NT, 4, C.G, C.bid);
        if (C.G == 256) { EpiPleFinal E{ssD, (const bf16_t*)(ws + WS_PP), hb, a.out, a.in[I_FIN], (unsigned*)(ws + WS_BAR + 32768), (unsigned*)(ws + WS_BAR + 16384)};
            gemm_phase<EpiPleFinal, StaticOrder>(C.lds, g, S, E); }
        else { EpiPle E{ssD, (const bf16_t*)(ws + WS_PP), hb, a.out, ssA}; gemm_phase<EpiPle, StaticOrder>(C.lds, g, S, E); }
    }
    if (C.G != 256) { SEAM(11); if (IN(12)) { PHASE_VARS final_phase(C, a); } }
#undef IN
#undef SEAM
}

extern "C" void kernel_launch(void* const* d_in, const int* in_sizes, int n_in, void* d_out, int out_size, void* d_ws, size_t ws_size, hipStream_t stream) {
    static int grid = 0;
    if (grid == 0) {
        if (n_in != 27 || out_size != T * DM || ws_size < WS_END) { fprintf(stderr, "kernel_launch: unexpected problem (n_in %d, out %d, ws %zu)\n", n_in, out_size, ws_size); grid = -1; return; }
        int dev = 0, cus = 0, per_cu = 0;
        hipGetDevice(&dev); hipDeviceGetAttribute(&cus, hipDeviceAttributeMultiprocessorCount, dev);
        hipFuncSetAttribute((const void*)mk_fwd, hipFuncAttributeMaxDynamicSharedMemorySize, LDS_BYTES);
        hipOccupancyMaxActiveBlocksPerMultiprocessor(&per_cu, (const void*)mk_fwd, 512, LDS_BYTES);
        if (per_cu < 1) { fprintf(stderr, "kernel_launch: occupancy query says %d blocks per CU\n", per_cu); per_cu = 1; }
        (void)hipGetLastError();
        grid = cus * 1;
    }
    if (grid < 0) return;
    Args a{};
    for (int i = 0; i < 27; ++i) a.in[i] = (const float*)d_in[i];
    a.out = (float*)d_out; a.ws = (unsigned char*)d_ws;
#if MK_SINGLE
    hipMemsetAsync((char*)d_ws + WS_BAR, 0, 32768, stream);
    a.ph_lo = 0; a.ph_hi = NPHASE;
    void* args[] = {&a};
    hipError_t e = hipLaunchCooperativeKernel((const void*)mk_fwd, dim3(grid), dim3(512), args, LDS_BYTES, stream);
    if (e != hipSuccess) fprintf(stderr, "cooperative launch failed: %s (grid %d)\n", hipGetErrorString(e), grid);
#else
    for (int k = 0; k < NPHASE; ++k) { a.ph_lo = k; a.ph_hi = k + 1; hipLaunchKernelGGL(mk_fwd, dim3(grid), dim3(512), LDS_BYTES, stream, a); }
#endif
}
```

```cpp
#include <hip/hip_runtime.h>
#include <hip/hip_cooperative_groups.h>
#include <cstdint>
#include <cstdio>
namespace cg = cooperative_groups;

#ifndef MK_SINGLE
#define MK_SINGLE 1
#endif

#define LAS __attribute__((address_space(3)))
typedef unsigned short bf16_t;
typedef short bf16x8 __attribute__((ext_vector_type(8)));
typedef float f32x4 __attribute__((ext_vector_type(4)));
typedef float f32x2 __attribute__((ext_vector_type(2)));
typedef float f32x16 __attribute__((ext_vector_type(16)));
typedef unsigned u32x4 __attribute__((ext_vector_type(4)));
typedef unsigned u32x2 __attribute__((ext_vector_type(2)));

constexpr int T = 16384, SEQ = 4096, DM = 1024, FF = 2816, PLE = 256;
constexpr int N3 = 5888;
constexpr float EPS = 1e-6f;
constexpr float LOG2E = 1.4426950408889634f;
constexpr float QSCALE = 0.125f * LOG2E;
constexpr int NPHASE = 13;

constexpr size_t MiB = 1u << 20;
constexpr size_t WS_SSA = 0, WS_SSB = 1 * MiB, WS_VSTAT = 2 * MiB, WS_ROPE = 4 * MiB, WS_GMW = 4 * MiB + 256 * 1024,
                 WS_KCMP = 4 * MiB + 512 * 1024, WS_VCMPT = 5 * MiB, WS_CBIAS = 5 * MiB + 512 * 1024, WS_GATE = 6 * MiB, WS_SSC = 9 * MiB, WS_SSD = 10 * MiB;
constexpr size_t WS_WIN = 11 * MiB;
constexpr size_t WS_WGB = WS_WIN + (size_t)N3 * 1024 * 2;
constexpr size_t WS_WA = WS_WGB + 2 * MiB, WS_WB = WS_WA + 2 * MiB, WS_WO = WS_WB + 2 * MiB, WS_WPG = WS_WO + 2 * MiB, WS_WPP = WS_WPG + 2 * MiB,
                 WS_WC1 = 33 * MiB;
constexpr size_t WS_WFIN = 35 * MiB, WS_WFOUT = 46 * MiB;
constexpr size_t WS_KC = 35 * MiB, WS_VC = 43 * MiB;
constexpr size_t WS_HID = 52 * MiB;
constexpr size_t WS_QRAW = 52 * MiB, WS_QROT = 84 * MiB, WS_KS = 92 * MiB, WS_KW = 100 * MiB, WS_VST = 108 * MiB, WS_VWT = 116 * MiB,
                 WS_GA = 124 * MiB, WS_UB = 156 * MiB, WS_HB = 188 * MiB, WS_GV = 220 * MiB, WS_CHID = 252 * MiB;
constexpr size_t WS_XB = 140 * MiB, WS_PB = 140 * MiB, WS_PP = 148 * MiB;
constexpr size_t WS_BAR = 51 * MiB + 512 * 1024;
constexpr size_t WS_END = 256 * MiB;
static_assert(WS_WPP + 512 * 1024 <= WS_WC1 && WS_WC1 + 2 * MiB <= WS_WFIN, "weight map");

typedef __bf16 bf16x2_t __attribute__((ext_vector_type(2)));
__device__ __forceinline__ unsigned cvt_pk_bf16(float lo, float hi) { f32x2 v = {lo, hi}; bf16x2_t b = __builtin_convertvector(v, bf16x2_t); return __builtin_bit_cast(unsigned, b); }
__device__ __forceinline__ float bf2f(unsigned short b) { return __uint_as_float((unsigned)b << 16); }
__device__ __forceinline__ float bflo(unsigned w) { return __uint_as_float(w << 16); }
__device__ __forceinline__ float bfhi(unsigned w) { return __uint_as_float(w & 0xffff0000u); }
__device__ __forceinline__ float fsigmoid(float x) { return __builtin_amdgcn_rcpf(1.0f + __builtin_amdgcn_exp2f(-x * LOG2E)); }
__device__ __forceinline__ float fsilu(float x) { return x * fsigmoid(x); }
__device__ __forceinline__ float fgelu(float x) { return x * fsigmoid(1.5957691216057308f * (x + 0.044715f * x * x * x)); }
__device__ __forceinline__ void sigmoid8(float (&v)[8]) {
#pragma unroll
    for (int i = 0; i < 8; i += 2) { f32x2 x = {v[i], v[i + 1]}; const f32x2 z = x * (-LOG2E); f32x2 e = {__builtin_amdgcn_exp2f(z.x), __builtin_amdgcn_exp2f(z.y)}; const f32x2 d = e + 1.0f;
        v[i] = __builtin_amdgcn_rcpf(d.x); v[i + 1] = __builtin_amdgcn_rcpf(d.y); }
}
__device__ __forceinline__ void silu8(float (&v)[8]) {
#pragma unroll
    for (int i = 0; i < 8; i += 2) { f32x2 x = {v[i], v[i + 1]}; const f32x2 z = x * (-LOG2E); f32x2 e = {__builtin_amdgcn_exp2f(z.x), __builtin_amdgcn_exp2f(z.y)}; const f32x2 d = e + 1.0f;
        const f32x2 r = {__builtin_amdgcn_rcpf(d.x), __builtin_amdgcn_rcpf(d.y)}; x = x * r; v[i] = x.x; v[i + 1] = x.y; }
}
__device__ __forceinline__ void gelu8(float (&v)[8]) {
    constexpr float c0 = -1.5957691216057308f * LOG2E, c1 = c0 * 0.044715f;
#pragma unroll
    for (int i = 0; i < 8; i += 2) { f32x2 x = {v[i], v[i + 1]}; const f32x2 w = (x * x) * c1 + c0; const f32x2 z = x * w; f32x2 e = {__builtin_amdgcn_exp2f(z.x), __builtin_amdgcn_exp2f(z.y)}; const f32x2 d = e + 1.0f;
        const f32x2 r = {__builtin_amdgcn_rcpf(d.x), __builtin_amdgcn_rcpf(d.y)}; x = x * r; v[i] = x.x; v[i + 1] = x.y; }
}
__device__ __forceinline__ u32x4 pack8(const float (&v)[8]) { u32x4 w; w.x = cvt_pk_bf16(v[0], v[1]); w.y = cvt_pk_bf16(v[2], v[3]); w.z = cvt_pk_bf16(v[4], v[5]); w.w = cvt_pk_bf16(v[6], v[7]); return w; }
__device__ __forceinline__ void unpack8(const u32x4 w, float (&v)[8]) { v[0] = bflo(w.x); v[1] = bfhi(w.x); v[2] = bflo(w.y); v[3] = bfhi(w.y); v[4] = bflo(w.z); v[5] = bfhi(w.z); v[6] = bflo(w.w); v[7] = bfhi(w.w); }
#define LDS_FENCE() asm volatile("s_waitcnt lgkmcnt(0)" ::: "memory")
__device__ __forceinline__ float quad_sum(float v) {
    v += __int_as_float(__builtin_amdgcn_update_dpp(0, __float_as_int(v), 0xB1, 0xF, 0xF, true));
    v += __int_as_float(__builtin_amdgcn_update_dpp(0, __float_as_int(v), 0x4E, 0xF, 0xF, true));
    return v;
}

namespace pg8 {
constexpr int BM = 256, BK = 64, HALF = 128, HTB = HALF * BK * 2, STAGE_BYTES = 8 * HTB, NXCD = 8, WGM = 4;
__host__ __device__ __forceinline__ int lds_byte(int r, int c) { const int st = (r >> 4) * 2 + (c >> 5), rr = r & 15, cc = c & 31, ob = rr * 64 + cc * 2; return st * 1024 + (ob ^ (((ob >> 9) & 1) << 5)); }
__host__ __device__ __forceinline__ void stage_rc(int b, int& R, int& C) { const int st = b / 1024, sb = b % 1024, swz = sb ^ (((sb >> 9) & 1) << 5); R = (st >> 1) * 16 + swz / 64; C = (st & 1) * 32 + (swz % 64) / 2; }
__host__ __device__ __forceinline__ int perm32(int rho) { const int n = rho >> 4, i = rho & 15; return 8 * (i >> 2) + 4 * n + (i & 3); }

struct Unit { int pm, pn; };
struct Gemm { const char* A; const char* Bt; int lda; int kstepA; int K; int nM, nN; int mode; };
__device__ __forceinline__ const char* abase(const Gemm& g, const Unit& u) {
    if (g.mode == 1) { const int pm = u.pm; return g.A + ((size_t)(pm >> 4) * ((size_t)T * 256) + (size_t)((pm & 15) >> 2) * 64 + (size_t)(pm & 3) * 256 * 4096) * 2; }
    return g.A + (size_t)u.pm * ((size_t)BM * g.lda * 2);
}
__device__ __forceinline__ const char* bbase(const Gemm& g, const Unit& u) {
    if (g.mode == 1) return g.Bt + (size_t)(u.pm >> 4) * ((size_t)256 * 2048 * 2);
    return g.Bt + (size_t)u.pn * ((size_t)BM * g.K * 2);
}

struct StaticOrder {
    int nM, nN, nwg, G, c;
    __device__ void init(int nM_, int nN_, int G_, int c_) { nM = nM_; nN = nN_; nwg = nM * nN; G = G_; c = c_; }
    __device__ bool next(int i, Unit& u) const {
        if (c < 0) return false;
        const long L = (long)i * G + c; if (L >= nwg) return false;
        int wgid = (int)L; { const int q = nwg / NXCD, r = nwg % NXCD, xcd = wgid % NXCD, off = wgid / NXCD; wgid = (xcd < r ? xcd * (q + 1) : r * (q + 1) + (xcd - r) * q) + off; }
        const int nig = WGM * nN, gid = wgid / nig, fm = gid * WGM, gsz = (nM - fm) < WGM ? (nM - fm) : WGM;
        u.pm = fm + ((wgid % nig) % gsz); u.pn = (wgid % nig) / gsz; return true;
    }
};

template <class Epi, class Sched, bool ALIGN_EPI = true, bool SP2 = true>
__device__ __forceinline__ void gemm_phase(LAS unsigned char* lds, const Gemm g, const Sched& S, const Epi& E) {
    const int tid = threadIdx.x, wid = __builtin_amdgcn_readfirstlane(tid >> 6), lane = tid & 63, wr = wid >> 2, wc = wid & 3, fr = lane & 15, fq = lane >> 4;
    const int K = g.K, nt = K / BK;
    unsigned voffA[2], voffB[2];
#pragma unroll
    for (int i = 0; i < 2; ++i) { int R, C; stage_rc(tid * 16 + i * 8192, R, C); const int Rb = Epi::PERM ? ((R & ~31) + perm32(R & 31)) : R;
        voffA[i] = (unsigned)(R * g.lda + C) * 2u; voffB[i] = (unsigned)(Rb * K + C) * 2u; }
    const size_t kstepA = (size_t)g.kstepA, kstepB = (size_t)(BK * 2);
    const size_t hstepA = (size_t)HALF * g.lda * 2, hstepB = (size_t)HALF * K * 2;
    const unsigned ldsw = (unsigned)wid * 1024u;
    const int aoff = lds_byte(wr * 64 + fr, fq * 8), boff = lds_byte(wc * 32 + fr, fq * 8);
#define PG8_SA(b, h) (((b) * 2 + (h)) * HTB)
#define PG8_SB(b, h) ((4 + (b) * 2 + (h)) * HTB)
#define PG8_STAGE(bufoff, gbase, voff) do { _Pragma("unroll") for (int _i = 0; _i < 2; ++_i) \
        __builtin_amdgcn_global_load_lds((const unsigned*)((const char*)(gbase) + (voff)[_i]), (LAS unsigned*)(lds + (bufoff) + ldsw + _i * 8192), 16, 0, 0); } while (0)
#define PG8_LDA(dst, b, h) do { _Pragma("unroll") for (int m = 0; m < 4; ++m) _Pragma("unroll") for (int k = 0; k < 2; ++k) dst[m][k] = *(const LAS bf16x8*)(lds + PG8_SA(b, h) + aoff + m * 2048 + k * 1024); } while (0)
#define PG8_LDB(dst, b, h) do { _Pragma("unroll") for (int n = 0; n < 2; ++n) _Pragma("unroll") for (int k = 0; k < 2; ++k) dst[n][k] = *(const LAS bf16x8*)(lds + PG8_SB(b, h) + boff + n * 2048 + k * 1024); } while (0)
#define PG8_MMA(ai, bj, At, Bt) do { __builtin_amdgcn_s_setprio(1); _Pragma("unroll") for (int m = 0; m < 4; ++m) _Pragma("unroll") for (int n = 0; n < 2; ++n) _Pragma("unroll") for (int k = 0; k < 2; ++k) \
        acc[ai][bj][m][n] = __builtin_amdgcn_mfma_f32_16x16x32_bf16(Bt[n][k], At[m][k], acc[ai][bj][m][n], 0, 0, 0); __builtin_amdgcn_s_setprio(0); } while (0)
#define PG8_WAIT_V(n) asm volatile("s_waitcnt vmcnt(" #n ")" ::: "memory")
#define PG8_WAIT_L(n) asm volatile("s_waitcnt lgkmcnt(" #n ")" ::: "memory")
#define PG8_BAR __builtin_amdgcn_s_barrier()
#define PG8_SCHED __builtin_amdgcn_sched_barrier(0)
    Unit cur, nxt; int ui = 0;
    if (!S.next(0, cur)) return;
    f32x4 acc[2][2][4][2];
#pragma unroll
    for (int a = 0; a < 2; ++a)
#pragma unroll
        for (int b = 0; b < 2; ++b)
#pragma unroll
            for (int m = 0; m < 4; ++m)
#pragma unroll
                for (int n = 0; n < 2; ++n) acc[a][b][m][n] = (f32x4){0.f, 0.f, 0.f, 0.f};
    bf16x8 At[4][2], B0[2][2], B1[2][2];
    const char* cA = abase(g, cur); const char* cB = bbase(g, cur);
    if constexpr (SP2) {
        PG8_STAGE(PG8_SB(0, 0), cB, voffB); PG8_STAGE(PG8_SB(0, 1), cB + hstepB, voffB); PG8_STAGE(PG8_SA(0, 0), cA, voffA); PG8_STAGE(PG8_SA(0, 1), cA + hstepA, voffA);
        if (wr == 1) PG8_BAR;
        PG8_WAIT_V(2); PG8_BAR;
        PG8_STAGE(PG8_SB(1, 0), cB + kstepB, voffB); PG8_STAGE(PG8_SA(1, 0), cA + kstepA, voffA); PG8_STAGE(PG8_SB(1, 1), cB + hstepB + kstepB, voffB);
        PG8_WAIT_V(6); PG8_BAR;
    } else {
        PG8_STAGE(PG8_SB(0, 0), cB, voffB); PG8_STAGE(PG8_SA(0, 0), cA, voffA); PG8_STAGE(PG8_SB(0, 1), cB + hstepB, voffB); PG8_STAGE(PG8_SA(0, 1), cA + hstepA, voffA);
        if (wr == 1) PG8_BAR;
        PG8_WAIT_V(4); PG8_BAR;
        PG8_STAGE(PG8_SB(1, 0), cB + kstepB, voffB); PG8_STAGE(PG8_SA(1, 0), cA + kstepA, voffA); PG8_STAGE(PG8_SB(1, 1), cB + hstepB + kstepB, voffB);
        PG8_WAIT_V(6); PG8_BAR;
    }
    for (;;) {
        const bool has_next = S.next(ui + 1, nxt);
        const char* nA = has_next ? abase(g, nxt) : cA + (size_t)(nt - 2) * kstepA; const char* nB = has_next ? bbase(g, nxt) : cB + (size_t)(nt - 2) * kstepB;
        for (int t = 0; t < nt; t += 2) {
            const bool last = (t == nt - 2);
            const char* a1 = cA + (size_t)(t + 1) * kstepA;
            const char* a2 = last ? nA : cA + (size_t)(t + 2) * kstepA; const char* b2 = last ? nB : cB + (size_t)(t + 2) * kstepB;
            const char* a3 = a2 + kstepA; const char* b3 = b2 + kstepB;
            if constexpr (SP2) {
            PG8_LDB(B0, 0, 0); PG8_LDB(B1, 0, 1); PG8_SCHED; PG8_LDA(At, 0, 0); PG8_STAGE(PG8_SA(1, 1), a1 + hstepA, voffA);
            PG8_WAIT_V(8); PG8_WAIT_L(0); PG8_BAR; PG8_MMA(0, 0, At, B0); PG8_MMA(0, 1, At, B1); PG8_BAR; PG8_SCHED;
            PG8_LDA(At, 0, 1); PG8_STAGE(PG8_SB(0, 0), b2, voffB); PG8_STAGE(PG8_SB(0, 1), b2 + hstepB, voffB); PG8_STAGE(PG8_SA(0, 0), a2, voffA);
            PG8_WAIT_V(8); PG8_WAIT_L(0); PG8_BAR; PG8_MMA(1, 0, At, B0); PG8_MMA(1, 1, At, B1); PG8_BAR; PG8_SCHED;
            PG8_LDB(B0, 1, 0); PG8_LDB(B1, 1, 1); PG8_SCHED; PG8_LDA(At, 1, 0); PG8_STAGE(PG8_SA(0, 1), a2 + hstepA, voffA);
            PG8_WAIT_V(8); PG8_WAIT_L(0); PG8_BAR; PG8_MMA(0, 0, At, B0); PG8_MMA(0, 1, At, B1); PG8_BAR; PG8_SCHED;
            PG8_LDA(At, 1, 1); PG8_STAGE(PG8_SB(1, 0), b3, voffB); PG8_STAGE(PG8_SB(1, 1), b3 + hstepB, voffB); PG8_STAGE(PG8_SA(1, 0), a3, voffA);
            PG8_WAIT_V(8); PG8_WAIT_L(0); PG8_BAR; PG8_MMA(1, 0, At, B0); PG8_MMA(1, 1, At, B1); PG8_BAR; PG8_SCHED;
            } else {
            PG8_LDB(B0, 0, 0); PG8_SCHED; PG8_LDA(At, 0, 0); PG8_STAGE(PG8_SA(1, 1), a1 + hstepA, voffA);
            PG8_WAIT_L(8); PG8_BAR; PG8_WAIT_L(0); PG8_MMA(0, 0, At, B0); PG8_BAR; PG8_SCHED;
            PG8_LDB(B1, 0, 1); PG8_STAGE(PG8_SB(0, 0), b2, voffB);
            PG8_BAR; PG8_WAIT_L(0); PG8_MMA(0, 1, At, B1); PG8_BAR;
            PG8_LDA(At, 0, 1); PG8_STAGE(PG8_SA(0, 0), a2, voffA);
            PG8_BAR; PG8_WAIT_L(0); PG8_MMA(1, 0, At, B0); PG8_BAR; PG8_SCHED;
            PG8_STAGE(PG8_SB(0, 1), b2 + hstepB, voffB);
            PG8_WAIT_V(6); PG8_BAR; PG8_MMA(1, 1, At, B1); PG8_BAR;
            PG8_LDB(B0, 1, 0); PG8_SCHED; PG8_LDA(At, 1, 0); PG8_STAGE(PG8_SA(0, 1), a2 + hstepA, voffA);
            PG8_WAIT_L(8); PG8_BAR; PG8_WAIT_L(0); PG8_MMA(0, 0, At, B0); PG8_BAR; PG8_SCHED;
            PG8_LDB(B1, 1, 1); PG8_STAGE(PG8_SB(1, 0), b3, voffB);
            PG8_BAR; PG8_WAIT_L(0); PG8_MMA(0, 1, At, B1); PG8_BAR;
            PG8_LDA(At, 1, 1); PG8_STAGE(PG8_SA(1, 0), a3, voffA);
            PG8_BAR; PG8_WAIT_L(0); PG8_MMA(1, 0, At, B0); PG8_BAR; PG8_SCHED;
            PG8_STAGE(PG8_SB(1, 1), b3 + hstepB, voffB);
            PG8_WAIT_V(6); PG8_BAR; PG8_MMA(1, 1, At, B1); PG8_BAR;
            }
        }
        if constexpr (ALIGN_EPI) { if (wr == 0) PG8_BAR; }
        if constexpr (!Epi::AFTER_DRAIN) E(acc, cur, wr, wc, fr, fq);
        if (!has_next) break;
#pragma unroll
        for (int a = 0; a < 2; ++a)
#pragma unroll
            for (int b = 0; b < 2; ++b)
#pragma unroll
                for (int m = 0; m < 4; ++m)
#pragma unroll
                    for (int n = 0; n < 2; ++n) acc[a][b][m][n] = (f32x4){0.f, 0.f, 0.f, 0.f};
        cur = nxt; cA = nA; cB = nB; ++ui;
        if constexpr (ALIGN_EPI) { if (wr == 1) PG8_BAR; }
    }
    PG8_WAIT_V(0);
    if constexpr (!ALIGN_EPI) { if (wr == 0) PG8_BAR; }
    PG8_BAR;
    if constexpr (Epi::AFTER_DRAIN) E.fused(acc, cur, wr, wc, fr, fq, lds, wid, lane);
#undef PG8_SA
#undef PG8_SB
#undef PG8_STAGE
#undef PG8_LDA
#undef PG8_LDB
#undef PG8_MMA
#undef PG8_WAIT_V
#undef PG8_WAIT_L
#undef PG8_BAR
#undef PG8_SCHED
}

typedef f32x4 Acc[2][2][4][2];
__device__ __forceinline__ void load_rs(const float* ssp, int row0, int fq, float (&rs)[2][4]) {
#pragma unroll
    for (int ai = 0; ai < 2; ++ai)
#pragma unroll
        for (int m = 0; m < 4; ++m) { const f32x4* pp = (const f32x4*)(ssp + (size_t)(row0 + 128 * ai + 16 * m) * 16); const f32x4 p0 = pp[0], p1 = pp[1], p2 = pp[2], p3 = pp[3];
            const float s = (((p0.x + p0.y) + (p0.z + p0.w)) + ((p1.x + p1.y) + (p1.z + p1.w))) + (((p2.x + p2.y) + (p2.z + p2.w)) + ((p3.x + p3.y) + (p3.z + p3.w)));
            rs[ai][m] = rsqrtf(s * (1.0f / 1024.0f) + EPS); asm volatile("" : "+v"(rs[ai][m]) :: "memory"); }
}
#define ACC8(v, ai, bj, m, sc) do { const f32x4 a0_ = acc[ai][bj][m][0], a1_ = acc[ai][bj][m][1]; v[0] = a0_[0] * (sc); v[1] = a0_[1] * (sc); v[2] = a0_[2] * (sc); v[3] = a0_[3] * (sc); \
        v[4] = a1_[0] * (sc); v[5] = a1_[1] * (sc); v[6] = a1_[2] * (sc); v[7] = a1_[3] * (sc); } while (0)

struct EpiSwiGLU { static constexpr bool PERM = true, AFTER_DRAIN = false; const float* ssp; bf16_t* hid;
    __device__ __forceinline__ void operator()(const Acc& acc, const Unit& u, int wr, int wc, int fr, int fq) const {
        const int row0 = u.pm * 256 + wr * 64 + fr; float rs[2][4]; load_rs(ssp, row0, fq, rs);
#pragma unroll
        for (int ai = 0; ai < 2; ++ai)
#pragma unroll
            for (int m = 0; m < 4; ++m) { float gt[8], up[8], o[8]; ACC8(gt, ai, 0, m, rs[ai][m]); ACC8(up, ai, 1, m, rs[ai][m]);
#pragma unroll
                for (int j = 0; j < 8; ++j) o[j] = gt[j];
                silu8(o);
#pragma unroll
                for (int j = 0; j < 8; ++j) o[j] *= up[j];
                *(u32x4*)(hid + (size_t)(row0 + 128 * ai + 16 * m) * FF + u.pn * 128 + wc * 32 + fq * 8) = pack8(o); }
    }
};
struct EpiResid { static constexpr bool PERM = true, AFTER_DRAIN = false; const bf16_t* baseb; float coef; bf16_t* hb; float* ssp;
    __device__ __forceinline__ void operator()(const Acc& acc, const Unit& u, int wr, int wc, int fr, int fq) const {
        const int row0 = u.pm * 256 + wr * 64 + fr;
#pragma unroll
        for (int ai = 0; ai < 2; ++ai)
#pragma unroll
            for (int m = 0; m < 4; ++m) { const int row = row0 + 128 * ai + 16 * m; float ss = 0.f;
#pragma unroll
                for (int bj = 0; bj < 2; ++bj) { const size_t off = (size_t)row * DM + u.pn * 256 + bj * 128 + wc * 32 + fq * 8; float v[8], bb[8]; ACC8(v, ai, bj, m, coef);
                    unpack8(*(const u32x4*)(baseb + off), bb);
#pragma unroll
                    for (int j = 0; j < 8; ++j) { v[j] += bb[j]; ss += v[j] * v[j]; }
                    *(u32x4*)(hb + off) = pack8(v); }
                ss += __shfl_xor(ss, 16); ss += __shfl_xor(ss, 32);
                if (fq == 0) ssp[(size_t)row * 16 + u.pn * 4 + wc] = ss; }
    }
};
struct EpiPle { static constexpr bool PERM = true, AFTER_DRAIN = false; const float* ssp_in; const bf16_t* pp; const bf16_t* hb; float* out; float* ssp;
    __device__ __forceinline__ void operator()(const Acc& acc, const Unit& u, int wr, int wc, int fr, int fq) const {
        const int row0 = u.pm * 256 + wr * 64 + fr; float rs[2][4]; load_rs(ssp_in, row0, fq, rs);
#pragma unroll
        for (int ai = 0; ai < 2; ++ai)
#pragma unroll
            for (int m = 0; m < 4; ++m) { const int row = row0 + 128 * ai + 16 * m; float ss = 0.f;
#pragma unroll
                for (int bj = 0; bj < 2; ++bj) { const size_t off = (size_t)row * DM + u.pn * 256 + bj * 128 + wc * 32 + fq * 8; float v[8], pv[8], bb[8]; ACC8(v, ai, bj, m, rs[ai][m]);
                    unpack8(*(const u32x4*)(pp + off), pv); unpack8(*(const u32x4*)(hb + off), bb);
#pragma unroll
                    for (int j = 0; j < 8; ++j) { v[j] = bb[j] + fsigmoid(v[j]) * pv[j]; ss += v[j] * v[j]; }
                    *(f32x4*)(out + off) = (f32x4){v[0], v[1], v[2], v[3]}; *(f32x4*)(out + off + 4) = (f32x4){v[4], v[5], v[6], v[7]}; }
                ss += __shfl_xor(ss, 16); ss += __shfl_xor(ss, 32);
                if (fq == 0) ssp[(size_t)row * 16 + u.pn * 4 + wc] = ss; }
    }
};
struct EpiPleFinal { static constexpr bool PERM = true, AFTER_DRAIN = true; const float* ssp_in; const bf16_t* pp; const bf16_t* hb; float* out; const float* fnorm; unsigned* xbuf; unsigned* cnt;
    __device__ __forceinline__ void operator()(const Acc&, const Unit&, int, int, int, int) const {}
    __device__ __forceinline__ void fused(Acc& acc, const Unit& u, int wr, int wc, int fr, int fq, LAS unsigned char* lds, int wid, int lane) const {
        const int row0 = u.pm * 256 + wr * 64 + fr; float rs[2][4]; load_rs(ssp_in, row0, fq, rs);
        LAS float* P = (LAS float*)lds;
        LAS float* Sr = (LAS float*)(lds + 4096);
        LAS unsigned* flag = (LAS unsigned*)(lds + 4096 + 1024);
#pragma unroll
        for (int ai = 0; ai < 2; ++ai)
#pragma unroll
            for (int m = 0; m < 4; ++m) { const int row = row0 + 128 * ai + 16 * m; float ss = 0.f;
#pragma unroll
                for (int bj = 0; bj < 2; ++bj) { const size_t off = (size_t)row * DM + u.pn * 256 + bj * 128 + wc * 32 + fq * 8; float v[8], pv[8], bb[8]; ACC8(v, ai, bj, m, rs[ai][m]);
                    unpack8(*(const u32x4*)(pp + off), pv); unpack8(*(const u32x4*)(hb + off), bb);
#pragma unroll
                    for (int j = 0; j < 8; ++j) { v[j] = bb[j] + fsigmoid(v[j]) * pv[j]; ss += v[j] * v[j]; }
                    acc[ai][bj][m][0] = (f32x4){v[0], v[1], v[2], v[3]}; acc[ai][bj][m][1] = (f32x4){v[4], v[5], v[6], v[7]}; }
                ss += __shfl_xor(ss, 16); ss += __shfl_xor(ss, 32);
                if (fq == 0) P[(128 * ai + 64 * wr + 16 * m + fr) * 4 + wc] = ss; }
        __syncthreads();
        const int tid = wid * 64 + lane;
        if (tid < 256) { const float sum = (P[tid * 4 + 0] + P[tid * 4 + 1]) + (P[tid * 4 + 2] + P[tid * 4 + 3]);
            __hip_atomic_store(xbuf + ((size_t)u.pm * 256 + tid) * 4 + u.pn, __float_as_uint(sum), __ATOMIC_RELAXED, __HIP_MEMORY_SCOPE_AGENT); }
        asm volatile("s_waitcnt vmcnt(0)" ::: "memory");
        if (lane == 0) __hip_atomic_fetch_add(cnt + 64 * u.pm, 1u, __ATOMIC_RELAXED, __HIP_MEMORY_SCOPE_AGENT);
        if (wid == 0) { unsigned sp = 0;
            while ((unsigned)__builtin_amdgcn_readfirstlane(__hip_atomic_load(cnt + 64 * u.pm, __ATOMIC_RELAXED, __HIP_MEMORY_SCOPE_AGENT)) < 32u) { __builtin_amdgcn_s_sleep(2); if (++sp > (1u << 22)) break; }
            __builtin_amdgcn_fence(__ATOMIC_ACQUIRE, "agent");
            if (lane == 0) flag[0] = 1u; }
        asm volatile("s_waitcnt vmcnt(0) lgkmcnt(0)" ::: "memory");
        __syncthreads();
        if (tid < 256) { const unsigned* slot = xbuf + ((size_t)u.pm * 256 + tid) * 4; float s = 0.f;
#pragma unroll
            for (int t = 0; t < 4; ++t) s += __uint_as_float(__hip_atomic_load(slot + t, __ATOMIC_RELAXED, __HIP_MEMORY_SCOPE_AGENT));
            Sr[tid] = rsqrtf(s * (1.0f / 1024.0f) + EPS); }
        __syncthreads();
#pragma unroll
        for (int ai = 0; ai < 2; ++ai)
#pragma unroll
            for (int m = 0; m < 4; ++m) { const int lrow = 128 * ai + 64 * wr + 16 * m + fr; const float r = Sr[lrow];
#pragma unroll
                for (int bj = 0; bj < 2; ++bj) { const int col = u.pn * 256 + bj * 128 + wc * 32 + fq * 8; const size_t off = (size_t)(u.pm * 256 + lrow) * DM + col;
                    const f32x4 g0 = *(const f32x4*)(fnorm + col), g1 = *(const f32x4*)(fnorm + col + 4); const f32x4 a0 = acc[ai][bj][m][0], a1 = acc[ai][bj][m][1];
                    *(f32x4*)(out + off) = (f32x4){a0[0] * r * g0[0], a0[1] * r * g0[1], a0[2] * r * g0[2], a0[3] * r * g0[3]};
                    *(f32x4*)(out + off + 4) = (f32x4){a1[0] * r * g1[0], a1[1] * r * g1[1], a1[2] * r * g1[2], a1[3] * r * g1[3]}; } }
    }
};
template <int MODE> struct EpiBf16 { static constexpr bool PERM = true, AFTER_DRAIN = false; bf16_t* O; const float* ssp; const bf16_t* mul; const bf16_t* add;
    __device__ __forceinline__ void operator()(const Acc& acc, const Unit& u, int wr, int wc, int fr, int fq) const {
        const int row0 = u.pm * 256 + wr * 64 + fr; float rs[2][4];
        if (MODE == 1 || MODE == 4) load_rs(ssp, row0, fq, rs);
#pragma unroll
        for (int ai = 0; ai < 2; ++ai)
#pragma unroll
            for (int m = 0; m < 4; ++m)
#pragma unroll
                for (int bj = 0; bj < 2; ++bj) { const size_t off = (size_t)(row0 + 128 * ai + 16 * m) * DM + u.pn * 256 + bj * 128 + wc * 32 + fq * 8; float v[8];
                    ACC8(v, ai, bj, m, (MODE == 1 ? rs[ai][m] : 1.0f));
                    if (MODE == 1) {
#pragma unroll
                        for (int j = 0; j < 8; ++j) v[j] = fsigmoid(v[j]); }
                    if (MODE == 2 || MODE == 3) { float mv[8]; unpack8(*(const u32x4*)(mul + off), mv);
#pragma unroll
                        for (int j = 0; j < 8; ++j) v[j] *= mv[j]; }
                    if (MODE == 4) { float mv[8]; unpack8(*(const u32x4*)(mul + off), mv);
#pragma unroll
                        for (int j = 0; j < 8; ++j) mv[j] *= rs[ai][m];
                        sigmoid8(mv);
#pragma unroll
                        for (int j = 0; j < 8; ++j) v[j] *= mv[j]; }
                    if (MODE == 3 || MODE == 4) { float av[8]; unpack8(*(const u32x4*)(add + off), av);
#pragma unroll
                        for (int j = 0; j < 8; ++j) v[j] += av[j]; }
                    *(u32x4*)(O + off) = pack8(v); }
    }
};
struct EpiCmp1 { static constexpr bool PERM = true, AFTER_DRAIN = false; bf16_t* chid; const float* bias;
    __device__ __forceinline__ void operator()(const Acc& acc, const Unit& u, int wr, int wc, int fr, int fq) const {
        const int row0 = u.pm * 256 + wr * 64 + fr; const float* bs = bias + (u.pm >> 4) * 256;
#pragma unroll
        for (int bj = 0; bj < 2; ++bj) { const int col = bj * 128 + wc * 32 + fq * 8; const f32x4 b0 = *(const f32x4*)(bs + col), b1 = *(const f32x4*)(bs + col + 4);
            const float bb[8] = {b0[0], b0[1], b0[2], b0[3], b1[0], b1[1], b1[2], b1[3]};
#pragma unroll
            for (int ai = 0; ai < 2; ++ai)
#pragma unroll
                for (int m = 0; m < 4; ++m) { float v[8]; ACC8(v, ai, bj, m, 1.0f);
#pragma unroll
                    for (int j = 0; j < 8; ++j) v[j] = fgelu(v[j] + bb[j]);
                    *(u32x4*)(chid + (size_t)(row0 + 128 * ai + 16 * m) * 256 + col) = pack8(v); } }
    }
};
__device__ __forceinline__ void rope8(float (&v)[8], int fq, const float* cs) {
    const f32x4 c0 = *(const f32x4*)(cs), c1 = *(const f32x4*)(cs + 4), c2 = *(const f32x4*)(cs + 8), c3 = *(const f32x4*)(cs + 12);
    const float cc[8] = {c0[0], c0[2], c1[0], c1[2], c2[0], c2[2], c3[0], c3[2]}, sn[8] = {c0[1], c0[3], c1[1], c1[3], c2[1], c2[3], c3[1], c3[3]};
#pragma unroll
    for (int j = 0; j < 8; ++j) { const float other = __shfl_xor(v[j], 16); v[j] = (fq == 0) ? (v[j] * cc[j] - other * sn[j]) : (v[j] * cc[j] + other * sn[j]); }
}
struct EpiProj { static constexpr bool PERM = true, AFTER_DRAIN = false;
    const float* ssp; const float* rope; bf16_t *ub, *gv, *qraw, *qrot, *kc, *vc, *ks, *kw, *vst, *vwt, *ga; float* vstat; float* gate;
    __device__ __forceinline__ void operator()(const Acc& acc, const Unit& u, int wr, int wc, int fr, int fq) const {
        const int row0 = u.pm * 256 + wr * 64 + fr; float rs[2][4]; load_rs(ssp, row0, fq, rs);
        const int pn = u.pn;
        if (pn < 4) {
#pragma unroll
            for (int ai = 0; ai < 2; ++ai)
#pragma unroll
                for (int m = 0; m < 4; ++m)
#pragma unroll
                    for (int bj = 0; bj < 2; ++bj) { float v[8]; ACC8(v, ai, bj, m, rs[ai][m]);
#pragma unroll
                        for (int j = 0; j < 1; ++j) {}
                        gelu8(v);
                        *(u32x4*)(ub + (size_t)(row0 + 128 * ai + 16 * m) * DM + pn * 256 + bj * 128 + wc * 32 + fq * 8) = pack8(v); }
        } else if (pn >= 18 && pn < 22) {
#pragma unroll
            for (int ai = 0; ai < 2; ++ai)
#pragma unroll
                for (int m = 0; m < 4; ++m)
#pragma unroll
                    for (int bj = 0; bj < 2; ++bj) { float v[8]; ACC8(v, ai, bj, m, rs[ai][m]);
#pragma unroll
                        for (int j = 0; j < 1; ++j) {}
                        sigmoid8(v);
                        *(u32x4*)(ga + (size_t)(row0 + 128 * ai + 16 * m) * DM + (pn - 18) * 256 + bj * 128 + wc * 32 + fq * 8) = pack8(v); }
        } else if (pn < 8) {
#pragma unroll
            for (int ai = 0; ai < 2; ++ai)
#pragma unroll
                for (int m = 0; m < 4; ++m) { const int row = row0 + 128 * ai + 16 * m; float s1 = 0.f, s2 = 0.f;
#pragma unroll
                    for (int bj = 0; bj < 2; ++bj) { float v[8]; ACC8(v, ai, bj, m, rs[ai][m]);
#pragma unroll
                        for (int j = 0; j < 1; ++j) {}
                        gelu8(v);
#pragma unroll
                        for (int j = 0; j < 8; ++j) { s1 += v[j]; s2 += v[j] * v[j]; }
                        *(u32x4*)(gv + (size_t)row * DM + (pn - 4) * 256 + bj * 128 + wc * 32 + fq * 8) = pack8(v); }
                    s1 += __shfl_xor(s1, 16); s1 += __shfl_xor(s1, 32); s2 += __shfl_xor(s2, 16); s2 += __shfl_xor(s2, 32);
                    if (fq == 0) *(f32x2*)(vstat + ((size_t)row * 16 + (pn - 4) * 4 + wc) * 2) = (f32x2){s1, s2}; }
        } else if (pn < 12) {
#pragma unroll
            for (int ai = 0; ai < 2; ++ai)
#pragma unroll
                for (int m = 0; m < 4; ++m) { const int row = row0 + 128 * ai + 16 * m;
#pragma unroll
                    for (int bj = 0; bj < 2; ++bj) { float v[8]; ACC8(v, ai, bj, m, rs[ai][m] * QSCALE);
                        *(u32x4*)(qraw + (size_t)row * DM + (pn - 8) * 256 + bj * 128 + wc * 32 + fq * 8) = pack8(v);
                        if ((wc & 1) == 0) { rope8(v, fq, rope + (size_t)(row & (SEQ - 1)) * 16);
                            const int head = (pn - 8) * 4 + bj * 2 + (wc >> 1);
                            if (fq < 2) *(u32x4*)(qrot + ((size_t)row * 16 + head) * 16 + fq * 8) = pack8(v); } } }
        } else if (pn == 12 || pn == 13 || pn == 14 || pn == 16) {
            bf16_t* O = pn == 12 ? kc : pn == 13 ? vc : pn == 14 ? ks : kw; const bool rot = pn >= 14;
#pragma unroll
            for (int ai = 0; ai < 2; ++ai)
#pragma unroll
                for (int m = 0; m < 4; ++m) { const int row = row0 + 128 * ai + 16 * m;
#pragma unroll
                    for (int bj = 0; bj < 2; ++bj) { float v[8]; ACC8(v, ai, bj, m, rs[ai][m]);
                        if (rot && (wc & 1) == 0) { float w[8];
#pragma unroll
                            for (int j = 0; j < 8; ++j) w[j] = v[j];
                            rope8(w, fq, rope + (size_t)(row & (SEQ - 1)) * 16);
                            if (fq < 2) {
#pragma unroll
                                for (int j = 0; j < 8; ++j) v[j] = w[j]; } }
                        *(u32x4*)(O + (size_t)row * 256 + bj * 128 + wc * 32 + fq * 8) = pack8(v); } }
        } else if (pn == 15 || pn == 17) {
            bf16_t* O = pn == 15 ? vst : vwt;
#pragma unroll
            for (int ai = 0; ai < 2; ++ai)
#pragma unroll
                for (int m = 0; m < 4; ++m) { const int row = row0 + 128 * ai + 16 * m; const int b = row >> 12, t = row & (SEQ - 1);
#pragma unroll
                    for (int bj = 0; bj < 2; ++bj) { float v[8]; ACC8(v, ai, bj, m, rs[ai][m]); const int kvh = bj * 2 + (wc >> 1), d0 = (wc & 1) * 32 + fq * 8;
                        bf16_t* p = O + ((size_t)(b * 4 + kvh) * 64 + d0) * SEQ + t;
#pragma unroll
                        for (int j = 0; j < 8; j += 2) { const unsigned w = cvt_pk_bf16(v[j], v[j + 1]); p[(size_t)j * SEQ] = (bf16_t)(w & 0xffffu); p[(size_t)(j + 1) * SEQ] = (bf16_t)(w >> 16); } } }
        } else {
            if (wc < 2) {
#pragma unroll
                for (int ai = 0; ai < 2; ++ai)
#pragma unroll
                    for (int m = 0; m < 4; ++m) { const int row = row0 + 128 * ai + 16 * m; float v[8]; ACC8(v, ai, 0, m, rs[ai][m]); const int col = wc * 32 + fq * 8;
                        if (col < 48) {
#pragma unroll
                            for (int j = 0; j < 8; ++j) v[j] = fsigmoid(v[j]);
                            *(f32x4*)(gate + (size_t)row * 48 + col) = (f32x4){v[0], v[1], v[2], v[3]}; *(f32x4*)(gate + (size_t)row * 48 + col + 4) = (f32x4){v[4], v[5], v[6], v[7]}; } }
            }
        }
    }
};
}

struct Ctx { LAS unsigned char* lds; int tid, lane, wave, G, bid; };

__device__ __forceinline__ float wave_sum(float v) {
#pragma unroll
    for (int o = 1; o < 64; o <<= 1) v += __shfl_xor(v, o);
    return v;
}
__device__ __forceinline__ int map_row(int map, int n) {
    if (map == 1) { const int up = n >= FF ? 1 : 0, j = n - up * FF; return (j >> 7) * 256 + up * 128 + (j & 127); }
    if (map == 2) { if (n < 4608) return n; if (n < 4656) return 5632 + (n - 4608); if (n < 5680) return 4608 + (n - 4656); return N3 + (n - 5680); }
    return n;
}
constexpr int TR_SCR = 17408;
__device__ __forceinline__ void transpose_item(const float* W, int K, int N, bf16_t* WT, const float* ks, int map, LAS float* scr, int item, int lane) {
    const int nblk = (N + 63) / 64, kb = item / nblk, nb = item % nblk, k0 = 64 * kb, n0 = 64 * nb;
    const int n4 = (lane & 15) * 4, r0 = lane >> 4;
    f32x4 v[16];
#pragma unroll
    for (int i = 0; i < 16; ++i) { const int kk = r0 + 4 * i; v[i] = (f32x4){0.f, 0.f, 0.f, 0.f}; if (n0 + n4 < N) v[i] = *(const f32x4*)(W + (size_t)(k0 + kk) * N + n0 + n4); }
#pragma unroll
    for (int i = 0; i < 16; ++i) { const int kk = r0 + 4 * i; const float sc = ks ? ks[k0 + kk] : 1.0f; LAS float* d = scr + kk * 65 + n4;
        d[0] = v[i].x * sc; d[1] = v[i].y * sc; d[2] = v[i].z * sc; d[3] = v[i].w * sc; }
    LDS_FENCE();
    const int c = lane >> 3, nl = lane & 7;
#pragma unroll
    for (int j = 0; j < 8; ++j) { const int nn = nl + 8 * j, n = n0 + nn;
        if (n < N) { const LAS float* s0 = scr + (8 * c) * 65 + nn;
            u32x4 o; o.x = cvt_pk_bf16(s0[0 * 65], s0[1 * 65]); o.y = cvt_pk_bf16(s0[2 * 65], s0[3 * 65]); o.z = cvt_pk_bf16(s0[4 * 65], s0[5 * 65]); o.w = cvt_pk_bf16(s0[6 * 65], s0[7 * 65]);
            *(u32x4*)(WT + (size_t)map_row(map, n) * K + k0 + 8 * c) = o; } }
    LDS_FENCE();
}
struct TJob { const float* W; int K, N; bf16_t* dst; const float* ks; int map; };
__device__ __forceinline__ int tjob_items(const TJob& j) { return (j.K / 64) * ((j.N + 63) / 64); }

struct Args {
    const float* in[27]; float* out; unsigned char* ws; int ph_lo, ph_hi;
};
enum { I_X = 0, I_P, I_F1N, I_F1WI, I_F1WO, I_MIXN, I_WIN, I_LNG, I_LNB, I_GWS, I_GBS, I_WA, I_CPK, I_CKW1, I_CKW2, I_CPV, I_CVW1, I_CVW2, I_WB, I_WO,
       I_F2N, I_F2WI, I_F2WO, I_PLEN, I_PLEG, I_PLEP, I_FIN };

__device__ __forceinline__ void run_tjobs(const Ctx& C, const TJob* jobs, int njobs) {
    LAS float* scr = (LAS float*)(C.lds + C.wave * TR_SCR);
    const int gw = C.bid * 8 + C.wave, NGW = C.G * 8;
    int total = 0;
    for (int j = 0; j < njobs; ++j) total += tjob_items(jobs[j]);
    for (int it = gw; it < total; it += NGW) { int r = it;
        for (int j = 0; j < njobs; ++j) { const int n = tjob_items(jobs[j]); if (r < n) { transpose_item(jobs[j].W, jobs[j].K, jobs[j].N, jobs[j].dst, jobs[j].ks, jobs[j].map, scr, r, C.lane); break; } r -= n; } }
}

__device__ __forceinline__ void small_weight_item(const Args& a, unsigned char* ws, LAS float* scr, int r, int lane) {
    if (r < 256) { transpose_item(a.in[I_WA], 1024, 1024, (bf16_t*)(ws + WS_WA), nullptr, 0, scr, r, lane); return; } r -= 256;
    if (r < 256) { transpose_item(a.in[I_WB], 1024, 1024, (bf16_t*)(ws + WS_WB), nullptr, 0, scr, r, lane); return; } r -= 256;
    if (r < 256) { transpose_item(a.in[I_WO], 1024, 1024, (bf16_t*)(ws + WS_WO), nullptr, 0, scr, r, lane); return; } r -= 256;
    if (r < 256) { transpose_item(a.in[I_PLEG], 1024, 1024, (bf16_t*)(ws + WS_WPG), a.in[I_PLEN], 0, scr, r, lane); return; } r -= 256;
    transpose_item(a.in[I_PLEP], 256, 1024, (bf16_t*)(ws + WS_WPP), nullptr, 0, scr, r, lane);
}

__device__ __forceinline__ void p0_prologue(const Ctx& C, const Args& a) {
    unsigned char* ws = a.ws;
    {
        const int gw = C.bid * 8 + C.wave, NGW = C.G * 8;
        LAS float* scr = (LAS float*)(C.lds + C.wave * TR_SCR);
        const bool split = (C.G == 256);
        for (int it = gw; it < (split ? 4048 : 5136); it += NGW) { int r = it;
            if (r < 1408) { transpose_item(a.in[I_F1WI], 1024, 5632, (bf16_t*)(ws + WS_WFIN), a.in[I_F1N], 1, scr, r, C.lane); continue; } r -= 1408;
            if (r < 704) { transpose_item(a.in[I_F1WO], 2816, 1024, (bf16_t*)(ws + WS_WFOUT), nullptr, 0, scr, r, C.lane); continue; } r -= 704;
            if (r < 1680) { transpose_item(a.in[I_WIN], 1024, 6704, (bf16_t*)(ws + WS_WIN), a.in[I_MIXN], 2, scr, r, C.lane); continue; } r -= 1680;
            if (r < 128) { transpose_item(a.in[I_CKW1], 2048, 256, (bf16_t*)(ws + WS_WC1), nullptr, 0, scr, r, C.lane); continue; } r -= 128;
            if (r < 128) { transpose_item(a.in[I_CVW1], 2048, 256, (bf16_t*)(ws + WS_WC1) + 256 * 2048, nullptr, 0, scr, r, C.lane); continue; } r -= 128;
            small_weight_item(a, ws, scr, r, C.lane);
        }
        const float* x = a.in[I_X]; bf16_t* xb = (bf16_t*)(ws + WS_XB); float* ssa = (float*)(ws + WS_SSA);
        for (int r = gw; r < T; r += NGW) { const f32x4* xr = (const f32x4*)(x + (size_t)r * DM) + C.lane; float s = 0.f; f32x4 v[4];
#pragma unroll
            for (int j = 0; j < 4; ++j) { v[j] = xr[64 * j]; s += (v[j].x * v[j].x + v[j].y * v[j].y) + (v[j].z * v[j].z + v[j].w * v[j].w); }
            s = wave_sum(s);
            u32x2* o = (u32x2*)(xb + (size_t)r * DM) + C.lane;
#pragma unroll
            for (int j = 0; j < 4; ++j) o[64 * j] = (u32x2){cvt_pk_bf16(v[j].x, v[j].y), cvt_pk_bf16(v[j].z, v[j].w)};
            if (C.lane < 16) ssa[(size_t)r * 16 + C.lane] = C.lane == 0 ? s : 0.f; }
        float* cb = (float*)(ws + WS_CBIAS);
        for (int it = gw; it < 64; it += NGW) { const int tsr = it >> 5, n0 = (it & 31) * 8; const float* pos = a.in[tsr ? I_CPV : I_CPK]; const float* w1 = a.in[tsr ? I_CVW1 : I_CKW1];
            float acc8[8] = {0.f, 0.f, 0.f, 0.f, 0.f, 0.f, 0.f, 0.f};
            for (int i = 0; i < 32; ++i) { const int k = C.lane + 64 * i; const float pk = pos[k]; const f32x4 w0 = *(const f32x4*)(w1 + (size_t)k * 256 + n0), w4 = *(const f32x4*)(w1 + (size_t)k * 256 + n0 + 4);
                acc8[0] += pk * w0[0]; acc8[1] += pk * w0[1]; acc8[2] += pk * w0[2]; acc8[3] += pk * w0[3]; acc8[4] += pk * w4[0]; acc8[5] += pk * w4[1]; acc8[6] += pk * w4[2]; acc8[7] += pk * w4[3]; }
#pragma unroll
            for (int j = 0; j < 8; ++j) { const float s = wave_sum(acc8[j]); if (C.lane == 0) cb[tsr * 256 + n0 + j] = s; } }
    }
    const int gt = C.bid * 512 + C.tid, NGT = C.G * 512;
    {
        float* rope = (float*)(ws + WS_ROPE);
        for (int e = gt; e < SEQ * 8; e += NGT) { const int t = e >> 3, i = e & 7;
            const float invf = i == 0 ? 1.0f : i == 1 ? 0.1939227432012558f : i == 2 ? 0.03760603070259094f : i == 3 ? 0.007292664609849453f : i == 4 ? 0.0014142135623842478f : i == 5 ? 0.00027424818836152554f : i == 6 ? 5.318296098266728e-05f : 1.0313386155758053e-05f;
            const float angf = (float)t * invf; const double ang = (double)angf;
            const double qd = __builtin_rint(ang * 0.63661977236758134308); const double r = (ang - qd * 1.5707963267948966192) - qd * 6.123233995736766e-17; const int qi = ((int)qd) & 3;
            const double r2 = r * r;
            const double sr = r * (1.0 + r2 * (-1.0 / 6 + r2 * (1.0 / 120 + r2 * (-1.0 / 5040 + r2 * (1.0 / 362880 + r2 * (-1.0 / 39916800 + r2 * (1.0 / 6227020800.0)))))));
            const double cr = 1.0 + r2 * (-0.5 + r2 * (1.0 / 24 + r2 * (-1.0 / 720 + r2 * (1.0 / 40320 + r2 * (-1.0 / 3628800 + r2 * (1.0 / 479001600.0 + r2 * (-1.0 / 87178291200.0)))))));
            const double sn = qi == 0 ? sr : qi == 1 ? cr : qi == 2 ? -sr : -cr, cs = qi == 0 ? cr : qi == 1 ? -sr : qi == 2 ? -cr : sr;
            rope[e * 2] = (float)cs; rope[e * 2 + 1] = (float)sn; }
    }
    {
        const float* w = a.in[I_GWS]; bf16_t* o = (bf16_t*)(ws + WS_GMW);
        for (int e = gt; e < 8 * 128 * 128; e += NGT) { const int t = (e >> 7) & 127, s = e & 127; const float v = s <= t ? w[e] : 0.f; o[e] = (bf16_t)(cvt_pk_bf16(v, 0.f) & 0xffffu); }
    }
}

__device__ __forceinline__ void p8_extras(const Ctx& C, const Args& a) {
    unsigned char* ws = a.ws; const int gw = C.bid * 8 + C.wave, NGW = C.G * 8;
    LAS float* scr = (LAS float*)(C.lds + C.wave * TR_SCR);
    for (int it = gw; it < 2112; it += NGW) { int r = it;
        if (r < 1408) { transpose_item(a.in[I_F2WI], 1024, 5632, (bf16_t*)(ws + WS_WFIN), a.in[I_F2N], 1, scr, r, C.lane); continue; } r -= 1408;
        transpose_item(a.in[I_F2WO], 2816, 1024, (bf16_t*)(ws + WS_WFOUT), nullptr, 0, scr, r, C.lane); }
    const float* p = a.in[I_P]; bf16_t* pb = (bf16_t*)(ws + WS_PB);
    for (int r = gw; r < T; r += NGW) { const f32x4 v = ((const f32x4*)(p + (size_t)r * PLE))[C.lane]; ((u32x2*)(pb + (size_t)r * PLE))[C.lane] = (u32x2){cvt_pk_bf16(v.x, v.y), cvt_pk_bf16(v.z, v.w)}; }
}

__device__ __forceinline__ void gmlp_job(const Ctx& C, const Args& a, int job) {
    unsigned char* ws = a.ws; const int g = job & 7, chunk = job >> 3; const int tok0 = chunk * 128;
    const bf16_t* gv = (const bf16_t*)(ws + WS_GV); bf16_t* ub = (bf16_t*)(ws + WS_UB); const float* vstat = (const float*)(ws + WS_VSTAT); const bf16_t* gmw = (const bf16_t*)(ws + WS_GMW);
    LAS bf16_t* vnT = (LAS bf16_t*)C.lds;
    const int wr = C.wave >> 1, wc = C.wave & 1, n = C.lane & 31, hi = C.lane >> 5;
    bf16x8 af[8];
    {   const bf16_t* wrow = gmw + ((size_t)g * 128 + wr * 32 + n) * 128 + 8 * hi;
#pragma unroll
        for (int k0 = 0; k0 < 8; ++k0) af[k0] = *(const bf16x8*)(wrow + 16 * k0); }
    {   const int s = C.tid >> 2, cq = C.tid & 3; const size_t row = (size_t)tok0 + s;
        float s1 = 0.f, s2 = 0.f;
#pragma unroll
        for (int k = 0; k < 8; ++k) { const f32x4 p = *(const f32x4*)(vstat + row * 32 + 4 * k); s1 += p.x + p.z; s2 += p.y + p.w; }
        const float mean = s1 * (1.0f / 1024.0f), var = s2 * (1.0f / 1024.0f) - mean * mean, rstd = rsqrtf(var + EPS);
        const float* lng = a.in[I_LNG] + g * 128 + cq * 32; const float* lnb = a.in[I_LNB] + g * 128 + cq * 32;
#pragma unroll
        for (int c8 = 0; c8 < 4; ++c8) { float v[8]; unpack8(*(const u32x4*)(gv + row * DM + g * 128 + cq * 32 + c8 * 8), v);
#pragma unroll
            for (int j = 0; j < 8; ++j) { const float y = (v[j] - mean) * rstd * lng[c8 * 8 + j] + lnb[c8 * 8 + j]; vnT[(cq * 32 + c8 * 8 + j) * 136 + s] = (bf16_t)(cvt_pk_bf16(y, 0.f) & 0xffffu); } }
    }
    __syncthreads();
    {   f32x16 acc0 = {}, acc1 = {};
        const LAS bf16_t* b0p = vnT + (wc * 64 + n) * 136 + 8 * hi; const LAS bf16_t* b1p = b0p + 32 * 136;
#pragma unroll
        for (int k0 = 0; k0 < 8; ++k0) if (k0 < 2 * (wr + 1)) { const bf16x8 bf0 = *(const LAS bf16x8*)(b0p + 16 * k0), bf1 = *(const LAS bf16x8*)(b1p + 16 * k0);
            acc0 = __builtin_amdgcn_mfma_f32_32x32x16_bf16(af[k0], bf0, acc0, 0, 0, 0); acc1 = __builtin_amdgcn_mfma_f32_32x32x16_bf16(af[k0], bf1, acc1, 0, 0, 0); }
        const float* bs = a.in[I_GBS] + g * 128 + wr * 32;
#pragma unroll
        for (int r = 0; r < 16; ++r) { const int tl = (r & 3) + 8 * (r >> 2) + 4 * hi; const float bias = bs[tl]; const size_t off = ((size_t)tok0 + wr * 32 + tl) * DM + g * 128 + wc * 64 + n;
            const float u0 = bf2f(ub[off]), u1 = bf2f(ub[off + 32]);
            ub[off] = (bf16_t)(cvt_pk_bf16(u0 * (acc0[r] + bias), 0.f) & 0xffffu); ub[off + 32] = (bf16_t)(cvt_pk_bf16(u1 * (acc1[r] + bias), 0.f) & 0xffffu); }
    }
    __syncthreads();
}

__device__ __forceinline__ void cmp2_phase(const Ctx& C, const Args& a) {
    unsigned char* ws = a.ws; const bf16_t* chid = (const bf16_t*)(ws + WS_CHID); bf16_t* kcmp = (bf16_t*)(ws + WS_KCMP); bf16_t* vcmpT = (bf16_t*)(ws + WS_VCMPT);
    const int gw = C.bid * 8 + C.wave, NGW = C.G * 8;
    for (int it = gw; it < 2048; it += NGW) { const int tsr = it >> 10, R0 = (it & 1023) * 4;
        const float* w2 = a.in[tsr ? I_CVW2 : I_CKW2]; const bf16_t* hr = chid + ((size_t)tsr * 4096 + R0) * 256;
        float acc[4] = {0.f, 0.f, 0.f, 0.f};
        for (int k8 = 0; k8 < 32; ++k8) { float wv[8];
#pragma unroll
            for (int j = 0; j < 8; ++j) wv[j] = w2[(k8 * 8 + j) * 64 + C.lane];
#pragma unroll
            for (int rr = 0; rr < 4; ++rr) { float hv[8]; unpack8(*(const u32x4*)(hr + rr * 256 + k8 * 8), hv);
#pragma unroll
                for (int j = 0; j < 8; ++j) acc[rr] += hv[j] * wv[j]; } }
#pragma unroll
        for (int rr = 0; rr < 4; ++rr) { const int R = R0 + rr; const int h = R >> 10, b = (R >> 8) & 3, i = R & 255;
            const bf16_t o = (bf16_t)(cvt_pk_bf16(i == 255 ? 0.f : acc[rr], 0.f) & 0xffffu);
            if (tsr == 0) kcmp[((size_t)(b * 4 + h) * 256 + i) * 64 + C.lane] = o; else vcmpT[((size_t)(b * 4 + h) * 64 + C.lane) * 256 + i] = o; } }
}

__device__ __forceinline__ void final_phase(const Ctx& C, const Args& a) {
    const float* ssa = (const float*)(a.ws + WS_SSA); const float* fn = a.in[I_FIN]; const int gw = C.bid * 8 + C.wave, NGW = C.G * 8;
    for (int r = gw; r < T; r += NGW) { float s = C.lane < 16 ? ssa[(size_t)r * 16 + C.lane] : 0.f; s = wave_sum(s); const float rstd = rsqrtf(s * (1.0f / 1024.0f) + EPS);
        f32x4* o = (f32x4*)(a.out + (size_t)r * DM) + C.lane; const f32x4* gp = (const f32x4*)fn + C.lane;
#pragma unroll
        for (int j = 0; j < 4; ++j) { const f32x4 v = o[64 * j], gg = gp[64 * j]; o[64 * j] = (f32x4){v.x * rstd * gg.x, v.y * rstd * gg.y, v.z * rstd * gg.z, v.w * rstd * gg.w}; } }
}

namespace att {
constexpr int ROWB = 144;
constexpr int TILEB = 64 * ROWB;
constexpr int OFF_K = 0, OFF_V = 2 * TILEB, OFF_PC = 4 * TILEB, PCROW = 260, OFF_WSF = OFF_PC + 64 * PCROW * 4, OFF_SELM = OFF_WSF + 8 * 64 * 4, LDS_END = OFF_SELM + 64 * 8;
static_assert(LDS_END <= 131072, "attention LDS");
__device__ __forceinline__ int crow(int r, int hi) { return (r & 3) + 8 * (r >> 2) + 4 * hi; }

struct Stream { const bf16_t* K; size_t kstride; const bf16_t* V; size_t vstride; };

struct State { float m, l; f32x16 o0, o1; };

struct Pre { u32x4 k0, v0, k1; };
__device__ __forceinline__ Pre prefetch(int tid, const Stream& S, int t0, int nt, bool needv) {
    const int lr = tid >> 3, lc = tid & 7; Pre p;
    const bf16_t* kg = S.K + (size_t)(t0 * 64 + lr) * S.kstride + lc * 8;
    p.k0 = *(const u32x4*)kg; p.v0 = (u32x4){0u, 0u, 0u, 0u}; p.k1 = p.v0;
    if (needv) p.v0 = *(const u32x4*)(S.V + (size_t)lr * S.vstride + (size_t)t0 * 64 + lc * 8);
    if (nt > 1) p.k1 = *(const u32x4*)(kg + (size_t)64 * S.kstride);
    return p;
}
template <int MODE>
__device__ __forceinline__ void run_branch(int tid, LAS unsigned char* lds, const Stream& S, const Pre& pre, int t0, int nt, const bf16x8 (&qf)[4], int klo, int khi, unsigned long long selbits,
                                           State& st, float inv_l, int tokl, int g) {
    const int lane = tid & 63, q = lane & 31, hi = lane >> 5, wid = __builtin_amdgcn_readfirstlane(tid >> 6);
    const int lr = tid >> 3, lc = tid & 7;
    const int pim = 16 * (q >> 4) + 8 * ((q >> 2) & 1) + 4 * ((q >> 3) & 1) + (q & 3);
    LAS float* wsf = (LAS float*)(lds + OFF_WSF) + wid * 64;
    LAS float* pc = (LAS float*)(lds + OFF_PC);
    const bf16_t* kg = S.K + (size_t)(t0 * 64 + lr) * S.kstride + lc * 8;
    const bf16_t* vg = S.V + (size_t)lr * S.vstride + (size_t)t0 * 64 + lc * 8;
    const unsigned sto = lr * ROWB + lc * 16;
    u32x4 kreg = pre.k1, vreg = pre.v0;
    *(LAS u32x4*)(lds + OFF_K + sto) = pre.k0; if (MODE != 1) *(LAS u32x4*)(lds + OFF_V + sto) = pre.v0;
    if (nt > 1) *(LAS u32x4*)(lds + OFF_K + TILEB + sto) = pre.k1;
    __syncthreads();
    const LAS unsigned char* kfb = lds + OFF_K + pim * ROWB + hi * 16;
    f32x16 p0 = {}, p1 = {};
#pragma unroll
    for (int d0 = 0; d0 < 4; ++d0) { const bf16x8 a0 = *(const LAS bf16x8*)(kfb + d0 * 32), a1 = *(const LAS bf16x8*)(kfb + 32 * ROWB + d0 * 32);
        p0 = __builtin_amdgcn_mfma_f32_32x32x16_bf16(a0, qf[d0], p0, 0, 0, 0); p1 = __builtin_amdgcn_mfma_f32_32x32x16_bf16(a1, qf[d0], p1, 0, 0, 0); }
    f32x16 q0 = {}, q1 = {};
    for (int t = 0; t < nt; t += 2) {
        {   const int jt = t0 + t; constexpr int buf = 0;
        if (t + 2 < nt) kreg = *(const u32x4*)(kg + (size_t)(t + 2) * 64 * S.kstride);
        if (MODE != 1 && t + 1 < nt) vreg = *(const u32x4*)(vg + (size_t)(t + 1) * 64);
        const int kb0 = jt * 64;
        const bool bit = (selbits >> jt) & 1ull;
        const bool none = !bit || kb0 > khi || kb0 + 63 < klo;
        const bool allv = bit && kb0 >= klo && kb0 + 63 <= khi;
        const bool colv = !none;
        if (__any(colv && !allv)) {
            const int hr = khi - kb0 - 8 * hi, lrr = klo - kb0 - 8 * hi;
#pragma unroll
            for (int r = 0; r < 16; ++r) { const int c = 16 * (r >> 3) + (r & 7);
                if (!(c <= hr && c >= lrr)) p0[r] = -__builtin_inff();
                if (!(c + 32 <= hr && c + 32 >= lrr)) p1[r] = -__builtin_inff(); }
        }
        float tm = fmaxf(fmaxf(p0[0], p0[1]), p0[2]);
#pragma unroll
        for (int r = 3; r < 15; r += 2) tm = fmaxf(fmaxf(tm, p0[r]), p0[r + 1]);
        tm = fmaxf(tm, p0[15]);
#pragma unroll
        for (int r = 0; r < 16; r += 2) tm = fmaxf(fmaxf(tm, p1[r]), p1[r + 1]);
        tm = fmaxf(tm, __shfl_xor(tm, 32));
        if (!colv) tm = -__builtin_inff();
        float mref;
        if (MODE == 2) { mref = st.m; }
        else {
            if (__any(tm > st.m + 8.0f)) {
                const float mn = fmaxf(st.m, tm); const float alpha = __builtin_amdgcn_exp2f(st.m - mn); st.l *= alpha; st.m = mn;
                if (MODE == 0) { if (hi == 0) wsf[q] = alpha; LDS_FENCE();
#pragma unroll
                    for (int r = 0; r < 16; ++r) { const float f = wsf[crow(r, hi)]; st.o0[r] *= f; st.o1[r] *= f; }
                    LDS_FENCE(); }
            }
            mref = st.m;
        }
        const float msub = colv ? mref : __builtin_inff();
        q0 = (f32x16){}; q1 = (f32x16){};
        {   const LAS unsigned char* kb = kfb + (buf ^ 1) * TILEB;
#pragma unroll
            for (int d0 = 0; d0 < 4; ++d0) { const bf16x8 a0 = *(const LAS bf16x8*)(kb + d0 * 32), a1 = *(const LAS bf16x8*)(kb + 32 * ROWB + d0 * 32);
                q0 = __builtin_amdgcn_mfma_f32_32x32x16_bf16(a0, qf[d0], q0, 0, 0, 0); q1 = __builtin_amdgcn_mfma_f32_32x32x16_bf16(a1, qf[d0], q1, 0, 0, 0); } }
        float ls = 0.f;
#pragma unroll
        for (int r = 0; r < 16; ++r) { p0[r] = __builtin_amdgcn_exp2f(p0[r] - msub); p1[r] = __builtin_amdgcn_exp2f(p1[r] - msub); ls += p0[r] + p1[r]; }
        if (MODE != 2) st.l += ls;
        if (MODE == 2) {
#pragma unroll
            for (int r = 0; r < 16; ++r) { p0[r] *= inv_l; p1[r] *= inv_l; }
            float hs0[16], hs1[16];
#pragma unroll
            for (int r = 0; r < 16; ++r) { hs0[r] = quad_sum(p0[r]); hs1[r] = quad_sum(p1[r]); }
            if (g == 0) { LAS float* pr = pc + tokl * PCROW + kb0 + 8 * hi;
#pragma unroll
                for (int r = 0; r < 16; ++r) { pr[16 * (r >> 3) + (r & 7)] = hs0[r]; pr[16 * (r >> 3) + (r & 7) + 32] = hs1[r]; } }
        }
        if (MODE != 1) {
            bf16x8 pa[4];
            {   u32x4 w;
                w.x = cvt_pk_bf16(p0[0], p0[1]); w.y = cvt_pk_bf16(p0[2], p0[3]); w.z = cvt_pk_bf16(p0[4], p0[5]); w.w = cvt_pk_bf16(p0[6], p0[7]); pa[0] = __builtin_bit_cast(bf16x8, w);
                w.x = cvt_pk_bf16(p0[8], p0[9]); w.y = cvt_pk_bf16(p0[10], p0[11]); w.z = cvt_pk_bf16(p0[12], p0[13]); w.w = cvt_pk_bf16(p0[14], p0[15]); pa[1] = __builtin_bit_cast(bf16x8, w);
                w.x = cvt_pk_bf16(p1[0], p1[1]); w.y = cvt_pk_bf16(p1[2], p1[3]); w.z = cvt_pk_bf16(p1[4], p1[5]); w.w = cvt_pk_bf16(p1[6], p1[7]); pa[2] = __builtin_bit_cast(bf16x8, w);
                w.x = cvt_pk_bf16(p1[8], p1[9]); w.y = cvt_pk_bf16(p1[10], p1[11]); w.z = cvt_pk_bf16(p1[12], p1[13]); w.w = cvt_pk_bf16(p1[14], p1[15]); pa[3] = __builtin_bit_cast(bf16x8, w); }
            const LAS unsigned char* vb = lds + OFF_V + buf * TILEB + q * ROWB + hi * 16;
#pragma unroll
            for (int c = 0; c < 4; ++c) { const bf16x8 v0 = *(const LAS bf16x8*)(vb + c * 32), v1 = *(const LAS bf16x8*)(vb + 32 * ROWB + c * 32);
                st.o0 = __builtin_amdgcn_mfma_f32_32x32x16_bf16(pa[c], v0, st.o0, 0, 0, 0); st.o1 = __builtin_amdgcn_mfma_f32_32x32x16_bf16(pa[c], v1, st.o1, 0, 0, 0); }
        }
        if (t + 2 < nt) *(LAS u32x4*)(lds + OFF_K + buf * TILEB + sto) = kreg;
        if (MODE != 1 && t + 1 < nt) *(LAS u32x4*)(lds + OFF_V + (buf ^ 1) * TILEB + sto) = vreg;
        __syncthreads();
        }
        if (t + 1 < nt) { const int t_ = t; { const int t = t_ + 1; const int jt = t0 + t; constexpr int buf = 1;
        if (t + 2 < nt) kreg = *(const u32x4*)(kg + (size_t)(t + 2) * 64 * S.kstride);
        if (MODE != 1 && t + 1 < nt) vreg = *(const u32x4*)(vg + (size_t)(t + 1) * 64);
        const int kb0 = jt * 64;
        const bool bit = (selbits >> jt) & 1ull;
        const bool none = !bit || kb0 > khi || kb0 + 63 < klo;
        const bool allv = bit && kb0 >= klo && kb0 + 63 <= khi;
        const bool colv = !none;
        if (__any(colv && !allv)) {
            const int hr = khi - kb0 - 8 * hi, lrr = klo - kb0 - 8 * hi;
#pragma unroll
            for (int r = 0; r < 16; ++r) { const int c = 16 * (r >> 3) + (r & 7);
                if (!(c <= hr && c >= lrr)) q0[r] = -__builtin_inff();
                if (!(c + 32 <= hr && c + 32 >= lrr)) q1[r] = -__builtin_inff(); }
        }
        float tm = fmaxf(fmaxf(q0[0], q0[1]), q0[2]);
#pragma unroll
        for (int r = 3; r < 15; r += 2) tm = fmaxf(fmaxf(tm, q0[r]), q0[r + 1]);
        tm = fmaxf(tm, q0[15]);
#pragma unroll
        for (int r = 0; r < 16; r += 2) tm = fmaxf(fmaxf(tm, q1[r]), q1[r + 1]);
        tm = fmaxf(tm, __shfl_xor(tm, 32));
        if (!colv) tm = -__builtin_inff();
        float mref;
        if (MODE == 2) { mref = st.m; }
        else {
            if (__any(tm > st.m + 8.0f)) {
                const float mn = fmaxf(st.m, tm); const float alpha = __builtin_amdgcn_exp2f(st.m - mn); st.l *= alpha; st.m = mn;
                if (MODE == 0) { if (hi == 0) wsf[q] = alpha; LDS_FENCE();
#pragma unroll
                    for (int r = 0; r < 16; ++r) { const float f = wsf[crow(r, hi)]; st.o0[r] *= f; st.o1[r] *= f; }
                    LDS_FENCE(); }
            }
            mref = st.m;
        }
        const float msub = colv ? mref : __builtin_inff();
        p0 = (f32x16){}; p1 = (f32x16){};
        {   const LAS unsigned char* kb = kfb + (buf ^ 1) * TILEB;
#pragma unroll
            for (int d0 = 0; d0 < 4; ++d0) { const bf16x8 a0 = *(const LAS bf16x8*)(kb + d0 * 32), a1 = *(const LAS bf16x8*)(kb + 32 * ROWB + d0 * 32);
                p0 = __builtin_amdgcn_mfma_f32_32x32x16_bf16(a0, qf[d0], p0, 0, 0, 0); p1 = __builtin_amdgcn_mfma_f32_32x32x16_bf16(a1, qf[d0], p1, 0, 0, 0); } }
        float ls = 0.f;
#pragma unroll
        for (int r = 0; r < 16; ++r) { q0[r] = __builtin_amdgcn_exp2f(q0[r] - msub); q1[r] = __builtin_amdgcn_exp2f(q1[r] - msub); ls += q0[r] + q1[r]; }
        if (MODE != 2) st.l += ls;
        if (MODE == 2) {
#pragma unroll
            for (int r = 0; r < 16; ++r) { q0[r] *= inv_l; q1[r] *= inv_l; }
            float hs0[16], hs1[16];
#pragma unroll
            for (int r = 0; r < 16; ++r) { hs0[r] = quad_sum(q0[r]); hs1[r] = quad_sum(q1[r]); }
            if (g == 0) { LAS float* pr = pc + tokl * PCROW + kb0 + 8 * hi;
#pragma unroll
                for (int r = 0; r < 16; ++r) { pr[16 * (r >> 3) + (r & 7)] = hs0[r]; pr[16 * (r >> 3) + (r & 7) + 32] = hs1[r]; } }
        }
        if (MODE != 1) {
            bf16x8 pa[4];
            {   u32x4 w;
                w.x = cvt_pk_bf16(q0[0], q0[1]); w.y = cvt_pk_bf16(q0[2], q0[3]); w.z = cvt_pk_bf16(q0[4], q0[5]); w.w = cvt_pk_bf16(q0[6], q0[7]); pa[0] = __builtin_bit_cast(bf16x8, w);
                w.x = cvt_pk_bf16(q0[8], q0[9]); w.y = cvt_pk_bf16(q0[10], q0[11]); w.z = cvt_pk_bf16(q0[12], q0[13]); w.w = cvt_pk_bf16(q0[14], q0[15]); pa[1] = __builtin_bit_cast(bf16x8, w);
                w.x = cvt_pk_bf16(q1[0], q1[1]); w.y = cvt_pk_bf16(q1[2], q1[3]); w.z = cvt_pk_bf16(q1[4], q1[5]); w.w = cvt_pk_bf16(q1[6], q1[7]); pa[2] = __builtin_bit_cast(bf16x8, w);
                w.x = cvt_pk_bf16(q1[8], q1[9]); w.y = cvt_pk_bf16(q1[10], q1[11]); w.z = cvt_pk_bf16(q1[12], q1[13]); w.w = cvt_pk_bf16(q1[14], q1[15]); pa[3] = __builtin_bit_cast(bf16x8, w); }
            const LAS unsigned char* vb = lds + OFF_V + buf * TILEB + q * ROWB + hi * 16;
#pragma unroll
            for (int c = 0; c < 4; ++c) { const bf16x8 v0 = *(const LAS bf16x8*)(vb + c * 32), v1 = *(const LAS bf16x8*)(vb + 32 * ROWB + c * 32);
                st.o0 = __builtin_amdgcn_mfma_f32_32x32x16_bf16(pa[c], v0, st.o0, 0, 0, 0); st.o1 = __builtin_amdgcn_mfma_f32_32x32x16_bf16(pa[c], v1, st.o1, 0, 0, 0); }
        }
        if (t + 2 < nt) *(LAS u32x4*)(lds + OFF_K + buf * TILEB + sto) = kreg;
        if (MODE != 1 && t + 1 < nt) *(LAS u32x4*)(lds + OFF_V + (buf ^ 1) * TILEB + sto) = vreg;
        __syncthreads();
        } }
    }
}

struct Tensors { const bf16_t *qraw, *qrot, *ks, *kw, *vst, *vwt, *kcmp, *vcmpT; const float* gate; bf16_t* ob; };

template <bool FIRST>
__device__ __forceinline__ void fold(LAS float* wsf, LAS float* oacc, int q, int hi, float fac, const State& st) {
    if (hi == 0) wsf[q] = fac; LDS_FENCE();
#pragma unroll
    for (int r = 0; r < 16; ++r) { const int row = crow(r, hi); const float f = wsf[row]; LAS float* p = oacc + row * 64 + q;
        if (FIRST) { p[0] = st.o0[r] * f; p[32] = st.o1[r] * f; } else { p[0] += st.o0[r] * f; p[32] += st.o1[r] * f; } }
    LDS_FENCE();
}

__device__ __forceinline__ void job(LAS unsigned char* lds, const Tensors& X, int b, int kvh, int qb) {
    int tid_ = threadIdx.x; asm volatile("" : "+v"(tid_));
    const int tid = tid_, lane = tid & 63, q = lane & 31, hi = lane >> 5, wid = __builtin_amdgcn_readfirstlane(tid >> 6);
    const int tokl = 8 * wid + (q >> 2), g = q & 3, tq = 64 * qb + tokl, head = 4 * kvh + g;
    const size_t trow = (size_t)b * SEQ + tq;
    LAS float* wsf = (LAS float*)(lds + OFF_WSF) + wid * 64;
    LAS float* pc = (LAS float*)(lds + OFF_PC);
    LAS unsigned long long* selm = (LAS unsigned long long*)(lds + OFF_SELM);
    bf16x8 qf[4];
    {   const bf16_t* qp = X.qraw + trow * DM + head * 64 + 8 * hi;
#pragma unroll
        for (int d0 = 0; d0 < 4; ++d0) qf[d0] = *(const bf16x8*)(qp + 16 * d0); }
    const float g0 = X.gate[trow * 48 + head * 3 + 0], g1 = X.gate[trow * 48 + head * 3 + 1], g2 = X.gate[trow * 48 + head * 3 + 2];
    LAS float* oacc = pc + 8 * wid * PCROW;
    const size_t bk = (size_t)b * 4 + kvh;
    const Stream Ssel{X.ks + (size_t)b * SEQ * 256 + kvh * 64, 256, X.vst + bk * 64 * SEQ, SEQ};
    Pre prs;
    {   const Stream S{X.kcmp + bk * 256 * 64, 64, X.vcmpT + bk * 64 * 256, 256};
        const int nct = (qb >> 4) + 1; const int mmax = tq >= 31 ? ((tq - 31) >> 4) : -1;
        State st; st.m = -1e30f; st.l = 0.f; st.o0 = (f32x16){}; st.o1 = (f32x16){};
        const Pre prc = prefetch(tid, S, 0, nct, true);
        run_branch<1>(tid, lds, S, prc, 0, nct, qf, -(1 << 30), mmax, ~0ull, st, 0.f, tokl, g);
        float lt = st.l + __shfl_xor(st.l, 32); const float inv_l = lt > 0.f ? 1.0f / lt : 0.f;
        run_branch<2>(tid, lds, S, prc, 0, nct, qf, -(1 << 30), mmax, ~0ull, st, inv_l, tokl, g);
    prs = prefetch(tid, Ssel, 0, qb + 1, true);
    {
        if (qb < 16) { if (lane < 8) selm[8 * wid + lane] = (2ull << qb) - 1ull; }
        else
#pragma unroll 1
        for (int i = 0; i < 4; ++i) { const int j = lane; unsigned keyA, keyB;
            if (j == 0 || j == qb || j == qb - 1) { keyA = 0xffffffc0u; keyB = 0xffffffc0u; } else if (j > qb) { keyA = 0u; keyB = 0u; }
            else { const LAS float* pa_ = pc + (8 * wid + i) * PCROW + 4 * j; const LAS float* pb_ = pa_ + 4 * PCROW;
                const float sa = (((pa_[-1] + pa_[0]) + pa_[1]) + pa_[2]) + pa_[3], sb = (((pb_[-1] + pb_[0]) + pb_[1]) + pb_[2]) + pb_[3];
                keyA = (__float_as_uint(sa) & 0x7fffffc0u) + 64u; keyB = (__float_as_uint(sb) & 0x7fffffc0u) + 64u; }
            keyA |= (unsigned)(63 - j); keyB |= (unsigned)(63 - j);
            unsigned thrA = 0u, thrB = 0u;
#pragma unroll
            for (int bpos = 29; bpos >= 0; --bpos) { const unsigned cA = thrA | (1u << bpos), cB = thrB | (1u << bpos);
                const unsigned long long mA = __ballot(keyA >= cA), mB = __ballot(keyB >= cB); if (__popcll(mA) >= 16) thrA = cA; if (__popcll(mB) >= 16) thrB = cB; }
            const unsigned long long maskA = __ballot(keyA >= thrA), maskB = __ballot(keyB >= thrB);
            if (lane == 0) { selm[8 * wid + i] = maskA; selm[8 * wid + i + 4] = maskB; } }
        LDS_FENCE();
        fold<true>(wsf, oacc, q, hi, g0, st);
    }
    }
    const unsigned long long mysel = selm[tokl];
    qf[0] = *(const bf16x8*)(X.qrot + (trow * 16 + head) * 16 + 8 * hi);
    const Stream Swin{X.kw + (size_t)b * SEQ * 256 + kvh * 64, 256, X.vwt + bk * 64 * SEQ, SEQ};
    const int tw0 = qb >= 8 ? qb - 8 : 0;
    Pre prw;
    {   State st; st.m = -1e30f; st.l = 0.f; st.o0 = (f32x16){}; st.o1 = (f32x16){};
        run_branch<0>(tid, lds, Ssel, prs, 0, qb + 1, qf, -(1 << 30), tq, mysel, st, 0.f, tokl, g);
        prw = prefetch(tid, Swin, tw0, qb + 1 - tw0, true);
        const float lt = st.l + __shfl_xor(st.l, 32); fold<false>(wsf, oacc, q, hi, lt > 0.f ? g1 / lt : 0.f, st);
    }
    {   State st; st.m = -1e30f; st.l = 0.f; st.o0 = (f32x16){}; st.o1 = (f32x16){};
        run_branch<0>(tid, lds, Swin, prw, tw0, qb + 1 - tw0, qf, tq - 511, tq, ~0ull, st, 0.f, tokl, g);
        const float lt = st.l + __shfl_xor(st.l, 32); fold<false>(wsf, oacc, q, hi, lt > 0.f ? g2 / lt : 0.f, st);
    }
    {   const int qq = lane >> 1, ch = lane & 1; const LAS float* src = oacc + qq * 64 + ch * 32;
        bf16_t* op = X.ob + ((size_t)b * SEQ + 64 * qb + 8 * wid + (qq >> 2)) * DM + (4 * kvh + (qq & 3)) * 64 + ch * 32;
#pragma unroll
        for (int c = 0; c < 4; ++c) { const f32x4 x0 = *(const LAS f32x4*)(src + c * 8), x1 = *(const LAS f32x4*)(src + c * 8 + 4);
            *(u32x4*)(op + c * 8) = (u32x4){cvt_pk_bf16(x0[0], x0[1]), cvt_pk_bf16(x0[2], x0[3]), cvt_pk_bf16(x1[0], x1[1]), cvt_pk_bf16(x1[2], x1[3])}; }
        LDS_FENCE(); }
}
}


#define XB_TMO      128
#define XB_XCNT(j)  (256  + 64 * (j))
#define XB_XSUB(j)  (1280 + 64 * (j))
#define XB_XGEN(j)  (2304 + 64 * (j))
#define XB_TOP      3328
#define XB_TOPGEN   3392
#define XCD_BAR_WORDS 3456
#define XB_SPIN_CAP (1u << 20)
__device__ __forceinline__ unsigned xb_ld(unsigned* p)              { return __hip_atomic_load(p, __ATOMIC_RELAXED, __HIP_MEMORY_SCOPE_AGENT); }
__device__ __forceinline__ unsigned xb_add(unsigned* p, unsigned v) { return __hip_atomic_fetch_add(p, v, __ATOMIC_RELAXED, __HIP_MEMORY_SCOPE_AGENT); }
__device__ __forceinline__ unsigned xb_xcc_id() { return (unsigned)__builtin_amdgcn_s_getreg((3 << 11) | 20) & 0xFu; }
#define XB_SPIN(cond, bar) do { unsigned _sp = 0; while (cond) { __builtin_amdgcn_s_sleep(1); \
    if ((++_sp & 255u) == 0u) { if (xb_ld(&(bar)[XB_TMO])) break; if (_sp > XB_SPIN_CAP) { atomicAdd(&(bar)[XB_TMO], 1u); break; } } } } while (0)
struct XcdBarrier { unsigned* bar; unsigned x; volatile LAS unsigned* st; };
__device__ __forceinline__ XcdBarrier xcd_barrier_post(unsigned* bar, volatile LAS unsigned* st) {
    XcdBarrier b; b.bar = bar; b.x = xb_xcc_id(); b.st = st;
    if (threadIdx.x == 0) (void)xb_add(&bar[XB_XCNT(b.x)], 1u);
    return b;
}
__device__ __forceinline__ void xcd_barrier_complete(unsigned* bar, unsigned x, unsigned& nloc, unsigned& nx) {
    const unsigned G = gridDim.x * gridDim.y * gridDim.z;
    unsigned sum, cnt, mine, sp = 0u;
    for (;;) {
        sum = 0u; cnt = 0u; mine = 0u;
#pragma unroll
        for (unsigned j = 0; j < 16; ++j) { const unsigned c = xb_ld(&bar[XB_XCNT(j)]); sum += c; cnt += (c > 0u) ? 1u : 0u; mine = (j == x) ? c : mine; }
        if (sum == G) break;
        __builtin_amdgcn_s_sleep(1);
        if ((++sp & 255u) == 0u) { if (xb_ld(&bar[XB_TMO])) break; if (sp > XB_SPIN_CAP) { atomicAdd(&bar[XB_TMO], 1u); break; } }
    }
    nloc = mine > 0u ? mine : 1u; nx = cnt > 0u ? cnt : 1u;
}
__device__ __forceinline__ void xcd_barrier(const XcdBarrier& b) {
    asm volatile("s_waitcnt vmcnt(0)" ::: "memory");
    __syncthreads();
    if (threadIdx.x == 0) {
        unsigned* bar = b.bar;
        __builtin_amdgcn_s_waitcnt(0);
        unsigned nloc = b.st[0], nx = b.st[1];
        if (nloc == 0u) { xcd_barrier_complete(bar, b.x, nloc, nx); b.st[0] = nloc; b.st[1] = nx; }
        const unsigned old = xb_add(&bar[XB_XSUB(b.x)], 1u);
        const unsigned gen = old / nloc;
        if (old + 1u == (gen + 1u) * nloc) {
            __builtin_amdgcn_fence(__ATOMIC_RELEASE, "agent");
            asm volatile("s_waitcnt vmcnt(0)" ::: "memory");
            const unsigned og = xb_add(&bar[XB_TOP], 1u);
            const unsigned tg = og / nx;
            if (og + 1u == (tg + 1u) * nx) xb_add(&bar[XB_TOPGEN], 1u);
            else XB_SPIN(xb_ld(&bar[XB_TOPGEN]) == tg, bar);
            __builtin_amdgcn_fence(__ATOMIC_ACQUIRE, "agent");
            xb_add(&bar[XB_XGEN(b.x)], 1u);
            asm volatile("s_waitcnt vmcnt(0)" ::: "memory");
        } else {
            XB_SPIN(xb_ld(&bar[XB_XGEN(b.x)]) == gen, bar);
            __builtin_amdgcn_fence(__ATOMIC_ACQUIRE, "agent");
            asm volatile("s_waitcnt vmcnt(0)" ::: "memory");
        }
    }
    __syncthreads();
}

constexpr int LDS_BYTES = 147456;
typedef const __attribute__((address_space(4))) Args* KArgP;
#define KARGS() (*(const Args*)({ KArgP p_ = (KArgP)__builtin_amdgcn_kernarg_segment_ptr(); asm volatile("" : "+s"(p_)); p_; }))
__global__ void __launch_bounds__(512, 2) mk_fwd(Args a_unused) {
    extern __shared__ __attribute__((aligned(16))) unsigned char lds_raw[];
    Ctx C; C.lds = (LAS unsigned char*)lds_raw; C.tid = threadIdx.x; C.lane = C.tid & 63; C.wave = __builtin_amdgcn_readfirstlane(C.tid >> 6); C.G = gridDim.x; C.bid = blockIdx.x;
    const int lo = KARGS().ph_lo, hi = KARGS().ph_hi;
    volatile LAS unsigned* xst = (volatile LAS unsigned*)(C.lds + LDS_BYTES - 64);
    if (C.tid < 2) xst[C.tid] = 0u;
    __syncthreads();
    if (lo > NPHASE) cg::this_grid().sync();
    const XcdBarrier xbar = xcd_barrier_post((unsigned*)(KARGS().ws + WS_BAR), xst);
#ifdef ONLY_PHASE
#define IN(k) ((k) == ONLY_PHASE && lo <= (k) && (k) < hi)
#else
#define IN(k) (lo <= (k) && (k) < hi)
#endif
#define SEAM(k) do { if (IN(k) && IN((k) + 1)) { xcd_barrier(xbar); } } while (0)
    using namespace pg8;
    const int NT = T / 256;
#define PHASE_VARS const Args& a = KARGS(); unsigned char* ws = a.ws; float* ssA = (float*)(ws + WS_SSA); float* ssB = (float*)(ws + WS_SSB); bf16_t* hb = (bf16_t*)(ws + WS_HB); bf16_t* hid = (bf16_t*)(ws + WS_HID); float* ssC = (float*)(ws + WS_SSC); float* ssD = (float*)(ws + WS_SSD); (void)ssC; (void)ssD; \
    (void)ssA; (void)ssB; (void)hb; (void)hid;

    if (IN(0)) { PHASE_VARS p0_prologue(C, a);
#ifdef PROBE_P0X2
        __syncthreads(); p0_prologue(C, a);
#endif
    } SEAM(0);
    if (IN(1)) { PHASE_VARS
        Gemm g{(const char*)(ws + WS_XB), (const char*)(ws + WS_WFIN), DM, 128, DM, NT, 22, 0}; StaticOrder S; S.init(NT, 22, C.G, C.bid);
        EpiSwiGLU E{ssA, hid}; gemm_phase<EpiSwiGLU, StaticOrder>(C.lds, g, S, E);
#ifdef PROBE_G1X2
        gemm_phase<EpiSwiGLU, StaticOrder>(C.lds, g, S, E);
#endif
    } SEAM(1);
    if (IN(2)) { PHASE_VARS
        Gemm g{(const char*)hid, (const char*)(ws + WS_WFOUT), FF, 128, FF, NT, 4, 0}; StaticOrder S; S.init(NT, 4, C.G, C.bid);
        EpiResid E{(const bf16_t*)(ws + WS_XB), 0.5f, hb, ssB}; gemm_phase<EpiResid, StaticOrder>(C.lds, g, S, E);
    } SEAM(2);
    if (IN(3)) { PHASE_VARS
        Gemm g{(const char*)hb, (const char*)(ws + WS_WIN), DM, 128, DM, NT, 23, 0}; StaticOrder S; S.init(NT, 23, C.G, C.bid);
        EpiProj E{ssB, (const float*)(ws + WS_ROPE), (bf16_t*)(ws + WS_UB), (bf16_t*)(ws + WS_GV), (bf16_t*)(ws + WS_QRAW), (bf16_t*)(ws + WS_QROT), (bf16_t*)(ws + WS_KC), (bf16_t*)(ws + WS_VC),
                  (bf16_t*)(ws + WS_KS), (bf16_t*)(ws + WS_KW), (bf16_t*)(ws + WS_VST), (bf16_t*)(ws + WS_VWT), (bf16_t*)(ws + WS_GA), (float*)(ws + WS_VSTAT), (float*)(ws + WS_GATE)};
        gemm_phase<EpiProj, StaticOrder>(C.lds, g, S, E);
        if (C.G == 256 && C.bid >= 192) { __syncthreads(); LAS float* scr = (LAS float*)(C.lds + C.wave * TR_SCR);
            for (int it = (C.bid - 192) * 8 + C.wave; it < 1088; it += 512) small_weight_item(a, ws, scr, it, C.lane); }
#ifdef PROBE_G3X2
        gemm_phase<EpiProj, StaticOrder>(C.lds, g, S, E);
#endif
    } SEAM(3);
    if (IN(4)) { PHASE_VARS
#ifndef NO_CMP
        {   Gemm g{(const char*)(ws + WS_KC), (const char*)(ws + WS_WC1), 4096, 512, 2048, 32, 1, 1}; StaticOrder S; S.init(32, 1, C.G, C.bid);
            EpiCmp1 E{(bf16_t*)(ws + WS_CHID), (const float*)(ws + WS_CBIAS)}; gemm_phase<EpiCmp1, StaticOrder>(C.lds, g, S, E); }
#endif
        __syncthreads();
#ifndef NO_GMLP
        if (C.G == 256) { if (C.bid >= 32) for (int j = C.bid - 32; j < 1024; j += 224) gmlp_job(C, a, j); }
        else for (int j = C.bid; j < 1024; j += C.G) gmlp_job(C, a, j);
#endif
    } SEAM(4);
    if (IN(5)) { PHASE_VARS
        {   Gemm g{(const char*)(ws + WS_UB), (const char*)(ws + WS_WA), DM, 128, DM, NT, 4, 0}; StaticOrder S; S.init(NT, 4, C.G, C.bid);
            EpiBf16<2> E{(bf16_t*)(ws + WS_GV), nullptr, (const bf16_t*)(ws + WS_GA), nullptr}; gemm_phase<EpiBf16<2>, StaticOrder>(C.lds, g, S, E); }
#ifndef NO_CMP
        cmp2_phase(C, a);
#endif
    } SEAM(5);
    if (IN(6)) { PHASE_VARS
        att::Tensors X{(const bf16_t*)(ws + WS_QRAW), (const bf16_t*)(ws + WS_QROT), (const bf16_t*)(ws + WS_KS), (const bf16_t*)(ws + WS_KW), (const bf16_t*)(ws + WS_VST), (const bf16_t*)(ws + WS_VWT),
                       (const bf16_t*)(ws + WS_KCMP), (const bf16_t*)(ws + WS_VCMPT), (const float*)(ws + WS_GATE), (bf16_t*)(ws + WS_QRAW)};
#ifndef NO_ATTN
#ifdef PROBE_ATTN2
        { att::Tensors X0 = X; X0.ob = (bf16_t*)(ws + WS_UB);
        if (C.G == 256) { const int vcu = (C.bid & 7) * 32 + (C.bid >> 3); const int bkv = vcu >> 4, s = vcu & 15;
#pragma unroll 1
            for (int i = 0; i < 4; ++i) { const int qb = i == 0 ? 63 - s : i == 1 ? 32 + s : i == 2 ? 31 - s : s; att::job(C.lds, X0, bkv >> 2, bkv & 3, qb); }
        } else { for (int j = C.bid; j < 1024; j += C.G) { const int bkv = j & 15, qb = 63 - (j >> 4); att::job(C.lds, X0, bkv >> 2, bkv & 3, qb); } }
        __syncthreads(); }
#endif
        if (C.G == 256) { const int vcu = (C.bid & 7) * 32 + (C.bid >> 3); const int bkv = vcu >> 4, s = vcu & 15;
#pragma unroll 1
            for (int i = 0; i < 4; ++i) { const int qb = i == 0 ? 63 - s : i == 1 ? 32 + s : i == 2 ? 31 - s : s; att::job(C.lds, X, bkv >> 2, bkv & 3, qb); }
        } else { for (int j = C.bid; j < 1024; j += C.G) { const int bkv = j & 15, qb = 63 - (j >> 4); att::job(C.lds, X, bkv >> 2, bkv & 3, qb); } }
#endif
        __syncthreads();
#ifndef NO_GB
        {   Gemm g{(const char*)hb, (const char*)(ws + WS_WGB), DM, 128, DM, NT, 4, 0}; StaticOrder S; S.init(NT, 4, C.G, C.bid);
            EpiBf16<0> E{(bf16_t*)(ws + WS_UB), nullptr, nullptr, nullptr}; gemm_phase<EpiBf16<0>, StaticOrder>(C.lds, g, S, E); }
#endif
    } SEAM(6);
    if (IN(7)) { PHASE_VARS
        Gemm g{(const char*)(ws + WS_QRAW), (const char*)(ws + WS_WB), DM, 128, DM, NT, 4, 0}; StaticOrder S; S.init(NT, 4, C.G, C.bid);
        EpiBf16<4> E{(bf16_t*)(ws + WS_GV), ssB, (const bf16_t*)(ws + WS_UB), (const bf16_t*)(ws + WS_GV)}; gemm_phase<EpiBf16<4>, StaticOrder>(C.lds, g, S, E);
    } SEAM(7);
    if (IN(8)) { PHASE_VARS
        {   Gemm g{(const char*)(ws + WS_GV), (const char*)(ws + WS_WO), DM, 128, DM, NT, 4, 0}; StaticOrder S; S.init(NT, 4, C.G, C.bid);
            EpiResid E{hb, 1.0f, hb, ssC}; gemm_phase<EpiResid, StaticOrder>(C.lds, g, S, E); }
        __syncthreads();
        p8_extras(C, a);
    } SEAM(8);
    if (IN(9)) { PHASE_VARS
        {   Gemm g{(const char*)hb, (const char*)(ws + WS_WFIN), DM, 128, DM, NT, 22, 0}; StaticOrder S; S.init(NT, 22, C.G, C.bid);
            EpiSwiGLU E{ssC, hid}; gemm_phase<EpiSwiGLU, StaticOrder>(C.lds, g, S, E); }
        int opq = 0; asm volatile("" : "+s"(opq));
        if (opq == 0) {   int kple = PLE; asm volatile("" : "+s"(kple));
            Gemm g{(const char*)(ws + WS_PB), (const char*)(ws + WS_WPP), PLE, 128, kple, NT, 4, 0}; StaticOrder S;
            if (C.G == 256) S.init(NT, 4, 128, C.bid >= 128 ? C.bid - 128 : -1); else S.init(NT, 4, C.G, C.bid);
            EpiBf16<0> E{(bf16_t*)(ws + WS_PP), nullptr, nullptr, nullptr}; gemm_phase<EpiBf16<0>, StaticOrder>(C.lds, g, S, E); }
    } SEAM(9);
    if (IN(10)) { PHASE_VARS
        Gemm g{(const char*)hid, (const char*)(ws + WS_WFOUT), FF, 128, FF, NT, 4, 0}; StaticOrder S; S.init(NT, 4, C.G, C.bid);
        EpiResid E{hb, 0.5f, hb, ssD}; gemm_phase<EpiResid, StaticOrder>(C.lds, g, S, E);
    } SEAM(10);
    if (IN(11)) { PHASE_VARS
        Gemm g{(const char*)hb, (const char*)(ws + WS_WPG), DM, 128, DM, NT, 4, 0}; StaticOrder S; S.init(NT, 4, C.G, C.bid);
        if (C.G == 256) { EpiPleFinal E{ssD, (const bf16_t*)(ws + WS_PP), hb, a.out, a.in[I_FIN], (unsigned*)(ws + WS_BAR + 32768), (unsigned*)(ws + WS_BAR + 16384)};
            gemm_phase<EpiPleFinal, StaticOrder>(C.lds, g, S, E); }
        else { EpiPle E{ssD, (const bf16_t*)(ws + WS_PP), hb, a.out, ssA}; gemm_phase<EpiPle, StaticOrder>(C.lds, g, S, E); }
    }
    if (C.G != 256) { SEAM(11); if (IN(12)) { PHASE_VARS final_phase(C, a); } }
#undef IN
#undef SEAM
}

extern "C" void kernel_launch(void* const* d_in, const int* in_sizes, int n_in, void* d_out, int out_size, void* d_ws, size_t ws_size, hipStream_t stream) {
    static int grid = 0;
    if (grid == 0) {
        if (n_in != 27 || out_size != T * DM || ws_size < WS_END) { fprintf(stderr, "kernel_launch: unexpected problem (n_in %d, out %d, ws %zu)\n", n_in, out_size, ws_size); grid = -1; return; }
        int dev = 0, cus = 0, per_cu = 0;
        hipGetDevice(&dev); hipDeviceGetAttribute(&cus, hipDeviceAttributeMultiprocessorCount, dev);
        hipFuncSetAttribute((const void*)mk_fwd, hipFuncAttributeMaxDynamicSharedMemorySize, LDS_BYTES);
        hipOccupancyMaxActiveBlocksPerMultiprocessor(&per_cu, (const void*)mk_fwd, 512, LDS_BYTES);
        if (per_cu < 1) { fprintf(stderr, "kernel_launch: occupancy query says %d blocks per CU\n", per_cu); per_cu = 1; }
        (void)hipGetLastError();
        grid = cus * 1;
    }
    if (grid < 0) return;
    Args a{};
    for (int i = 0; i < 27; ++i) a.in[i] = (const float*)d_in[i];
    a.out = (float*)d_out; a.ws = (unsigned char*)d_ws;
#if MK_SINGLE
    hipMemsetAsync((char*)d_ws + WS_BAR, 0, 32768, stream);
    a.ph_lo = 0; a.ph_hi = NPHASE;
    void* args[] = {&a};
    hipError_t e = hipLaunchCooperativeKernel((const void*)mk_fwd, dim3(grid), dim3(512), args, LDS_BYTES, stream);
    if (e != hipSuccess) fprintf(stderr, "cooperative launch failed: %s (grid %d)\n", hipGetErrorString(e), grid);
#else
    for (int k = 0; k < NPHASE; ++k) { a.ph_lo = k; a.ph_hi = k + 1; hipLaunchKernelGGL(mk_fwd, dim3(grid), dim3(512), LDS_BYTES, stream, a); }
#endif
}
```

```cpp
#include <hip/hip_runtime.h>
#include <hip/hip_cooperative_groups.h>
#include <cstdint>
#include <cstdio>
namespace cg = cooperative_groups;

#ifndef MK_SINGLE
#define MK_SINGLE 1
#endif

#define LAS __attribute__((address_space(3)))
typedef unsigned short bf16_t;
typedef short bf16x8 __attribute__((ext_vector_type(8)));
typedef float f32x4 __attribute__((ext_vector_type(4)));
typedef float f32x2 __attribute__((ext_vector_type(2)));
typedef float f32x16 __attribute__((ext_vector_type(16)));
typedef unsigned u32x4 __attribute__((ext_vector_type(4)));
typedef unsigned u32x2 __attribute__((ext_vector_type(2)));

constexpr int T = 16384, SEQ = 4096, DM = 1024, FF = 2816, PLE = 256;
constexpr int N3 = 5888;
constexpr float EPS = 1e-6f;
constexpr float LOG2E = 1.4426950408889634f;
constexpr float QSCALE = 0.125f * LOG2E;
constexpr int NPHASE = 13;

constexpr size_t MiB = 1u << 20;
constexpr size_t WS_SSA = 0, WS_SSB = 1 * MiB, WS_VSTAT = 2 * MiB, WS_ROPE = 4 * MiB, WS_GMW = 4 * MiB + 256 * 1024,
                 WS_KCMP = 4 * MiB + 512 * 1024, WS_VCMPT = 5 * MiB, WS_CBIAS = 5 * MiB + 512 * 1024, WS_GATE = 6 * MiB, WS_SSC = 9 * MiB, WS_SSD = 10 * MiB;
constexpr size_t WS_WIN = 11 * MiB;
constexpr size_t WS_WGB = WS_WIN + (size_t)N3 * 1024 * 2;
constexpr size_t WS_WA = WS_WGB + 2 * MiB, WS_WB = WS_WA + 2 * MiB, WS_WO = WS_WB + 2 * MiB, WS_WPG = WS_WO + 2 * MiB, WS_WPP = WS_WPG + 2 * MiB,
                 WS_WC1 = 33 * MiB;
constexpr size_t WS_WFIN = 35 * MiB, WS_WFOUT = 46 * MiB;
constexpr size_t WS_KC = 35 * MiB, WS_VC = 43 * MiB;
constexpr size_t WS_HID = 52 * MiB;
constexpr size_t WS_QRAW = 52 * MiB, WS_QROT = 84 * MiB, WS_KS = 92 * MiB, WS_KW = 100 * MiB, WS_VST = 108 * MiB, WS_VWT = 116 * MiB,
                 WS_GA = 124 * MiB, WS_UB = 156 * MiB, WS_HB = 188 * MiB, WS_GV = 220 * MiB, WS_CHID = 252 * MiB;
constexpr size_t WS_XB = 140 * MiB, WS_PB = 140 * MiB, WS_PP = 148 * MiB;
constexpr size_t WS_BAR = 51 * MiB + 512 * 1024;
constexpr size_t WS_END = 256 * MiB;
static_assert(WS_WPP + 512 * 1024 <= WS_WC1 && WS_WC1 + 2 * MiB <= WS_WFIN, "weight map");

typedef __bf16 bf16x2_t __attribute__((ext_vector_type(2)));
__device__ __forceinline__ unsigned cvt_pk_bf16(float lo, float hi) { f32x2 v = {lo, hi}; bf16x2_t b = __builtin_convertvector(v, bf16x2_t); return __builtin_bit_cast(unsigned, b); }
__device__ __forceinline__ float bf2f(unsigned short b) { return __uint_as_float((unsigned)b << 16); }
__device__ __forceinline__ float bflo(unsigned w) { return __uint_as_float(w << 16); }
__device__ __forceinline__ float bfhi(unsigned w) { return __uint_as_float(w & 0xffff0000u); }
__device__ __forceinline__ float fsigmoid(float x) { return __builtin_amdgcn_rcpf(1.0f + __builtin_amdgcn_exp2f(-x * LOG2E)); }
__device__ __forceinline__ float fsilu(float x) { return x * fsigmoid(x); }
__device__ __forceinline__ float fgelu(float x) { return x * fsigmoid(1.5957691216057308f * (x + 0.044715f * x * x * x)); }
__device__ __forceinline__ void sigmoid8(float (&v)[8]) {
#pragma unroll
    for (int i = 0; i < 8; i += 2) { f32x2 x = {v[i], v[i + 1]}; const f32x2 z = x * (-LOG2E); f32x2 e = {__builtin_amdgcn_exp2f(z.x), __builtin_amdgcn_exp2f(z.y)}; const f32x2 d = e + 1.0f;
        v[i] = __builtin_amdgcn_rcpf(d.x); v[i + 1] = __builtin_amdgcn_rcpf(d.y); }
}
__device__ __forceinline__ void silu8(float (&v)[8]) {
#pragma unroll
    for (int i = 0; i < 8; i += 2) { f32x2 x = {v[i], v[i + 1]}; const f32x2 z = x * (-LOG2E); f32x2 e = {__builtin_amdgcn_exp2f(z.x), __builtin_amdgcn_exp2f(z.y)}; const f32x2 d = e + 1.0f;
        const f32x2 r = {__builtin_amdgcn_rcpf(d.x), __builtin_amdgcn_rcpf(d.y)}; x = x * r; v[i] = x.x; v[i + 1] = x.y; }
}
__device__ __forceinline__ void gelu8(float (&v)[8]) {
    constexpr float c0 = -1.5957691216057308f * LOG2E, c1 = c0 * 0.044715f;
#pragma unroll
    for (int i = 0; i < 8; i += 2) { f32x2 x = {v[i], v[i + 1]}; const f32x2 w = (x * x) * c1 + c0; const f32x2 z = x * w; f32x2 e = {__builtin_amdgcn_exp2f(z.x), __builtin_amdgcn_exp2f(z.y)}; const f32x2 d = e + 1.0f;
        const f32x2 r = {__builtin_amdgcn_rcpf(d.x), __builtin_amdgcn_rcpf(d.y)}; x = x * r; v[i] = x.x; v[i + 1] = x.y; }
}
__device__ __forceinline__ u32x4 pack8(const float (&v)[8]) { u32x4 w; w.x = cvt_pk_bf16(v[0], v[1]); w.y = cvt_pk_bf16(v[2], v[3]); w.z = cvt_pk_bf16(v[4], v[5]); w.w = cvt_pk_bf16(v[6], v[7]); return w; }
__device__ __forceinline__ void unpack8(const u32x4 w, float (&v)[8]) { v[0] = bflo(w.x); v[1] = bfhi(w.x); v[2] = bflo(w.y); v[3] = bfhi(w.y); v[4] = bflo(w.z); v[5] = bfhi(w.z); v[6] = bflo(w.w); v[7] = bfhi(w.w); }
#define LDS_FENCE() asm volatile("s_waitcnt lgkmcnt(0)" ::: "memory")
__device__ __forceinline__ float quad_sum(float v) {
    v += __int_as_float(__builtin_amdgcn_update_dpp(0, __float_as_int(v), 0xB1, 0xF, 0xF, true));
    v += __int_as_float(__builtin_amdgcn_update_dpp(0, __float_as_int(v), 0x4E, 0xF, 0xF, true));
    return v;
}

namespace pg8 {
constexpr int BM = 256, BK = 64, HALF = 128, HTB = HALF * BK * 2, STAGE_BYTES = 8 * HTB, NXCD = 8, WGM = 4;
__host__ __device__ __forceinline__ int lds_byte(int r, int c) { const int st = (r >> 4) * 2 + (c >> 5), rr = r & 15, cc = c & 31, ob = rr * 64 + cc * 2; return st * 1024 + (ob ^ (((ob >> 9) & 1) << 5)); }
__host__ __device__ __forceinline__ void stage_rc(int b, int& R, int& C) { const int st = b / 1024, sb = b % 1024, swz = sb ^ (((sb >> 9) & 1) << 5); R = (st >> 1) * 16 + swz / 64; C = (st & 1) * 32 + (swz % 64) / 2; }
__host__ __device__ __forceinline__ int perm32(int rho) { const int n = rho >> 4, i = rho & 15; return 8 * (i >> 2) + 4 * n + (i & 3); }

struct Unit { int pm, pn; };
struct Gemm { const char* A; const char* Bt; int lda; int kstepA; int K; int nM, nN; int mode; };
__device__ __forceinline__ const char* abase(const Gemm& g, const Unit& u) {
    if (g.mode == 1) { const int pm = u.pm; return g.A + ((size_t)(pm >> 4) * ((size_t)T * 256) + (size_t)((pm & 15) >> 2) * 64 + (size_t)(pm & 3) * 256 * 4096) * 2; }
    return g.A + (size_t)u.pm * ((size_t)BM * g.lda * 2);
}
__device__ __forceinline__ const char* bbase(const Gemm& g, const Unit& u) {
    if (g.mode == 1) return g.Bt + (size_t)(u.pm >> 4) * ((size_t)256 * 2048 * 2);
    return g.Bt + (size_t)u.pn * ((size_t)BM * g.K * 2);
}

struct StaticOrder {
    int nM, nN, nwg, G, c;
    __device__ void init(int nM_, int nN_, int G_, int c_) { nM = nM_; nN = nN_; nwg = nM * nN; G = G_; c = c_; }
    __device__ bool next(int i, Unit& u) const {
        if (c < 0) return false;
        const long L = (long)i * G + c; if (L >= nwg) return false;
        int wgid = (int)L; { const int q = nwg / NXCD, r = nwg % NXCD, xcd = wgid % NXCD, off = wgid / NXCD; wgid = (xcd < r ? xcd * (q + 1) : r * (q + 1) + (xcd - r) * q) + off; }
        const int nig = WGM * nN, gid = wgid / nig, fm = gid * WGM, gsz = (nM - fm) < WGM ? (nM - fm) : WGM;
        u.pm = fm + ((wgid % nig) % gsz); u.pn = (wgid % nig) / gsz; return true;
    }
};

template <class Epi, class Sched, bool ALIGN_EPI = true, bool SP2 = true>
__device__ __forceinline__ void gemm_phase(LAS unsigned char* lds, const Gemm g, const Sched& S, const Epi& E) {
    const int tid = threadIdx.x, wid = __builtin_amdgcn_readfirstlane(tid >> 6), lane = tid & 63, wr = wid >> 2, wc = wid & 3, fr = lane & 15, fq = lane >> 4;
    const int K = g.K, nt = K / BK;
    unsigned voffA[2], voffB[2];
#pragma unroll
    for (int i = 0; i < 2; ++i) { int R, C; stage_rc(tid * 16 + i * 8192, R, C); const int Rb = Epi::PERM ? ((R & ~31) + perm32(R & 31)) : R;
        voffA[i] = (unsigned)(R * g.lda + C) * 2u; voffB[i] = (unsigned)(Rb * K + C) * 2u; }
    const size_t kstepA = (size_t)g.kstepA, kstepB = (size_t)(BK * 2);
    const size_t hstepA = (size_t)HALF * g.lda * 2, hstepB = (size_t)HALF * K * 2;
    const unsigned ldsw = (unsigned)wid * 1024u;
    const int aoff = lds_byte(wr * 64 + fr, fq * 8), boff = lds_byte(wc * 32 + fr, fq * 8);
#define PG8_SA(b, h) (((b) * 2 + (h)) * HTB)
#define PG8_SB(b, h) ((4 + (b) * 2 + (h)) * HTB)
#define PG8_STAGE(bufoff, gbase, voff) do { _Pragma("unroll") for (int _i = 0; _i < 2; ++_i) \
        __builtin_amdgcn_global_load_lds((const unsigned*)((const char*)(gbase) + (voff)[_i]), (LAS unsigned*)(lds + (bufoff) + ldsw + _i * 8192), 16, 0, 0); } while (0)
#define PG8_LDA(dst, b, h) do { _Pragma("unroll") for (int m = 0; m < 4; ++m) _Pragma("unroll") for (int k = 0; k < 2; ++k) dst[m][k] = *(const LAS bf16x8*)(lds + PG8_SA(b, h) + aoff + m * 2048 + k * 1024); } while (0)
#define PG8_LDB(dst, b, h) do { _Pragma("unroll") for (int n = 0; n < 2; ++n) _Pragma("unroll") for (int k = 0; k < 2; ++k) dst[n][k] = *(const LAS bf16x8*)(lds + PG8_SB(b, h) + boff + n * 2048 + k * 1024); } while (0)
#define PG8_MMA(ai, bj, At, Bt) do { __builtin_amdgcn_s_setprio(1); _Pragma("unroll") for (int m = 0; m < 4; ++m) _Pragma("unroll") for (int n = 0; n < 2; ++n) _Pragma("unroll") for (int k = 0; k < 2; ++k) \
        acc[ai][bj][m][n] = __builtin_amdgcn_mfma_f32_16x16x32_bf16(Bt[n][k], At[m][k], acc[ai][bj][m][n], 0, 0, 0); __builtin_amdgcn_s_setprio(0); } while (0)
#define PG8_WAIT_V(n) asm volatile("s_waitcnt vmcnt(" #n ")" ::: "memory")
#define PG8_WAIT_L(n) asm volatile("s_waitcnt lgkmcnt(" #n ")" ::: "memory")
#define PG8_BAR __builtin_amdgcn_s_barrier()
#define PG8_SCHED __builtin_amdgcn_sched_barrier(0)
    Unit cur, nxt; int ui = 0;
    if (!S.next(0, cur)) return;
    f32x4 acc[2][2][4][2];
#pragma unroll
    for (int a = 0; a < 2; ++a)
#pragma unroll
        for (int b = 0; b < 2; ++b)
#pragma unroll
            for (int m = 0; m < 4; ++m)
#pragma unroll
                for (int n = 0; n < 2; ++n) acc[a][b][m][n] = (f32x4){0.f, 0.f, 0.f, 0.f};
    bf16x8 At[4][2], B0[2][2], B1[2][2];
    const char* cA = abase(g, cur); const char* cB = bbase(g, cur);
    if constexpr (SP2) {
        PG8_STAGE(PG8_SB(0, 0), cB, voffB); PG8_STAGE(PG8_SB(0, 1), cB + hstepB, voffB); PG8_STAGE(PG8_SA(0, 0), cA, voffA); PG8_STAGE(PG8_SA(0, 1), cA + hstepA, voffA);
        if (wr == 1) PG8_BAR;
        PG8_WAIT_V(2); PG8_BAR;
        PG8_STAGE(PG8_SB(1, 0), cB + kstepB, voffB); PG8_STAGE(PG8_SA(1, 0), cA + kstepA, voffA); PG8_STAGE(PG8_SB(1, 1), cB + hstepB + kstepB, voffB);
        PG8_WAIT_V(6); PG8_BAR;
    } else {
        PG8_STAGE(PG8_SB(0, 0), cB, voffB); PG8_STAGE(PG8_SA(0, 0), cA, voffA); PG8_STAGE(PG8_SB(0, 1), cB + hstepB, voffB); PG8_STAGE(PG8_SA(0, 1), cA + hstepA, voffA);
        if (wr == 1) PG8_BAR;
        PG8_WAIT_V(4); PG8_BAR;
        PG8_STAGE(PG8_SB(1, 0), cB + kstepB, voffB); PG8_STAGE(PG8_SA(1, 0), cA + kstepA, voffA); PG8_STAGE(PG8_SB(1, 1), cB + hstepB + kstepB, voffB);
        PG8_WAIT_V(6); PG8_BAR;
    }
    for (;;) {
        const bool has_next = S.next(ui + 1, nxt);
        const char* nA = has_next ? abase(g, nxt) : cA + (size_t)(nt - 2) * kstepA; const char* nB = has_next ? bbase(g, nxt) : cB + (size_t)(nt - 2) * kstepB;
        for (int t = 0; t < nt; t += 2) {
            const bool last = (t == nt - 2);
            const char* a1 = cA + (size_t)(t + 1) * kstepA;
            const char* a2 = last ? nA : cA + (size_t)(t + 2) * kstepA; const char* b2 = last ? nB : cB + (size_t)(t + 2) * kstepB;
            const char* a3 = a2 + kstepA; const char* b3 = b2 + kstepB;
            if constexpr (SP2) {
            PG8_LDB(B0, 0, 0); PG8_LDB(B1, 0, 1); PG8_SCHED; PG8_LDA(At, 0, 0); PG8_STAGE(PG8_SA(1, 1), a1 + hstepA, voffA);
            PG8_WAIT_V(8); PG8_WAIT_L(0); PG8_BAR; PG8_MMA(0, 0, At, B0); PG8_MMA(0, 1, At, B1); PG8_BAR; PG8_SCHED;
            PG8_LDA(At, 0, 1); PG8_STAGE(PG8_SB(0, 0), b2, voffB); PG8_STAGE(PG8_SB(0, 1), b2 + hstepB, voffB); PG8_STAGE(PG8_SA(0, 0), a2, voffA);
            PG8_WAIT_V(8); PG8_WAIT_L(0); PG8_BAR; PG8_MMA(1, 0, At, B0); PG8_MMA(1, 1, At, B1); PG8_BAR; PG8_SCHED;
            PG8_LDB(B0, 1, 0); PG8_LDB(B1, 1, 1); PG8_SCHED; PG8_LDA(At, 1, 0); PG8_STAGE(PG8_SA(0, 1), a2 + hstepA, voffA);
            PG8_WAIT_V(8); PG8_WAIT_L(0); PG8_BAR; PG8_MMA(0, 0, At, B0); PG8_MMA(0, 1, At, B1); PG8_BAR; PG8_SCHED;
            PG8_LDA(At, 1, 1); PG8_STAGE(PG8_SB(1, 0), b3, voffB); PG8_STAGE(PG8_SB(1, 1), b3 + hstepB, voffB); PG8_STAGE(PG8_SA(1, 0), a3, voffA);
            PG8_WAIT_V(8); PG8_WAIT_L(0); PG8_BAR; PG8_MMA(1, 0, At, B0); PG8_MMA(1, 1, At, B1); PG8_BAR; PG8_SCHED;
            } else {
            PG8_LDB(B0, 0, 0); PG8_SCHED; PG8_LDA(At, 0, 0); PG8_STAGE(PG8_SA(1, 1), a1 + hstepA, voffA);
            PG8_WAIT_L(8); PG8_BAR; PG8_WAIT_L(0); PG8_MMA(0, 0, At, B0); PG8_BAR; PG8_SCHED;
            PG8_LDB(B1, 0, 1); PG8_STAGE(PG8_SB(0, 0), b2, voffB);
            PG8_BAR; PG8_WAIT_L(0); PG8_MMA(0, 1, At, B1); PG8_BAR;
            PG8_LDA(At, 0, 1); PG8_STAGE(PG8_SA(0, 0), a2, voffA);
            PG8_BAR; PG8_WAIT_L(0); PG8_MMA(1, 0, At, B0); PG8_BAR; PG8_SCHED;
            PG8_STAGE(PG8_SB(0, 1), b2 + hstepB, voffB);
            PG8_WAIT_V(6); PG8_BAR; PG8_MMA(1, 1, At, B1); PG8_BAR;
            PG8_LDB(B0, 1, 0); PG8_SCHED; PG8_LDA(At, 1, 0); PG8_STAGE(PG8_SA(0, 1), a2 + hstepA, voffA);
            PG8_WAIT_L(8); PG8_BAR; PG8_WAIT_L(0); PG8_MMA(0, 0, At, B0); PG8_BAR; PG8_SCHED;
            PG8_LDB(B1, 1, 1); PG8_STAGE(PG8_SB(1, 0), b3, voffB);
            PG8_BAR; PG8_WAIT_L(0); PG8_MMA(0, 1, At, B1); PG8_BAR;
            PG8_LDA(At, 1, 1); PG8_STAGE(PG8_SA(1, 0), a3, voffA);
            PG8_BAR; PG8_WAIT_L(0); PG8_MMA(1, 0, At, B0); PG8_BAR; PG8_SCHED;
            PG8_STAGE(PG8_SB(1, 1), b3 + hstepB, voffB);
            PG8_WAIT_V(6); PG8_BAR; PG8_MMA(1, 1, At, B1); PG8_BAR;
            }
        }
        if constexpr (ALIGN_EPI) { if (wr == 0) PG8_BAR; }
        if constexpr (!Epi::AFTER_DRAIN) E(acc, cur, wr, wc, fr, fq);
        if (!has_next) break;
#pragma unroll
        for (int a = 0; a < 2; ++a)
#pragma unroll
            for (int b = 0; b < 2; ++b)
#pragma unroll
                for (int m = 0; m < 4; ++m)
#pragma unroll
                    for (int n = 0; n < 2; ++n) acc[a][b][m][n] = (f32x4){0.f, 0.f, 0.f, 0.f};
        cur = nxt; cA = nA; cB = nB; ++ui;
        if constexpr (ALIGN_EPI) { if (wr == 1) PG8_BAR; }
    }
    PG8_WAIT_V(0);
    if constexpr (!ALIGN_EPI) { if (wr == 0) PG8_BAR; }
    PG8_BAR;
    if constexpr (Epi::AFTER_DRAIN) E.fused(acc, cur, wr, wc, fr, fq, lds, wid, lane);
#undef PG8_SA
#undef PG8_SB
#undef PG8_STAGE
#undef PG8_LDA
#undef PG8_LDB
#undef PG8_MMA
#undef PG8_WAIT_V
#undef PG8_WAIT_L
#undef PG8_BAR
#undef PG8_SCHED
}

typedef f32x4 Acc[2][2][4][2];
__device__ __forceinline__ void load_rs(const float* ssp, int row0, int fq, float (&rs)[2][4]) {
#pragma unroll
    for (int ai = 0; ai < 2; ++ai)
#pragma unroll
        for (int m = 0; m < 4; ++m) { const f32x4* pp = (const f32x4*)(ssp + (size_t)(row0 + 128 * ai + 16 * m) * 16); const f32x4 p0 = pp[0], p1 = pp[1], p2 = pp[2], p3 = pp[3];
            const float s = (((p0.x + p0.y) + (p0.z + p0.w)) + ((p1.x + p1.y) + (p1.z + p1.w))) + (((p2.x + p2.y) + (p2.z + p2.w)) + ((p3.x + p3.y) + (p3.z + p3.w)));
            rs[ai][m] = rsqrtf(s * (1.0f / 1024.0f) + EPS); asm volatile("" : "+v"(rs[ai][m]) :: "memory"); }
}
#define ACC8(v, ai, bj, m, sc) do { const f32x4 a0_ = acc[ai][bj][m][0], a1_ = acc[ai][bj][m][1]; v[0] = a0_[0] * (sc); v[1] = a0_[1] * (sc); v[2] = a0_[2] * (sc); v[3] = a0_[3] * (sc); \
        v[4] = a1_[0] * (sc); v[5] = a1_[1] * (sc); v[6] = a1_[2] * (sc); v[7] = a1_[3] * (sc); } while (0)

struct EpiSwiGLU { static constexpr bool PERM = true, AFTER_DRAIN = false; const float* ssp; bf16_t* hid;
    __device__ __forceinline__ void operator()(const Acc& acc, const Unit& u, int wr, int wc, int fr, int fq) const {
        const int row0 = u.pm * 256 + wr * 64 + fr; float rs[2][4]; load_rs(ssp, row0, fq, rs);
#pragma unroll
        for (int ai = 0; ai < 2; ++ai)
#pragma unroll
            for (int m = 0; m < 4; ++m) { float gt[8], up[8], o[8]; ACC8(gt, ai, 0, m, rs[ai][m]); ACC8(up, ai, 1, m, rs[ai][m]);
#pragma unroll
                for (int j = 0; j < 8; ++j) o[j] = gt[j];
                silu8(o);
#pragma unroll
                for (int j = 0; j < 8; ++j) o[j] *= up[j];
                *(u32x4*)(hid + (size_t)(row0 + 128 * ai + 16 * m) * FF + u.pn * 128 + wc * 32 + fq * 8) = pack8(o); }
    }
};
struct EpiResid { static constexpr bool PERM = true, AFTER_DRAIN = false; const bf16_t* baseb; float coef; bf16_t* hb; float* ssp;
    __device__ __forceinline__ void operator()(const Acc& acc, const Unit& u, int wr, int wc, int fr, int fq) const {
        const int row0 = u.pm * 256 + wr * 64 + fr;
#pragma unroll
        for (int ai = 0; ai < 2; ++ai)
#pragma unroll
            for (int m = 0; m < 4; ++m) { const int row = row0 + 128 * ai + 16 * m; float ss = 0.f;
#pragma unroll
                for (int bj = 0; bj < 2; ++bj) { const size_t off = (size_t)row * DM + u.pn * 256 + bj * 128 + wc * 32 + fq * 8; float v[8], bb[8]; ACC8(v, ai, bj, m, coef);
                    unpack8(*(const u32x4*)(baseb + off), bb);
#pragma unroll
                    for (int j = 0; j < 8; ++j) { v[j] += bb[j]; ss += v[j] * v[j]; }
                    *(u32x4*)(hb + off) = pack8(v); }
                ss += __shfl_xor(ss, 16); ss += __shfl_xor(ss, 32);
                if (fq == 0) ssp[(size_t)row * 16 + u.pn * 4 + wc] = ss; }
    }
};
struct EpiPle { static constexpr bool PERM = true, AFTER_DRAIN = false; const float* ssp_in; const bf16_t* pp; const bf16_t* hb; float* out; float* ssp;
    __device__ __forceinline__ void operator()(const Acc& acc, const Unit& u, int wr, int wc, int fr, int fq) const {
        const int row0 = u.pm * 256 + wr * 64 + fr; float rs[2][4]; load_rs(ssp_in, row0, fq, rs);
#pragma unroll
        for (int ai = 0; ai < 2; ++ai)
#pragma unroll
            for (int m = 0; m < 4; ++m) { const int row = row0 + 128 * ai + 16 * m; float ss = 0.f;
#pragma unroll
                for (int bj = 0; bj < 2; ++bj) { const size_t off = (size_t)row * DM + u.pn * 256 + bj * 128 + wc * 32 + fq * 8; float v[8], pv[8], bb[8]; ACC8(v, ai, bj, m, rs[ai][m]);
                    unpack8(*(const u32x4*)(pp + off), pv); unpack8(*(const u32x4*)(hb + off), bb);
#pragma unroll
                    for (int j = 0; j < 8; ++j) { v[j] = bb[j] + fsigmoid(v[j]) * pv[j]; ss += v[j] * v[j]; }
                    *(f32x4*)(out + off) = (f32x4){v[0], v[1], v[2], v[3]}; *(f32x4*)(out + off + 4) = (f32x4){v[4], v[5], v[6], v[7]}; }
                ss += __shfl_xor(ss, 16); ss += __shfl_xor(ss, 32);
                if (fq == 0) ssp[(size_t)row * 16 + u.pn * 4 + wc] = ss; }
    }
};
struct EpiPleFinal { static constexpr bool PERM = true, AFTER_DRAIN = true; const float* ssp_in; const bf16_t* pp; const bf16_t* hb; float* out; const float* fnorm; unsigned* xbuf; unsigned* cnt;
    __device__ __forceinline__ void operator()(const Acc&, const Unit&, int, int, int, int) const {}
    __device__ __forceinline__ void fused(Acc& acc, const Unit& u, int wr, int wc, int fr, int fq, LAS unsigned char* lds, int wid, int lane) const {
        const int row0 = u.pm * 256 + wr * 64 + fr; float rs[2][4]; load_rs(ssp_in, row0, fq, rs);
        LAS float* P = (LAS float*)lds;
        LAS float* Sr = (LAS float*)(lds + 4096);
        LAS unsigned* flag = (LAS unsigned*)(lds + 4096 + 1024);
#pragma unroll
        for (int ai = 0; ai < 2; ++ai)
#pragma unroll
            for (int m = 0; m < 4; ++m) { const int row = row0 + 128 * ai + 16 * m; float ss = 0.f;
#pragma unroll
                for (int bj = 0; bj < 2; ++bj) { const size_t off = (size_t)row * DM + u.pn * 256 + bj * 128 + wc * 32 + fq * 8; float v[8], pv[8], bb[8]; ACC8(v, ai, bj, m, rs[ai][m]);
                    unpack8(*(const u32x4*)(pp + off), pv); unpack8(*(const u32x4*)(hb + off), bb);
#pragma unroll
                    for (int j = 0; j < 8; ++j) { v[j] = bb[j] + fsigmoid(v[j]) * pv[j]; ss += v[j] * v[j]; }
                    acc[ai][bj][m][0] = (f32x4){v[0], v[1], v[2], v[3]}; acc[ai][bj][m][1] = (f32x4){v[4], v[5], v[6], v[7]}; }
                ss += __shfl_xor(ss, 16); ss += __shfl_xor(ss, 32);
                if (fq == 0) P[(128 * ai + 64 * wr + 16 * m + fr) * 4 + wc] = ss; }
        __syncthreads();
        const int tid = wid * 64 + lane;
        if (tid < 256) { const float sum = (P[tid * 4 + 0] + P[tid * 4 + 1]) + (P[tid * 4 + 2] + P[tid * 4 + 3]);
            __hip_atomic_store(xbuf + ((size_t)u.pm * 256 + tid) * 4 + u.pn, __float_as_uint(sum), __ATOMIC_RELAXED, __HIP_MEMORY_SCOPE_AGENT); }
        asm volatile("s_waitcnt vmcnt(0)" ::: "memory");
        if (lane == 0) __hip_atomic_fetch_add(cnt + 64 * u.pm, 1u, __ATOMIC_RELAXED, __HIP_MEMORY_SCOPE_AGENT);
        if (wid == 0) { unsigned sp = 0;
            while ((unsigned)__builtin_amdgcn_readfirstlane(__hip_atomic_load(cnt + 64 * u.pm, __ATOMIC_RELAXED, __HIP_MEMORY_SCOPE_AGENT)) < 32u) { __builtin_amdgcn_s_sleep(2); if (++sp > (1u << 22)) break; }
            __builtin_amdgcn_fence(__ATOMIC_ACQUIRE, "agent");
            if (lane == 0) flag[0] = 1u; }
        asm volatile("s_waitcnt vmcnt(0) lgkmcnt(0)" ::: "memory");
        __syncthreads();
        if (tid < 256) { const unsigned* slot = xbuf + ((size_t)u.pm * 256 + tid) * 4; float s = 0.f;
#pragma unroll
            for (int t = 0; t < 4; ++t) s += __uint_as_float(__hip_atomic_load(slot + t, __ATOMIC_RELAXED, __HIP_MEMORY_SCOPE_AGENT));
            Sr[tid] = rsqrtf(s * (1.0f / 1024.0f) + EPS); }
        __syncthreads();
#pragma unroll
        for (int ai = 0; ai < 2; ++ai)
#pragma unroll
            for (int m = 0; m < 4; ++m) { const int lrow = 128 * ai + 64 * wr + 16 * m + fr; const float r = Sr[lrow];
#pragma unroll
                for (int bj = 0; bj < 2; ++bj) { const int col = u.pn * 256 + bj * 128 + wc * 32 + fq * 8; const size_t off = (size_t)(u.pm * 256 + lrow) * DM + col;
                    const f32x4 g0 = *(const f32x4*)(fnorm + col), g1 = *(const f32x4*)(fnorm + col + 4); const f32x4 a0 = acc[ai][bj][m][0], a1 = acc[ai][bj][m][1];
                    *(f32x4*)(out + off) = (f32x4){a0[0] * r * g0[0], a0[1] * r * g0[1], a0[2] * r * g0[2], a0[3] * r * g0[3]};
                    *(f32x4*)(out + off + 4) = (f32x4){a1[0] * r * g1[0], a1[1] * r * g1[1], a1[2] * r * g1[2], a1[3] * r * g1[3]}; } }
    }
};
template <int MODE> struct EpiBf16 { static constexpr bool PERM = true, AFTER_DRAIN = false; bf16_t* O; const float* ssp; const bf16_t* mul; const bf16_t* add;
    __device__ __forceinline__ void operator()(const Acc& acc, const Unit& u, int wr, int wc, int fr, int fq) const {
        const int row0 = u.pm * 256 + wr * 64 + fr; float rs[2][4];
        if (MODE == 1 || MODE == 4) load_rs(ssp, row0, fq, rs);
#pragma unroll
        for (int ai = 0; ai < 2; ++ai)
#pragma unroll
            for (int m = 0; m < 4; ++m)
#pragma unroll
                for (int bj = 0; bj < 2; ++bj) { const size_t off = (size_t)(row0 + 128 * ai + 16 * m) * DM + u.pn * 256 + bj * 128 + wc * 32 + fq * 8; float v[8];
                    ACC8(v, ai, bj, m, (MODE == 1 ? rs[ai][m] : 1.0f));
                    if (MODE == 1) {
#pragma unroll
                        for (int j = 0; j < 8; ++j) v[j] = fsigmoid(v[j]); }
                    if (MODE == 2 || MODE == 3) { float mv[8]; unpack8(*(const u32x4*)(mul + off), mv);
#pragma unroll
                        for (int j = 0; j < 8; ++j) v[j] *= mv[j]; }
                    if (MODE == 4) { float mv[8]; unpack8(*(const u32x4*)(mul + off), mv);
#pragma unroll
                        for (int j = 0; j < 8; ++j) mv[j] *= rs[ai][m];
                        sigmoid8(mv);
#pragma unroll
                        for (int j = 0; j < 8; ++j) v[j] *= mv[j]; }
                    if (MODE == 3 || MODE == 4) { float av[8]; unpack8(*(const u32x4*)(add + off), av);
#pragma unroll
                        for (int j = 0; j < 8; ++j) v[j] += av[j]; }
                    *(u32x4*)(O + off) = pack8(v); }
    }
};
struct EpiCmp1 { static constexpr bool PERM = true, AFTER_DRAIN = false; bf16_t* chid; const float* bias;
    __device__ __forceinline__ void operator()(const Acc& acc, const Unit& u, int wr, int wc, int fr, int fq) const {
        const int row0 = u.pm * 256 + wr * 64 + fr; const float* bs = bias + (u.pm >> 4) * 256;
#pragma unroll
        for (int bj = 0; bj < 2; ++bj) { const int col = bj * 128 + wc * 32 + fq * 8; const f32x4 b0 = *(const f32x4*)(bs + col), b1 = *(const f32x4*)(bs + col + 4);
            const float bb[8] = {b0[0], b0[1], b0[2], b0[3], b1[0], b1[1], b1[2], b1[3]};
#pragma unroll
            for (int ai = 0; ai < 2; ++ai)
#pragma unroll
                for (int m = 0; m < 4; ++m) { float v[8]; ACC8(v, ai, bj, m, 1.0f);
#pragma unroll
                    for (int j = 0; j < 8; ++j) v[j] = fgelu(v[j] + bb[j]);
                    *(u32x4*)(chid + (size_t)(row0 + 128 * ai + 16 * m) * 256 + col) = pack8(v); } }
    }
};
__device__ __forceinline__ void rope8(float (&v)[8], int fq, const float* cs) {
    const f32x4 c0 = *(const f32x4*)(cs), c1 = *(const f32x4*)(cs + 4), c2 = *(const f32x4*)(cs + 8), c3 = *(const f32x4*)(cs + 12);
    const float cc[8] = {c0[0], c0[2], c1[0], c1[2], c2[0], c2[2], c3[0], c3[2]}, sn[8] = {c0[1], c0[3], c1[1], c1[3], c2[1], c2[3], c3[1], c3[3]};
#pragma unroll
    for (int j = 0; j < 8; ++j) { const float other = __shfl_xor(v[j], 16); v[j] = (fq == 0) ? (v[j] * cc[j] - other * sn[j]) : (v[j] * cc[j] + other * sn[j]); }
}
struct EpiProj { static constexpr bool PERM = true, AFTER_DRAIN = false;
    const float* ssp; const float* rope; bf16_t *ub, *gv, *qraw, *qrot, *kc, *vc, *ks, *kw, *vst, *vwt, *ga; float* vstat; float* gate;
    __device__ __forceinline__ void operator()(const Acc& acc, const Unit& u, int wr, int wc, int fr, int fq) const {
        const int row0 = u.pm * 256 + wr * 64 + fr; float rs[2][4]; load_rs(ssp, row0, fq, rs);
        const int pn = u.pn;
        if (pn < 4) {
#pragma unroll
            for (int ai = 0; ai < 2; ++ai)
#pragma unroll
                for (int m = 0; m < 4; ++m)
#pragma unroll
                    for (int bj = 0; bj < 2; ++bj) { float v[8]; ACC8(v, ai, bj, m, rs[ai][m]);
#pragma unroll
                        for (int j = 0; j < 1; ++j) {}
                        gelu8(v);
                        *(u32x4*)(ub + (size_t)(row0 + 128 * ai + 16 * m) * DM + pn * 256 + bj * 128 + wc * 32 + fq * 8) = pack8(v); }
        } else if (pn >= 18 && pn < 22) {
#pragma unroll
            for (int ai = 0; ai < 2; ++ai)
#pragma unroll
                for (int m = 0; m < 4; ++m)
#pragma unroll
                    for (int bj = 0; bj < 2; ++bj) { float v[8]; ACC8(v, ai, bj, m, rs[ai][m]);
#pragma unroll
                        for (int j = 0; j < 1; ++j) {}
                        sigmoid8(v);
                        *(u32x4*)(ga + (size_t)(row0 + 128 * ai + 16 * m) * DM + (pn - 18) * 256 + bj * 128 + wc * 32 + fq * 8) = pack8(v); }
        } else if (pn < 8) {
#pragma unroll
            for (int ai = 0; ai < 2; ++ai)
#pragma unroll
                for (int m = 0; m < 4; ++m) { const int row = row0 + 128 * ai + 16 * m; float s1 = 0.f, s2 = 0.f;
#pragma unroll
                    for (int bj = 0; bj < 2; ++bj) { float v[8]; ACC8(v, ai, bj, m, rs[ai][m]);
#pragma unroll
                        for (int j = 0; j < 1; ++j) {}
                        gelu8(v);
#pragma unroll
                        for (int j = 0; j < 8; ++j) { s1 += v[j]; s2 += v[j] * v[j]; }
                        *(u32x4*)(gv + (size_t)row * DM + (pn - 4) * 256 + bj * 128 + wc * 32 + fq * 8) = pack8(v); }
                    s1 += __shfl_xor(s1, 16); s1 += __shfl_xor(s1, 32); s2 += __shfl_xor(s2, 16); s2 += __shfl_xor(s2, 32);
                    if (fq == 0) *(f32x2*)(vstat + ((size_t)row * 16 + (pn - 4) * 4 + wc) * 2) = (f32x2){s1, s2}; }
        } else if (pn < 12) {
#pragma unroll
            for (int ai = 0; ai < 2; ++ai)
#pragma unroll
                for (int m = 0; m < 4; ++m) { const int row = row0 + 128 * ai + 16 * m;
#pragma unroll
                    for (int bj = 0; bj < 2; ++bj) { float v[8]; ACC8(v, ai, bj, m, rs[ai][m] * QSCALE);
                        *(u32x4*)(qraw + (size_t)row * DM + (pn - 8) * 256 + bj * 128 + wc * 32 + fq * 8) = pack8(v);
                        if ((wc & 1) == 0) { rope8(v, fq, rope + (size_t)(row & (SEQ - 1)) * 16);
                            const int head = (pn - 8) * 4 + bj * 2 + (wc >> 1);
                            if (fq < 2) *(u32x4*)(qrot + ((size_t)row * 16 + head) * 16 + fq * 8) = pack8(v); } } }
        } else if (pn == 12 || pn == 13 || pn == 14 || pn == 16) {
            bf16_t* O = pn == 12 ? kc : pn == 13 ? vc : pn == 14 ? ks : kw; const bool rot = pn >= 14;
#pragma unroll
            for (int ai = 0; ai < 2; ++ai)
#pragma unroll
                for (int m = 0; m < 4; ++m) { const int row = row0 + 128 * ai + 16 * m;
#pragma unroll
                    for (int bj = 0; bj < 2; ++bj) { float v[8]; ACC8(v, ai, bj, m, rs[ai][m]);
                        if (rot && (wc & 1) == 0) { float w[8];
#pragma unroll
                            for (int j = 0; j < 8; ++j) w[j] = v[j];
                            rope8(w, fq, rope + (size_t)(row & (SEQ - 1)) * 16);
                            if (fq < 2) {
#pragma unroll
                                for (int j = 0; j < 8; ++j) v[j] = w[j]; } }
                        *(u32x4*)(O + (size_t)row * 256 + bj * 128 + wc * 32 + fq * 8) = pack8(v); } }
        } else if (pn == 15 || pn == 17) {
            bf16_t* O = pn == 15 ? vst : vwt;
#pragma unroll
            for (int ai = 0; ai < 2; ++ai)
#pragma unroll
                for (int m = 0; m < 4; ++m) { const int row = row0 + 128 * ai + 16 * m; const int b = row >> 12, t = row & (SEQ - 1);
#pragma unroll
                    for (int bj = 0; bj < 2; ++bj) { float v[8]; ACC8(v, ai, bj, m, rs[ai][m]); const int kvh = bj * 2 + (wc >> 1), d0 = (wc & 1) * 32 + fq * 8;
                        bf16_t* p = O + ((size_t)(b * 4 + kvh) * 64 + d0) * SEQ + t;
#pragma unroll
                        for (int j = 0; j < 8; j += 2) { const unsigned w = cvt_pk_bf16(v[j], v[j + 1]); p[(size_t)j * SEQ] = (bf16_t)(w & 0xffffu); p[(size_t)(j + 1) * SEQ] = (bf16_t)(w >> 16); } } }
        } else {
            if (wc < 2) {
#pragma unroll
                for (int ai = 0; ai < 2; ++ai)
#pragma unroll
                    for (int m = 0; m < 4; ++m) { const int row = row0 + 128 * ai + 16 * m; float v[8]; ACC8(v, ai, 0, m, rs[ai][m]); const int col = wc * 32 + fq * 8;
                        if (col < 48) {
#pragma unroll
                            for (int j = 0; j < 8; ++j) v[j] = fsigmoid(v[j]);
                            *(f32x4*)(gate + (size_t)row * 48 + col) = (f32x4){v[0], v[1], v[2], v[3]}; *(f32x4*)(gate + (size_t)row * 48 + col + 4) = (f32x4){v[4], v[5], v[6], v[7]}; } }
            }
        }
    }
};
}

struct Ctx { LAS unsigned char* lds; int tid, lane, wave, G, bid; };

__device__ __forceinline__ float wave_sum(float v) {
#pragma unroll
    for (int o = 1; o < 64; o <<= 1) v += __shfl_xor(v, o);
    return v;
}
__device__ __forceinline__ int map_row(int map, int n) {
    if (map == 1) { const int up = n >= FF ? 1 : 0, j = n - up * FF; return (j >> 7) * 256 + up * 128 + (j & 127); }
    if (map == 2) { if (n < 4608) return n; if (n < 4656) return 5632 + (n - 4608); if (n < 5680) return 4608 + (n - 4656); return N3 + (n - 5680); }
    return n;
}
constexpr int TR_SCR = 17408;
__device__ __forceinline__ void transpose_item(const float* W, int K, int N, bf16_t* WT, const float* ks, int map, LAS float* scr, int item, int lane) {
    const int nblk = (N + 63) / 64, kb = item / nblk, nb = item % nblk, k0 = 64 * kb, n0 = 64 * nb;
    const int n4 = (lane & 15) * 4, r0 = lane >> 4;
    f32x4 v[16];
#pragma unroll
    for (int i = 0; i < 16; ++i) { const int kk = r0 + 4 * i; v[i] = (f32x4){0.f, 0.f, 0.f, 0.f}; if (n0 + n4 < N) v[i] = *(const f32x4*)(W + (size_t)(k0 + kk) * N + n0 + n4); }
#pragma unroll
    for (int i = 0; i < 16; ++i) { const int kk = r0 + 4 * i; const float sc = ks ? ks[k0 + kk] : 1.0f; LAS float* d = scr + kk * 65 + n4;
        d[0] = v[i].x * sc; d[1] = v[i].y * sc; d[2] = v[i].z * sc; d[3] = v[i].w * sc; }
    LDS_FENCE();
    const int c = lane >> 3, nl = lane & 7;
#pragma unroll
    for (int j = 0; j < 8; ++j) { const int nn = nl + 8 * j, n = n0 + nn;
        if (n < N) { const LAS float* s0 = scr + (8 * c) * 65 + nn;
            u32x4 o; o.x = cvt_pk_bf16(s0[0 * 65], s0[1 * 65]); o.y = cvt_pk_bf16(s0[2 * 65], s0[3 * 65]); o.z = cvt_pk_bf16(s0[4 * 65], s0[5 * 65]); o.w = cvt_pk_bf16(s0[6 * 65], s0[7 * 65]);
            *(u32x4*)(WT + (size_t)map_row(map, n) * K + k0 + 8 * c) = o; } }
    LDS_FENCE();
}
struct TJob { const float* W; int K, N; bf16_t* dst; const float* ks; int map; };
__device__ __forceinline__ int tjob_items(const TJob& j) { return (j.K / 64) * ((j.N + 63) / 64); }

struct Args {
    const float* in[27]; float* out; unsigned char* ws; int ph_lo, ph_hi;
};
enum { I_X = 0, I_P, I_F1N, I_F1WI, I_F1WO, I_MIXN, I_WIN, I_LNG, I_LNB, I_GWS, I_GBS, I_WA, I_CPK, I_CKW1, I_CKW2, I_CPV, I_CVW1, I_CVW2, I_WB, I_WO,
       I_F2N, I_F2WI, I_F2WO, I_PLEN, I_PLEG, I_PLEP, I_FIN };

__device__ __forceinline__ void run_tjobs(const Ctx& C, const TJob* jobs, int njobs) {
    LAS float* scr = (LAS float*)(C.lds + C.wave * TR_SCR);
    const int gw = C.bid * 8 + C.wave, NGW = C.G * 8;
    int total = 0;
    for (int j = 0; j < njobs; ++j) total += tjob_items(jobs[j]);
    for (int it = gw; it < total; it += NGW) { int r = it;
        for (int j = 0; j < njobs; ++j) { const int n = tjob_items(jobs[j]); if (r < n) { transpose_item(jobs[j].W, jobs[j].K, jobs[j].N, jobs[j].dst, jobs[j].ks, jobs[j].map, scr, r, C.lane); break; } r -= n; } }
}

__device__ __forceinline__ void small_weight_item(const Args& a, unsigned char* ws, LAS float* scr, int r, int lane) {
    if (r < 256) { transpose_item(a.in[I_WA], 1024, 1024, (bf16_t*)(ws + WS_WA), nullptr, 0, scr, r, lane); return; } r -= 256;
    if (r < 256) { transpose_item(a.in[I_WB], 1024, 1024, (bf16_t*)(ws + WS_WB), nullptr, 0, scr, r, lane); return; } r -= 256;
    if (r < 256) { transpose_item(a.in[I_WO], 1024, 1024, (bf16_t*)(ws + WS_WO), nullptr, 0, scr, r, lane); return; } r -= 256;
    if (r < 256) { transpose_item(a.in[I_PLEG], 1024, 1024, (bf16_t*)(ws + WS_WPG), a.in[I_PLEN], 0, scr, r, lane); return; } r -= 256;
    transpose_item(a.in[I_PLEP], 256, 1024, (bf16_t*)(ws + WS_WPP), nullptr, 0, scr, r, lane);
}

__device__ __forceinline__ void p0_prologue(const Ctx& C, const Args& a) {
    unsigned char* ws = a.ws;
    {
        const int gw = C.bid * 8 + C.wave, NGW = C.G * 8;
        LAS float* scr = (LAS float*)(C.lds + C.wave * TR_SCR);
        const bool split = (C.G == 256);
        for (int it = gw; it < (split ? 2368 : 5136); it += NGW) { int r = it;
            if (r < 1408) { transpose_item(a.in[I_F1WI], 1024, 5632, (bf16_t*)(ws + WS_WFIN), a.in[I_F1N], 1, scr, r, C.lane); continue; } r -= 1408;
            if (r < 704) { transpose_item(a.in[I_F1WO], 2816, 1024, (bf16_t*)(ws + WS_WFOUT), nullptr, 0, scr, r, C.lane); continue; } r -= 704;
            if (!split) { if (r < 1680) { transpose_item(a.in[I_WIN], 1024, 6704, (bf16_t*)(ws + WS_WIN), a.in[I_MIXN], 2, scr, r, C.lane); continue; } r -= 1680; }
            if (r < 128) { transpose_item(a.in[I_CKW1], 2048, 256, (bf16_t*)(ws + WS_WC1), nullptr, 0, scr, r, C.lane); continue; } r -= 128;
            if (r < 128) { transpose_item(a.in[I_CVW1], 2048, 256, (bf16_t*)(ws + WS_WC1) + 256 * 2048, nullptr, 0, scr, r, C.lane); continue; } r -= 128;
            small_weight_item(a, ws, scr, r, C.lane);
        }
        const float* x = a.in[I_X]; bf16_t* xb = (bf16_t*)(ws + WS_XB); float* ssa = (float*)(ws + WS_SSA);
        for (int r = gw; r < T; r += NGW) { const f32x4* xr = (const f32x4*)(x + (size_t)r * DM) + C.lane; float s = 0.f; f32x4 v[4];
#pragma unroll
            for (int j = 0; j < 4; ++j) { v[j] = xr[64 * j]; s += (v[j].x * v[j].x + v[j].y * v[j].y) + (v[j].z * v[j].z + v[j].w * v[j].w); }
            s = wave_sum(s);
            u32x2* o = (u32x2*)(xb + (size_t)r * DM) + C.lane;
#pragma unroll
            for (int j = 0; j < 4; ++j) o[64 * j] = (u32x2){cvt_pk_bf16(v[j].x, v[j].y), cvt_pk_bf16(v[j].z, v[j].w)};
            if (C.lane < 16) ssa[(size_t)r * 16 + C.lane] = C.lane == 0 ? s : 0.f; }
        float* cb = (float*)(ws + WS_CBIAS);
        for (int it = gw; it < 64; it += NGW) { const int tsr = it >> 5, n0 = (it & 31) * 8; const float* pos = a.in[tsr ? I_CPV : I_CPK]; const float* w1 = a.in[tsr ? I_CVW1 : I_CKW1];
            float acc8[8] = {0.f, 0.f, 0.f, 0.f, 0.f, 0.f, 0.f, 0.f};
            for (int i = 0; i < 32; ++i) { const int k = C.lane + 64 * i; const float pk = pos[k]; const f32x4 w0 = *(const f32x4*)(w1 + (size_t)k * 256 + n0), w4 = *(const f32x4*)(w1 + (size_t)k * 256 + n0 + 4);
                acc8[0] += pk * w0[0]; acc8[1] += pk * w0[1]; acc8[2] += pk * w0[2]; acc8[3] += pk * w0[3]; acc8[4] += pk * w4[0]; acc8[5] += pk * w4[1]; acc8[6] += pk * w4[2]; acc8[7] += pk * w4[3]; }
#pragma unroll
            for (int j = 0; j < 8; ++j) { const float s = wave_sum(acc8[j]); if (C.lane == 0) cb[tsr * 256 + n0 + j] = s; } }
    }
    const int gt = C.bid * 512 + C.tid, NGT = C.G * 512;
    {
        float* rope = (float*)(ws + WS_ROPE);
        for (int e = gt; e < SEQ * 8; e += NGT) { const int t = e >> 3, i = e & 7;
            const float invf = i == 0 ? 1.0f : i == 1 ? 0.1939227432012558f : i == 2 ? 0.03760603070259094f : i == 3 ? 0.007292664609849453f : i == 4 ? 0.0014142135623842478f : i == 5 ? 0.00027424818836152554f : i == 6 ? 5.318296098266728e-05f : 1.0313386155758053e-05f;
            const float angf = (float)t * invf; const double ang = (double)angf;
            const double qd = __builtin_rint(ang * 0.63661977236758134308); const double r = (ang - qd * 1.5707963267948966192) - qd * 6.123233995736766e-17; const int qi = ((int)qd) & 3;
            const double r2 = r * r;
            const double sr = r * (1.0 + r2 * (-1.0 / 6 + r2 * (1.0 / 120 + r2 * (-1.0 / 5040 + r2 * (1.0 / 362880 + r2 * (-1.0 / 39916800 + r2 * (1.0 / 6227020800.0)))))));
            const double cr = 1.0 + r2 * (-0.5 + r2 * (1.0 / 24 + r2 * (-1.0 / 720 + r2 * (1.0 / 40320 + r2 * (-1.0 / 3628800 + r2 * (1.0 / 479001600.0 + r2 * (-1.0 / 87178291200.0)))))));
            const double sn = qi == 0 ? sr : qi == 1 ? cr : qi == 2 ? -sr : -cr, cs = qi == 0 ? cr : qi == 1 ? -sr : qi == 2 ? -cr : sr;
            rope[e * 2] = (float)cs; rope[e * 2 + 1] = (float)sn; }
    }
    {
        const float* w = a.in[I_GWS]; bf16_t* o = (bf16_t*)(ws + WS_GMW);
        for (int e = gt; e < 8 * 128 * 128; e += NGT) { const int t = (e >> 7) & 127, s = e & 127; const float v = s <= t ? w[e] : 0.f; o[e] = (bf16_t)(cvt_pk_bf16(v, 0.f) & 0xffffu); }
    }
}

__device__ __forceinline__ void p8_extras(const Ctx& C, const Args& a) {
    unsigned char* ws = a.ws; const int gw = C.bid * 8 + C.wave, NGW = C.G * 8;
    LAS float* scr = (LAS float*)(C.lds + C.wave * TR_SCR);
    for (int it = gw; it < 2112; it += NGW) { int r = it;
        if (r < 1408) { transpose_item(a.in[I_F2WI], 1024, 5632, (bf16_t*)(ws + WS_WFIN), a.in[I_F2N], 1, scr, r, C.lane); continue; } r -= 1408;
        transpose_item(a.in[I_F2WO], 2816, 1024, (bf16_t*)(ws + WS_WFOUT), nullptr, 0, scr, r, C.lane); }
    const float* p = a.in[I_P]; bf16_t* pb = (bf16_t*)(ws + WS_PB);
    for (int r = gw; r < T; r += NGW) { const f32x4 v = ((const f32x4*)(p + (size_t)r * PLE))[C.lane]; ((u32x2*)(pb + (size_t)r * PLE))[C.lane] = (u32x2){cvt_pk_bf16(v.x, v.y), cvt_pk_bf16(v.z, v.w)}; }
}

__device__ __forceinline__ void gmlp_job(const Ctx& C, const Args& a, int job) {
    unsigned char* ws = a.ws; const int g = job & 7, chunk = job >> 3; const int tok0 = chunk * 128;
    const bf16_t* gv = (const bf16_t*)(ws + WS_GV); bf16_t* ub = (bf16_t*)(ws + WS_UB); const float* vstat = (const float*)(ws + WS_VSTAT); const bf16_t* gmw = (const bf16_t*)(ws + WS_GMW);
    LAS bf16_t* vnT = (LAS bf16_t*)C.lds;
    const int wr = C.wave >> 1, wc = C.wave & 1, n = C.lane & 31, hi = C.lane >> 5;
    bf16x8 af[8];
    {   const bf16_t* wrow = gmw + ((size_t)g * 128 + wr * 32 + n) * 128 + 8 * hi;
#pragma unroll
        for (int k0 = 0; k0 < 8; ++k0) af[k0] = *(const bf16x8*)(wrow + 16 * k0); }
    {   const int s = C.tid >> 2, cq = C.tid & 3; const size_t row = (size_t)tok0 + s;
        float s1 = 0.f, s2 = 0.f;
#pragma unroll
        for (int k = 0; k < 8; ++k) { const f32x4 p = *(const f32x4*)(vstat + row * 32 + 4 * k); s1 += p.x + p.z; s2 += p.y + p.w; }
        const float mean = s1 * (1.0f / 1024.0f), var = s2 * (1.0f / 1024.0f) - mean * mean, rstd = rsqrtf(var + EPS);
        const float* lng = a.in[I_LNG] + g * 128 + cq * 32; const float* lnb = a.in[I_LNB] + g * 128 + cq * 32;
#pragma unroll
        for (int c8 = 0; c8 < 4; ++c8) { float v[8]; unpack8(*(const u32x4*)(gv + row * DM + g * 128 + cq * 32 + c8 * 8), v);
#pragma unroll
            for (int j = 0; j < 8; ++j) { const float y = (v[j] - mean) * rstd * lng[c8 * 8 + j] + lnb[c8 * 8 + j]; vnT[(cq * 32 + c8 * 8 + j) * 136 + s] = (bf16_t)(cvt_pk_bf16(y, 0.f) & 0xffffu); } }
    }
    __syncthreads();
    {   f32x16 acc0 = {}, acc1 = {};
        const LAS bf16_t* b0p = vnT + (wc * 64 + n) * 136 + 8 * hi; const LAS bf16_t* b1p = b0p + 32 * 136;
#pragma unroll
        for (int k0 = 0; k0 < 8; ++k0) if (k0 < 2 * (wr + 1)) { const bf16x8 bf0 = *(const LAS bf16x8*)(b0p + 16 * k0), bf1 = *(const LAS bf16x8*)(b1p + 16 * k0);
            acc0 = __builtin_amdgcn_mfma_f32_32x32x16_bf16(af[k0], bf0, acc0, 0, 0, 0); acc1 = __builtin_amdgcn_mfma_f32_32x32x16_bf16(af[k0], bf1, acc1, 0, 0, 0); }
        const float* bs = a.in[I_GBS] + g * 128 + wr * 32;
#pragma unroll
        for (int r = 0; r < 16; ++r) { const int tl = (r & 3) + 8 * (r >> 2) + 4 * hi; const float bias = bs[tl]; const size_t off = ((size_t)tok0 + wr * 32 + tl) * DM + g * 128 + wc * 64 + n;
            const float u0 = bf2f(ub[off]), u1 = bf2f(ub[off + 32]);
            ub[off] = (bf16_t)(cvt_pk_bf16(u0 * (acc0[r] + bias), 0.f) & 0xffffu); ub[off + 32] = (bf16_t)(cvt_pk_bf16(u1 * (acc1[r] + bias), 0.f) & 0xffffu); }
    }
    __syncthreads();
}

__device__ __forceinline__ void cmp2_phase(const Ctx& C, const Args& a) {
    unsigned char* ws = a.ws; const bf16_t* chid = (const bf16_t*)(ws + WS_CHID); bf16_t* kcmp = (bf16_t*)(ws + WS_KCMP); bf16_t* vcmpT = (bf16_t*)(ws + WS_VCMPT);
    const int gw = C.bid * 8 + C.wave, NGW = C.G * 8;
    for (int it = gw; it < 2048; it += NGW) { const int tsr = it >> 10, R0 = (it & 1023) * 4;
        const float* w2 = a.in[tsr ? I_CVW2 : I_CKW2]; const bf16_t* hr = chid + ((size_t)tsr * 4096 + R0) * 256;
        float acc[4] = {0.f, 0.f, 0.f, 0.f};
        for (int k8 = 0; k8 < 32; ++k8) { float wv[8];
#pragma unroll
            for (int j = 0; j < 8; ++j) wv[j] = w2[(k8 * 8 + j) * 64 + C.lane];
#pragma unroll
            for (int rr = 0; rr < 4; ++rr) { float hv[8]; unpack8(*(const u32x4*)(hr + rr * 256 + k8 * 8), hv);
#pragma unroll
                for (int j = 0; j < 8; ++j) acc[rr] += hv[j] * wv[j]; } }
#pragma unroll
        for (int rr = 0; rr < 4; ++rr) { const int R = R0 + rr; const int h = R >> 10, b = (R >> 8) & 3, i = R & 255;
            const bf16_t o = (bf16_t)(cvt_pk_bf16(i == 255 ? 0.f : acc[rr], 0.f) & 0xffffu);
            if (tsr == 0) kcmp[((size_t)(b * 4 + h) * 256 + i) * 64 + C.lane] = o; else vcmpT[((size_t)(b * 4 + h) * 64 + C.lane) * 256 + i] = o; } }
}

__device__ __forceinline__ void final_phase(const Ctx& C, const Args& a) {
    const float* ssa = (const float*)(a.ws + WS_SSA); const float* fn = a.in[I_FIN]; const int gw = C.bid * 8 + C.wave, NGW = C.G * 8;
    for (int r = gw; r < T; r += NGW) { float s = C.lane < 16 ? ssa[(size_t)r * 16 + C.lane] : 0.f; s = wave_sum(s); const float rstd = rsqrtf(s * (1.0f / 1024.0f) + EPS);
        f32x4* o = (f32x4*)(a.out + (size_t)r * DM) + C.lane; const f32x4* gp = (const f32x4*)fn + C.lane;
#pragma unroll
        for (int j = 0; j < 4; ++j) { const f32x4 v = o[64 * j], gg = gp[64 * j]; o[64 * j] = (f32x4){v.x * rstd * gg.x, v.y * rstd * gg.y, v.z * rstd * gg.z, v.w * rstd * gg.w}; } }
}

namespace att {
constexpr int ROWB = 144;
constexpr int TILEB = 64 * ROWB;
constexpr int OFF_K = 0, OFF_V = 2 * TILEB, OFF_PC = 4 * TILEB, PCROW = 260, OFF_WSF = OFF_PC + 64 * PCROW * 4, OFF_SELM = OFF_WSF + 8 * 64 * 4, LDS_END = OFF_SELM + 64 * 8;
static_assert(LDS_END <= 131072, "attention LDS");
__device__ __forceinline__ int crow(int r, int hi) { return (r & 3) + 8 * (r >> 2) + 4 * hi; }

struct Stream { const bf16_t* K; size_t kstride; const bf16_t* V; size_t vstride; };

struct State { float m, l; f32x16 o0, o1; };

struct Pre { u32x4 k0, v0, k1; };
__device__ __forceinline__ Pre prefetch(int tid, const Stream& S, int t0, int nt, bool needv) {
    const int lr = tid >> 3, lc = tid & 7; Pre p;
    const bf16_t* kg = S.K + (size_t)(t0 * 64 + lr) * S.kstride + lc * 8;
    p.k0 = *(const u32x4*)kg; p.v0 = (u32x4){0u, 0u, 0u, 0u}; p.k1 = p.v0;
    if (needv) p.v0 = *(const u32x4*)(S.V + (size_t)lr * S.vstride + (size_t)t0 * 64 + lc * 8);
    if (nt > 1) p.k1 = *(const u32x4*)(kg + (size_t)64 * S.kstride);
    return p;
}
template <int MODE>
__device__ __forceinline__ void run_branch(int tid, LAS unsigned char* lds, const Stream& S, const Pre& pre, int t0, int nt, const bf16x8 (&qf)[4], int klo, int khi, unsigned long long selbits,
                                           State& st, float inv_l, int tokl, int g) {
    const int lane = tid & 63, q = lane & 31, hi = lane >> 5, wid = __builtin_amdgcn_readfirstlane(tid >> 6);
    const int lr = tid >> 3, lc = tid & 7;
    const int pim = 16 * (q >> 4) + 8 * ((q >> 2) & 1) + 4 * ((q >> 3) & 1) + (q & 3);
    LAS float* wsf = (LAS float*)(lds + OFF_WSF) + wid * 64;
    LAS float* pc = (LAS float*)(lds + OFF_PC);
    const bf16_t* kg = S.K + (size_t)(t0 * 64 + lr) * S.kstride + lc * 8;
    const bf16_t* vg = S.V + (size_t)lr * S.vstride + (size_t)t0 * 64 + lc * 8;
    const unsigned sto = lr * ROWB + lc * 16;
    u32x4 kreg = pre.k1, vreg = pre.v0;
    *(LAS u32x4*)(lds + OFF_K + sto) = pre.k0; if (MODE != 1) *(LAS u32x4*)(lds + OFF_V + sto) = pre.v0;
    if (nt > 1) *(LAS u32x4*)(lds + OFF_K + TILEB + sto) = pre.k1;
    __syncthreads();
    const LAS unsigned char* kfb = lds + OFF_K + pim * ROWB + hi * 16;
    f32x16 p0 = {}, p1 = {};
#pragma unroll
    for (int d0 = 0; d0 < 4; ++d0) { const bf16x8 a0 = *(const LAS bf16x8*)(kfb + d0 * 32), a1 = *(const LAS bf16x8*)(kfb + 32 * ROWB + d0 * 32);
        p0 = __builtin_amdgcn_mfma_f32_32x32x16_bf16(a0, qf[d0], p0, 0, 0, 0); p1 = __builtin_amdgcn_mfma_f32_32x32x16_bf16(a1, qf[d0], p1, 0, 0, 0); }
    f32x16 q0 = {}, q1 = {};
    for (int t = 0; t < nt; t += 2) {
        {   const int jt = t0 + t; constexpr int buf = 0;
        if (t + 2 < nt) kreg = *(const u32x4*)(kg + (size_t)(t + 2) * 64 * S.kstride);
        if (MODE != 1 && t + 1 < nt) vreg = *(const u32x4*)(vg + (size_t)(t + 1) * 64);
        const int kb0 = jt * 64;
        const bool bit = (selbits >> jt) & 1ull;
        const bool none = !bit || kb0 > khi || kb0 + 63 < klo;
        const bool allv = bit && kb0 >= klo && kb0 + 63 <= khi;
        const bool colv = !none;
        if (__any(colv && !allv)) {
            const int hr = khi - kb0 - 8 * hi, lrr = klo - kb0 - 8 * hi;
#pragma unroll
            for (int r = 0; r < 16; ++r) { const int c = 16 * (r >> 3) + (r & 7);
                if (!(c <= hr && c >= lrr)) p0[r] = -__builtin_inff();
                if (!(c + 32 <= hr && c + 32 >= lrr)) p1[r] = -__builtin_inff(); }
        }
        float tm = fmaxf(fmaxf(p0[0], p0[1]), p0[2]);
#pragma unroll
        for (int r = 3; r < 15; r += 2) tm = fmaxf(fmaxf(tm, p0[r]), p0[r + 1]);
        tm = fmaxf(tm, p0[15]);
#pragma unroll
        for (int r = 0; r < 16; r += 2) tm = fmaxf(fmaxf(tm, p1[r]), p1[r + 1]);
        tm = fmaxf(tm, __shfl_xor(tm, 32));
        if (!colv) tm = -__builtin_inff();
        float mref;
        if (MODE == 2) { mref = st.m; }
        else {
            if (__any(tm > st.m + 8.0f)) {
                const float mn = fmaxf(st.m, tm); const float alpha = __builtin_amdgcn_exp2f(st.m - mn); st.l *= alpha; st.m = mn;
                if (MODE == 0) { if (hi == 0) wsf[q] = alpha; LDS_FENCE();
#pragma unroll
                    for (int r = 0; r < 16; ++r) { const float f = wsf[crow(r, hi)]; st.o0[r] *= f; st.o1[r] *= f; }
                    LDS_FENCE(); }
            }
            mref = st.m;
        }
        const float msub = colv ? mref : __builtin_inff();
        q0 = (f32x16){}; q1 = (f32x16){};
        {   const LAS unsigned char* kb = kfb + (buf ^ 1) * TILEB;
#pragma unroll
            for (int d0 = 0; d0 < 4; ++d0) { const bf16x8 a0 = *(const LAS bf16x8*)(kb + d0 * 32), a1 = *(const LAS bf16x8*)(kb + 32 * ROWB + d0 * 32);
                q0 = __builtin_amdgcn_mfma_f32_32x32x16_bf16(a0, qf[d0], q0, 0, 0, 0); q1 = __builtin_amdgcn_mfma_f32_32x32x16_bf16(a1, qf[d0], q1, 0, 0, 0); } }
        float ls = 0.f;
#pragma unroll
        for (int r = 0; r < 16; ++r) { p0[r] = __builtin_amdgcn_exp2f(p0[r] - msub); p1[r] = __builtin_amdgcn_exp2f(p1[r] - msub); ls += p0[r] + p1[r]; }
        if (MODE != 2) st.l += ls;
        if (MODE == 2) {
#pragma unroll
            for (int r = 0; r < 16; ++r) { p0[r] *= inv_l; p1[r] *= inv_l; }
            float hs0[16], hs1[16];
#pragma unroll
            for (int r = 0; r < 16; ++r) { hs0[r] = quad_sum(p0[r]); hs1[r] = quad_sum(p1[r]); }
            if (g == 0) { LAS float* pr = pc + tokl * PCROW + kb0 + 8 * hi;
#pragma unroll
                for (int r = 0; r < 16; ++r) { pr[16 * (r >> 3) + (r & 7)] = hs0[r]; pr[16 * (r >> 3) + (r & 7) + 32] = hs1[r]; } }
        }
        if (MODE != 1) {
            bf16x8 pa[4];
            {   u32x4 w;
                w.x = cvt_pk_bf16(p0[0], p0[1]); w.y = cvt_pk_bf16(p0[2], p0[3]); w.z = cvt_pk_bf16(p0[4], p0[5]); w.w = cvt_pk_bf16(p0[6], p0[7]); pa[0] = __builtin_bit_cast(bf16x8, w);
                w.x = cvt_pk_bf16(p0[8], p0[9]); w.y = cvt_pk_bf16(p0[10], p0[11]); w.z = cvt_pk_bf16(p0[12], p0[13]); w.w = cvt_pk_bf16(p0[14], p0[15]); pa[1] = __builtin_bit_cast(bf16x8, w);
                w.x = cvt_pk_bf16(p1[0], p1[1]); w.y = cvt_pk_bf16(p1[2], p1[3]); w.z = cvt_pk_bf16(p1[4], p1[5]); w.w = cvt_pk_bf16(p1[6], p1[7]); pa[2] = __builtin_bit_cast(bf16x8, w);
                w.x = cvt_pk_bf16(p1[8], p1[9]); w.y = cvt_pk_bf16(p1[10], p1[11]); w.z = cvt_pk_bf16(p1[12], p1[13]); w.w = cvt_pk_bf16(p1[14], p1[15]); pa[3] = __builtin_bit_cast(bf16x8, w); }
            const LAS unsigned char* vb = lds + OFF_V + buf * TILEB + q * ROWB + hi * 16;
#pragma unroll
            for (int c = 0; c < 4; ++c) { const bf16x8 v0 = *(const LAS bf16x8*)(vb + c * 32), v1 = *(const LAS bf16x8*)(vb + 32 * ROWB + c * 32);
                st.o0 = __builtin_amdgcn_mfma_f32_32x32x16_bf16(pa[c], v0, st.o0, 0, 0, 0); st.o1 = __builtin_amdgcn_mfma_f32_32x32x16_bf16(pa[c], v1, st.o1, 0, 0, 0); }
        }
        if (t + 2 < nt) *(LAS u32x4*)(lds + OFF_K + buf * TILEB + sto) = kreg;
        if (MODE != 1 && t + 1 < nt) *(LAS u32x4*)(lds + OFF_V + (buf ^ 1) * TILEB + sto) = vreg;
        __syncthreads();
        }
        if (t + 1 < nt) { const int t_ = t; { const int t = t_ + 1; const int jt = t0 + t; constexpr int buf = 1;
        if (t + 2 < nt) kreg = *(const u32x4*)(kg + (size_t)(t + 2) * 64 * S.kstride);
        if (MODE != 1 && t + 1 < nt) vreg = *(const u32x4*)(vg + (size_t)(t + 1) * 64);
        const int kb0 = jt * 64;
        const bool bit = (selbits >> jt) & 1ull;
        const bool none = !bit || kb0 > khi || kb0 + 63 < klo;
        const bool allv = bit && kb0 >= klo && kb0 + 63 <= khi;
        const bool colv = !none;
        if (__any(colv && !allv)) {
            const int hr = khi - kb0 - 8 * hi, lrr = klo - kb0 - 8 * hi;
#pragma unroll
            for (int r = 0; r < 16; ++r) { const int c = 16 * (r >> 3) + (r & 7);
                if (!(c <= hr && c >= lrr)) q0[r] = -__builtin_inff();
                if (!(c + 32 <= hr && c + 32 >= lrr)) q1[r] = -__builtin_inff(); }
        }
        float tm = fmaxf(fmaxf(q0[0], q0[1]), q0[2]);
#pragma unroll
        for (int r = 3; r < 15; r += 2) tm = fmaxf(fmaxf(tm, q0[r]), q0[r + 1]);
        tm = fmaxf(tm, q0[15]);
#pragma unroll
        for (int r = 0; r < 16; r += 2) tm = fmaxf(fmaxf(tm, q1[r]), q1[r + 1]);
        tm = fmaxf(tm, __shfl_xor(tm, 32));
        if (!colv) tm = -__builtin_inff();
        float mref;
        if (MODE == 2) { mref = st.m; }
        else {
            if (__any(tm > st.m + 8.0f)) {
                const float mn = fmaxf(st.m, tm); const float alpha = __builtin_amdgcn_exp2f(st.m - mn); st.l *= alpha; st.m = mn;
                if (MODE == 0) { if (hi == 0) wsf[q] = alpha; LDS_FENCE();
#pragma unroll
                    for (int r = 0; r < 16; ++r) { const float f = wsf[crow(r, hi)]; st.o0[r] *= f; st.o1[r] *= f; }
                    LDS_FENCE(); }
            }
            mref = st.m;
        }
        const float msub = colv ? mref : __builtin_inff();
        p0 = (f32x16){}; p1 = (f32x16){};
        {   const LAS unsigned char* kb = kfb + (buf ^ 1) * TILEB;
#pragma unroll
            for (int d0 = 0; d0 < 4; ++d0) { const bf16x8 a0 = *(const LAS bf16x8*)(kb + d0 * 32), a1 = *(const LAS bf16x8*)(kb + 32 * ROWB + d0 * 32);
                p0 = __builtin_amdgcn_mfma_f32_32x32x16_bf16(a0, qf[d0], p0, 0, 0, 0); p1 = __builtin_amdgcn_mfma_f32_32x32x16_bf16(a1, qf[d0], p1, 0, 0, 0); } }
        float ls = 0.f;
#pragma unroll
        for (int r = 0; r < 16; ++r) { q0[r] = __builtin_amdgcn_exp2f(q0[r] - msub); q1[r] = __builtin_amdgcn_exp2f(q1[r] - msub); ls += q0[r] + q1[r]; }
        if (MODE != 2) st.l += ls;
        if (MODE == 2) {
#pragma unroll
            for (int r = 0; r < 16; ++r) { q0[r] *= inv_l; q1[r] *= inv_l; }
            float hs0[16], hs1[16];
#pragma unroll
            for (int r = 0; r < 16; ++r) { hs0[r] = quad_sum(q0[r]); hs1[r] = quad_sum(q1[r]); }
            if (g == 0) { LAS float* pr = pc + tokl * PCROW + kb0 + 8 * hi;
#pragma unroll
                for (int r = 0; r < 16; ++r) { pr[16 * (r >> 3) + (r & 7)] = hs0[r]; pr[16 * (r >> 3) + (r & 7) + 32] = hs1[r]; } }
        }
        if (MODE != 1) {
            bf16x8 pa[4];
            {   u32x4 w;
                w.x = cvt_pk_bf16(q0[0], q0[1]); w.y = cvt_pk_bf16(q0[2], q0[3]); w.z = cvt_pk_bf16(q0[4], q0[5]); w.w = cvt_pk_bf16(q0[6], q0[7]); pa[0] = __builtin_bit_cast(bf16x8, w);
                w.x = cvt_pk_bf16(q0[8], q0[9]); w.y = cvt_pk_bf16(q0[10], q0[11]); w.z = cvt_pk_bf16(q0[12], q0[13]); w.w = cvt_pk_bf16(q0[14], q0[15]); pa[1] = __builtin_bit_cast(bf16x8, w);
                w.x = cvt_pk_bf16(q1[0], q1[1]); w.y = cvt_pk_bf16(q1[2], q1[3]); w.z = cvt_pk_bf16(q1[4], q1[5]); w.w = cvt_pk_bf16(q1[6], q1[7]); pa[2] = __builtin_bit_cast(bf16x8, w);
                w.x = cvt_pk_bf16(q1[8], q1[9]); w.y = cvt_pk_bf16(q1[10], q1[11]); w.z = cvt_pk_bf16(q1[12], q1[13]); w.w = cvt_pk_bf16(q1[14], q1[15]); pa[3] = __builtin_bit_cast(bf16x8, w); }
            const LAS unsigned char* vb = lds + OFF_V + buf * TILEB + q * ROWB + hi * 16;
#pragma unroll
            for (int c = 0; c < 4; ++c) { const bf16x8 v0 = *(const LAS bf16x8*)(vb + c * 32), v1 = *(const LAS bf16x8*)(vb + 32 * ROWB + c * 32);
                st.o0 = __builtin_amdgcn_mfma_f32_32x32x16_bf16(pa[c], v0, st.o0, 0, 0, 0); st.o1 = __builtin_amdgcn_mfma_f32_32x32x16_bf16(pa[c], v1, st.o1, 0, 0, 0); }
        }
        if (t + 2 < nt) *(LAS u32x4*)(lds + OFF_K + buf * TILEB + sto) = kreg;
        if (MODE != 1 && t + 1 < nt) *(LAS u32x4*)(lds + OFF_V + (buf ^ 1) * TILEB + sto) = vreg;
        __syncthreads();
        } }
    }
}

struct Tensors { const bf16_t *qraw, *qrot, *ks, *kw, *vst, *vwt, *kcmp, *vcmpT; const float* gate; bf16_t* ob; };

template <bool FIRST>
__device__ __forceinline__ void fold(LAS float* wsf, LAS float* oacc, int q, int hi, float fac, const State& st) {
    if (hi == 0) wsf[q] = fac; LDS_FENCE();
#pragma unroll
    for (int r = 0; r < 16; ++r) { const int row = crow(r, hi); const float f = wsf[row]; LAS float* p = oacc + row * 64 + q;
        if (FIRST) { p[0] = st.o0[r] * f; p[32] = st.o1[r] * f; } else { p[0] += st.o0[r] * f; p[32] += st.o1[r] * f; } }
    LDS_FENCE();
}

__device__ __forceinline__ void job(LAS unsigned char* lds, const Tensors& X, int b, int kvh, int qb) {
    int tid_ = threadIdx.x; asm volatile("" : "+v"(tid_));
    const int tid = tid_, lane = tid & 63, q = lane & 31, hi = lane >> 5, wid = __builtin_amdgcn_readfirstlane(tid >> 6);
    const int tokl = 8 * wid + (q >> 2), g = q & 3, tq = 64 * qb + tokl, head = 4 * kvh + g;
    const size_t trow = (size_t)b * SEQ + tq;
    LAS float* wsf = (LAS float*)(lds + OFF_WSF) + wid * 64;
    LAS float* pc = (LAS float*)(lds + OFF_PC);
    LAS unsigned long long* selm = (LAS unsigned long long*)(lds + OFF_SELM);
    bf16x8 qf[4];
    {   const bf16_t* qp = X.qraw + trow * DM + head * 64 + 8 * hi;
#pragma unroll
        for (int d0 = 0; d0 < 4; ++d0) qf[d0] = *(const bf16x8*)(qp + 16 * d0); }
    const float g0 = X.gate[trow * 48 + head * 3 + 0], g1 = X.gate[trow * 48 + head * 3 + 1], g2 = X.gate[trow * 48 + head * 3 + 2];
    LAS float* oacc = pc + 8 * wid * PCROW;
    const size_t bk = (size_t)b * 4 + kvh;
    const Stream Ssel{X.ks + (size_t)b * SEQ * 256 + kvh * 64, 256, X.vst + bk * 64 * SEQ, SEQ};
    Pre prs;
    {   const Stream S{X.kcmp + bk * 256 * 64, 64, X.vcmpT + bk * 64 * 256, 256};
        const int nct = (qb >> 4) + 1; const int mmax = tq >= 31 ? ((tq - 31) >> 4) : -1;
        State st; st.m = -1e30f; st.l = 0.f; st.o0 = (f32x16){}; st.o1 = (f32x16){};
        const Pre prc = prefetch(tid, S, 0, nct, true);
        run_branch<1>(tid, lds, S, prc, 0, nct, qf, -(1 << 30), mmax, ~0ull, st, 0.f, tokl, g);
        float lt = st.l + __shfl_xor(st.l, 32); const float inv_l = lt > 0.f ? 1.0f / lt : 0.f;
        run_branch<2>(tid, lds, S, prc, 0, nct, qf, -(1 << 30), mmax, ~0ull, st, inv_l, tokl, g);
    prs = prefetch(tid, Ssel, 0, qb + 1, true);
    {
        if (qb < 16) { if (lane < 8) selm[8 * wid + lane] = (2ull << qb) - 1ull; }
        else
#pragma unroll 1
        for (int i = 0; i < 4; ++i) { const int j = lane; unsigned keyA, keyB;
            if (j == 0 || j == qb || j == qb - 1) { keyA = 0xffffffc0u; keyB = 0xffffffc0u; } else if (j > qb) { keyA = 0u; keyB = 0u; }
            else { const LAS float* pa_ = pc + (8 * wid + i) * PCROW + 4 * j; const LAS float* pb_ = pa_ + 4 * PCROW;
                const float sa = (((pa_[-1] + pa_[0]) + pa_[1]) + pa_[2]) + pa_[3], sb = (((pb_[-1] + pb_[0]) + pb_[1]) + pb_[2]) + pb_[3];
                keyA = (__float_as_uint(sa) & 0x7fffffc0u) + 64u; keyB = (__float_as_uint(sb) & 0x7fffffc0u) + 64u; }
            keyA |= (unsigned)(63 - j); keyB |= (unsigned)(63 - j);
            unsigned thrA = 0u, thrB = 0u;
#pragma unroll
            for (int bpos = 29; bpos >= 0; --bpos) { const unsigned cA = thrA | (1u << bpos), cB = thrB | (1u << bpos);
                const unsigned long long mA = __ballot(keyA >= cA), mB = __ballot(keyB >= cB); if (__popcll(mA) >= 16) thrA = cA; if (__popcll(mB) >= 16) thrB = cB; }
            const unsigned long long maskA = __ballot(keyA >= thrA), maskB = __ballot(keyB >= thrB);
            if (lane == 0) { selm[8 * wid + i] = maskA; selm[8 * wid + i + 4] = maskB; } }
        LDS_FENCE();
        fold<true>(wsf, oacc, q, hi, g0, st);
    }
    }
    const unsigned long long mysel = selm[tokl];
    qf[0] = *(const bf16x8*)(X.qrot + (trow * 16 + head) * 16 + 8 * hi);
    const Stream Swin{X.kw + (size_t)b * SEQ * 256 + kvh * 64, 256, X.vwt + bk * 64 * SEQ, SEQ};
    const int tw0 = qb >= 8 ? qb - 8 : 0;
    Pre prw;
    {   State st; st.m = -1e30f; st.l = 0.f; st.o0 = (f32x16){}; st.o1 = (f32x16){};
        run_branch<0>(tid, lds, Ssel, prs, 0, qb + 1, qf, -(1 << 30), tq, mysel, st, 0.f, tokl, g);
        prw = prefetch(tid, Swin, tw0, qb + 1 - tw0, true);
        const float lt = st.l + __shfl_xor(st.l, 32); fold<false>(wsf, oacc, q, hi, lt > 0.f ? g1 / lt : 0.f, st);
    }
    {   State st; st.m = -1e30f; st.l = 0.f; st.o0 = (f32x16){}; st.o1 = (f32x16){};
        run_branch<0>(tid, lds, Swin, prw, tw0, qb + 1 - tw0, qf, tq - 511, tq, ~0ull, st, 0.f, tokl, g);
        const float lt = st.l + __shfl_xor(st.l, 32); fold<false>(wsf, oacc, q, hi, lt > 0.f ? g2 / lt : 0.f, st);
    }
    {   const int qq = lane >> 1, ch = lane & 1; const LAS float* src = oacc + qq * 64 + ch * 32;
        bf16_t* op = X.ob + ((size_t)b * SEQ + 64 * qb + 8 * wid + (qq >> 2)) * DM + (4 * kvh + (qq & 3)) * 64 + ch * 32;
#pragma unroll
        for (int c = 0; c < 4; ++c) { const f32x4 x0 = *(const LAS f32x4*)(src + c * 8), x1 = *(const LAS f32x4*)(src + c * 8 + 4);
            *(u32x4*)(op + c * 8) = (u32x4){cvt_pk_bf16(x0[0], x0[1]), cvt_pk_bf16(x0[2], x0[3]), cvt_pk_bf16(x1[0], x1[1]), cvt_pk_bf16(x1[2], x1[3])}; }
        LDS_FENCE(); }
}
}


#define XB_TMO      128
#define XB_XCNT(j)  (256  + 64 * (j))
#define XB_XSUB(j)  (1280 + 64 * (j))
#define XB_XGEN(j)  (2304 + 64 * (j))
#define XB_TOP      3328
#define XB_TOPGEN   3392
#define XCD_BAR_WORDS 3456
#define XB_SPIN_CAP (1u << 20)
__device__ __forceinline__ unsigned xb_ld(unsigned* p)              { return __hip_atomic_load(p, __ATOMIC_RELAXED, __HIP_MEMORY_SCOPE_AGENT); }
__device__ __forceinline__ unsigned xb_add(unsigned* p, unsigned v) { return __hip_atomic_fetch_add(p, v, __ATOMIC_RELAXED, __HIP_MEMORY_SCOPE_AGENT); }
__device__ __forceinline__ unsigned xb_xcc_id() { return (unsigned)__builtin_amdgcn_s_getreg((3 << 11) | 20) & 0xFu; }
#define XB_SPIN(cond, bar) do { unsigned _sp = 0; while (cond) { __builtin_amdgcn_s_sleep(1); \
    if ((++_sp & 255u) == 0u) { if (xb_ld(&(bar)[XB_TMO])) break; if (_sp > XB_SPIN_CAP) { atomicAdd(&(bar)[XB_TMO], 1u); break; } } } } while (0)
struct XcdBarrier { unsigned* bar; unsigned x; volatile LAS unsigned* st; };
__device__ __forceinline__ XcdBarrier xcd_barrier_post(unsigned* bar, volatile LAS unsigned* st) {
    XcdBarrier b; b.bar = bar; b.x = xb_xcc_id(); b.st = st;
    if (threadIdx.x == 0) (void)xb_add(&bar[XB_XCNT(b.x)], 1u);
    return b;
}
__device__ __forceinline__ void xcd_barrier_complete(unsigned* bar, unsigned x, unsigned& nloc, unsigned& nx) {
    const unsigned G = gridDim.x * gridDim.y * gridDim.z;
    unsigned sum, cnt, mine, sp = 0u;
    for (;;) {
        sum = 0u; cnt = 0u; mine = 0u;
#pragma unroll
        for (unsigned j = 0; j < 16; ++j) { const unsigned c = xb_ld(&bar[XB_XCNT(j)]); sum += c; cnt += (c > 0u) ? 1u : 0u; mine = (j == x) ? c : mine; }
        if (sum == G) break;
        __builtin_amdgcn_s_sleep(1);
        if ((++sp & 255u) == 0u) { if (xb_ld(&bar[XB_TMO])) break; if (sp > XB_SPIN_CAP) { atomicAdd(&bar[XB_TMO], 1u); break; } }
    }
    nloc = mine > 0u ? mine : 1u; nx = cnt > 0u ? cnt : 1u;
}
__device__ __forceinline__ void xcd_barrier(const XcdBarrier& b) {
    asm volatile("s_waitcnt vmcnt(0)" ::: "memory");
    __syncthreads();
    if (threadIdx.x == 0) {
        unsigned* bar = b.bar;
        __builtin_amdgcn_s_waitcnt(0);
        unsigned nloc = b.st[0], nx = b.st[1];
        if (nloc == 0u) { xcd_barrier_complete(bar, b.x, nloc, nx); b.st[0] = nloc; b.st[1] = nx; }
        const unsigned old = xb_add(&bar[XB_XSUB(b.x)], 1u);
        const unsigned gen = old / nloc;
        if (old + 1u == (gen + 1u) * nloc) {
            __builtin_amdgcn_fence(__ATOMIC_RELEASE, "agent");
            asm volatile("s_waitcnt vmcnt(0)" ::: "memory");
            const unsigned og = xb_add(&bar[XB_TOP], 1u);
            const unsigned tg = og / nx;
            if (og + 1u == (tg + 1u) * nx) xb_add(&bar[XB_TOPGEN], 1u);
            else XB_SPIN(xb_ld(&bar[XB_TOPGEN]) == tg, bar);
            __builtin_amdgcn_fence(__ATOMIC_ACQUIRE, "agent");
            xb_add(&bar[XB_XGEN(b.x)], 1u);
            asm volatile("s_waitcnt vmcnt(0)" ::: "memory");
        } else {
            XB_SPIN(xb_ld(&bar[XB_XGEN(b.x)]) == gen, bar);
            __builtin_amdgcn_fence(__ATOMIC_ACQUIRE, "agent");
            asm volatile("s_waitcnt vmcnt(0)" ::: "memory");
        }
    }
    __syncthreads();
}

constexpr int LDS_BYTES = 147456;
typedef const __attribute__((address_space(4))) Args* KArgP;
#define KARGS() (*(const Args*)({ KArgP p_ = (KArgP)__builtin_amdgcn_kernarg_segment_ptr(); asm volatile("" : "+s"(p_)); p_; }))
__global__ void __launch_bounds__(512, 2) mk_fwd(Args a_unused) {
    extern __shared__ __attribute__((aligned(16))) unsigned char lds_raw[];
    Ctx C; C.lds = (LAS unsigned char*)lds_raw; C.tid = threadIdx.x; C.lane = C.tid & 63; C.wave = __builtin_amdgcn_readfirstlane(C.tid >> 6); C.G = gridDim.x; C.bid = blockIdx.x;
    const int lo = KARGS().ph_lo, hi = KARGS().ph_hi;
    volatile LAS unsigned* xst = (volatile LAS unsigned*)(C.lds + LDS_BYTES - 64);
    if (C.tid < 2) xst[C.tid] = 0u;
    __syncthreads();
    if (lo > NPHASE) cg::this_grid().sync();
    const XcdBarrier xbar = xcd_barrier_post((unsigned*)(KARGS().ws + WS_BAR), xst);
#ifdef ONLY_PHASE
#define IN(k) ((k) == ONLY_PHASE && lo <= (k) && (k) < hi)
#else
#define IN(k) (lo <= (k) && (k) < hi)
#endif
#define SEAM(k) do { if (IN(k) && IN((k) + 1)) { xcd_barrier(xbar); } } while (0)
    using namespace pg8;
    const int NT = T / 256;
#define PHASE_VARS const Args& a = KARGS(); unsigned char* ws = a.ws; float* ssA = (float*)(ws + WS_SSA); float* ssB = (float*)(ws + WS_SSB); bf16_t* hb = (bf16_t*)(ws + WS_HB); bf16_t* hid = (bf16_t*)(ws + WS_HID); float* ssC = (float*)(ws + WS_SSC); float* ssD = (float*)(ws + WS_SSD); (void)ssC; (void)ssD; \
    (void)ssA; (void)ssB; (void)hb; (void)hid;

    if (IN(0)) { PHASE_VARS p0_prologue(C, a);
#ifdef PROBE_P0X2
        __syncthreads(); p0_prologue(C, a);
#endif
    } SEAM(0);
    if (IN(1)) { PHASE_VARS
        Gemm g{(const char*)(ws + WS_XB), (const char*)(ws + WS_WFIN), DM, 128, DM, NT, 22, 0}; StaticOrder S; S.init(NT, 22, C.G, C.bid);
        EpiSwiGLU E{ssA, hid}; gemm_phase<EpiSwiGLU, StaticOrder>(C.lds, g, S, E);
        if (C.G == 256 && C.bid >= 128) { __syncthreads(); LAS float* scr = (LAS float*)(C.lds + C.wave * TR_SCR);
            for (int it = (C.bid - 128) * 8 + C.wave; it < 1680; it += 1024) transpose_item(a.in[I_WIN], 1024, 6704, (bf16_t*)(ws + WS_WIN), a.in[I_MIXN], 2, scr, it, C.lane); }
#ifdef PROBE_G1X2
        gemm_phase<EpiSwiGLU, StaticOrder>(C.lds, g, S, E);
#endif
    } SEAM(1);
    if (IN(2)) { PHASE_VARS
        Gemm g{(const char*)hid, (const char*)(ws + WS_WFOUT), FF, 128, FF, NT, 4, 0}; StaticOrder S; S.init(NT, 4, C.G, C.bid);
        EpiResid E{(const bf16_t*)(ws + WS_XB), 0.5f, hb, ssB}; gemm_phase<EpiResid, StaticOrder>(C.lds, g, S, E);
    } SEAM(2);
    if (IN(3)) { PHASE_VARS
        Gemm g{(const char*)hb, (const char*)(ws + WS_WIN), DM, 128, DM, NT, 23, 0}; StaticOrder S; S.init(NT, 23, C.G, C.bid);
        EpiProj E{ssB, (const float*)(ws + WS_ROPE), (bf16_t*)(ws + WS_UB), (bf16_t*)(ws + WS_GV), (bf16_t*)(ws + WS_QRAW), (bf16_t*)(ws + WS_QROT), (bf16_t*)(ws + WS_KC), (bf16_t*)(ws + WS_VC),
                  (bf16_t*)(ws + WS_KS), (bf16_t*)(ws + WS_KW), (bf16_t*)(ws + WS_VST), (bf16_t*)(ws + WS_VWT), (bf16_t*)(ws + WS_GA), (float*)(ws + WS_VSTAT), (float*)(ws + WS_GATE)};
        gemm_phase<EpiProj, StaticOrder>(C.lds, g, S, E);
        if (C.G == 256 && C.bid >= 192) { __syncthreads(); LAS float* scr = (LAS float*)(C.lds + C.wave * TR_SCR);
            for (int it = (C.bid - 192) * 8 + C.wave; it < 1088; it += 512) small_weight_item(a, ws, scr, it, C.lane); }
#ifdef PROBE_G3X2
        gemm_phase<EpiProj, StaticOrder>(C.lds, g, S, E);
#endif
    } SEAM(3);
    if (IN(4)) { PHASE_VARS
#ifndef NO_CMP
        {   Gemm g{(const char*)(ws + WS_KC), (const char*)(ws + WS_WC1), 4096, 512, 2048, 32, 1, 1}; StaticOrder S; S.init(32, 1, C.G, C.bid);
            EpiCmp1 E{(bf16_t*)(ws + WS_CHID), (const float*)(ws + WS_CBIAS)}; gemm_phase<EpiCmp1, StaticOrder>(C.lds, g, S, E); }
#endif
        __syncthreads();
#ifndef NO_GMLP
        if (C.G == 256) { if (C.bid >= 32) for (int j = C.bid - 32; j < 1024; j += 224) gmlp_job(C, a, j); }
        else for (int j = C.bid; j < 1024; j += C.G) gmlp_job(C, a, j);
#endif
    } SEAM(4);
    if (IN(5)) { PHASE_VARS
        {   Gemm g{(const char*)(ws + WS_UB), (const char*)(ws + WS_WA), DM, 128, DM, NT, 4, 0}; StaticOrder S; S.init(NT, 4, C.G, C.bid);
            EpiBf16<2> E{(bf16_t*)(ws + WS_GV), nullptr, (const bf16_t*)(ws + WS_GA), nullptr}; gemm_phase<EpiBf16<2>, StaticOrder>(C.lds, g, S, E); }
#ifndef NO_CMP
        cmp2_phase(C, a);
#endif
    } SEAM(5);
    if (IN(6)) { PHASE_VARS
        att::Tensors X{(const bf16_t*)(ws + WS_QRAW), (const bf16_t*)(ws + WS_QROT), (const bf16_t*)(ws + WS_KS), (const bf16_t*)(ws + WS_KW), (const bf16_t*)(ws + WS_VST), (const bf16_t*)(ws + WS_VWT),
                       (const bf16_t*)(ws + WS_KCMP), (const bf16_t*)(ws + WS_VCMPT), (const float*)(ws + WS_GATE), (bf16_t*)(ws + WS_QRAW)};
#ifndef NO_ATTN
#ifdef PROBE_ATTN2
        { att::Tensors X0 = X; X0.ob = (bf16_t*)(ws + WS_UB);
        if (C.G == 256) { const int vcu = (C.bid & 7) * 32 + (C.bid >> 3); const int bkv = vcu >> 4, s = vcu & 15;
#pragma unroll 1
            for (int i = 0; i < 4; ++i) { const int qb = i == 0 ? 63 - s : i == 1 ? 32 + s : i == 2 ? 31 - s : s; att::job(C.lds, X0, bkv >> 2, bkv & 3, qb); }
        } else { for (int j = C.bid; j < 1024; j += C.G) { const int bkv = j & 15, qb = 63 - (j >> 4); att::job(C.lds, X0, bkv >> 2, bkv & 3, qb); } }
        __syncthreads(); }
#endif
        if (C.G == 256) { const int vcu = (C.bid & 7) * 32 + (C.bid >> 3); const int bkv = vcu >> 4, s = vcu & 15;
#pragma unroll 1
            for (int i = 0; i < 4; ++i) { const int qb = i == 0 ? 63 - s : i == 1 ? 32 + s : i == 2 ? 31 - s : s; att::job(C.lds, X, bkv >> 2, bkv & 3, qb); }
        } else { for (int j = C.bid; j < 1024; j += C.G) { const int bkv = j & 15, qb = 63 - (j >> 4); att::job(C.lds, X, bkv >> 2, bkv & 3, qb); } }
#endif
        __syncthreads();
#ifndef NO_GB
        {   Gemm g{(const char*)hb, (const char*)(ws + WS_WGB), DM, 128, DM, NT, 4, 0}; StaticOrder S; S.init(NT, 4, C.G, C.bid);
            EpiBf16<0> E{(bf16_t*)(ws + WS_UB), nullptr, nullptr, nullptr}; gemm_phase<EpiBf16<0>, StaticOrder>(C.lds, g, S, E); }
#endif
    } SEAM(6);
    if (IN(7)) { PHASE_VARS
        Gemm g{(const char*)(ws + WS_QRAW), (const char*)(ws + WS_WB), DM, 128, DM, NT, 4, 0}; StaticOrder S; S.init(NT, 4, C.G, C.bid);
        EpiBf16<4> E{(bf16_t*)(ws + WS_GV), ssB, (const bf16_t*)(ws + WS_UB), (const bf16_t*)(ws + WS_GV)}; gemm_phase<EpiBf16<4>, StaticOrder>(C.lds, g, S, E);
    } SEAM(7);
    if (IN(8)) { PHASE_VARS
        {   Gemm g{(const char*)(ws + WS_GV), (const char*)(ws + WS_WO), DM, 128, DM, NT, 4, 0}; StaticOrder S; S.init(NT, 4, C.G, C.bid);
            EpiResid E{hb, 1.0f, hb, ssC}; gemm_phase<EpiResid, StaticOrder>(C.lds, g, S, E); }
        __syncthreads();
        p8_extras(C, a);
    } SEAM(8);
    if (IN(9)) { PHASE_VARS
        {   Gemm g{(const char*)hb, (const char*)(ws + WS_WFIN), DM, 128, DM, NT, 22, 0}; StaticOrder S; S.init(NT, 22, C.G, C.bid);
            EpiSwiGLU E{ssC, hid}; gemm_phase<EpiSwiGLU, StaticOrder>(C.lds, g, S, E); }
        int opq = 0; asm volatile("" : "+s"(opq));
        if (opq == 0) {   int kple = PLE; asm volatile("" : "+s"(kple));
            Gemm g{(const char*)(ws + WS_PB), (const char*)(ws + WS_WPP), PLE, 128, kple, NT, 4, 0}; StaticOrder S;
            if (C.G == 256) S.init(NT, 4, 128, C.bid >= 128 ? C.bid - 128 : -1); else S.init(NT, 4, C.G, C.bid);
            EpiBf16<0> E{(bf16_t*)(ws + WS_PP), nullptr, nullptr, nullptr}; gemm_phase<EpiBf16<0>, StaticOrder>(C.lds, g, S, E); }
    } SEAM(9);
    if (IN(10)) { PHASE_VARS
        Gemm g{(const char*)hid, (const char*)(ws + WS_WFOUT), FF, 128, FF, NT, 4, 0}; StaticOrder S; S.init(NT, 4, C.G, C.bid);
        EpiResid E{hb, 0.5f, hb, ssD}; gemm_phase<EpiResid, StaticOrder>(C.lds, g, S, E);
    } SEAM(10);
    if (IN(11)) { PHASE_VARS
        Gemm g{(const char*)hb, (const char*)(ws + WS_WPG), DM, 128, DM, NT, 4, 0}; StaticOrder S; S.init(NT, 4, C.G, C.bid);
        if (C.G == 256) { EpiPleFinal E{ssD, (const bf16_t*)(ws + WS_PP), hb, a.out, a.in[I_FIN], (unsigned*)(ws + WS_BAR + 32768), (unsigned*)(ws + WS_BAR + 16384)};
            gemm_phase<EpiPleFinal, StaticOrder>(C.lds, g, S, E); }
        else { EpiPle E{ssD, (const bf16_t*)(ws + WS_PP), hb, a.out, ssA}; gemm_phase<EpiPle, StaticOrder>(C.lds, g, S, E); }
    }
    if (C.G != 256) { SEAM(11); if (IN(12)) { PHASE_VARS final_phase(C, a); } }
#undef IN
#undef SEAM
}

extern "C" void kernel_launch(void* const* d_in, const int* in_sizes, int n_in, void* d_out, int out_size, void* d_ws, size_t ws_size, hipStream_t stream) {
    static int grid = 0;
    if (grid == 0) {
        if (n_in != 27 || out_size != T * DM || ws_size < WS_END) { fprintf(stderr, "kernel_launch: unexpected problem (n_in %d, out %d, ws %zu)\n", n_in, out_size, ws_size); grid = -1; return; }
        int dev = 0, cus = 0, per_cu = 0;
        hipGetDevice(&dev); hipDeviceGetAttribute(&cus, hipDeviceAttributeMultiprocessorCount, dev);
        hipFuncSetAttribute((const void*)mk_fwd, hipFuncAttributeMaxDynamicSharedMemorySize, LDS_BYTES);
        hipOccupancyMaxActiveBlocksPerMultiprocessor(&per_cu, (const void*)mk_fwd, 512, LDS_BYTES);
        if (per_cu < 1) { fprintf(stderr, "kernel_launch: occupancy query says %d blocks per CU\n", per_cu); per_cu = 1; }
        (void)hipGetLastError();
        grid = cus * 1;
    }
    if (grid < 0) return;
    Args a{};
    for (int i = 0; i < 27; ++i) a.in[i] = (const float*)d_in[i];
    a.out = (float*)d_out; a.ws = (unsigned char*)d_ws;
#if MK_SINGLE
    hipMemsetAsync((char*)d_ws + WS_BAR, 0, 32768, stream);
    a.ph_lo = 0; a.ph_hi = NPHASE;
    void* args[] = {&a};
    hipError_t e = hipLaunchCooperativeKernel((const void*)mk_fwd, dim3(grid), dim3(512), args, LDS_BYTES, stream);
    if (e != hipSuccess) fprintf(stderr, "cooperative launch failed: %s (grid %d)\n", hipGetErrorString(e), grid);
#else
    for (int k = 0; k < NPHASE; ++k) { a.ph_lo = k; a.ph_hi = k + 1; hipLaunchKernelGGL(mk_fwd, dim3(grid), dim3(512), LDS_BYTES, stream, a); }
#endif
}
```

```cpp
#include <hip/hip_runtime.h>
#include <hip/hip_cooperative_groups.h>
#include <cstdint>
#include <cstdio>
namespace cg = cooperative_groups;

#ifndef MK_SINGLE
#define MK_SINGLE 1
#endif

#define LAS __attribute__((address_space(3)))
typedef unsigned short bf16_t;
typedef short bf16x8 __attribute__((ext_vector_type(8)));
typedef float f32x4 __attribute__((ext_vector_type(4)));
typedef float f32x2 __attribute__((ext_vector_type(2)));
typedef float f32x16 __attribute__((ext_vector_type(16)));
typedef unsigned u32x4 __attribute__((ext_vector_type(4)));
typedef unsigned u32x2 __attribute__((ext_vector_type(2)));

constexpr int T = 16384, SEQ = 4096, DM = 1024, FF = 2816, PLE = 256;
constexpr int N3 = 5888;
constexpr float EPS = 1e-6f;
constexpr float LOG2E = 1.4426950408889634f;
constexpr float QSCALE = 0.125f * LOG2E;
constexpr int NPHASE = 13;

constexpr size_t MiB = 1u << 20;
constexpr size_t WS_SSA = 0, WS_SSB = 1 * MiB, WS_VSTAT = 2 * MiB, WS_ROPE = 4 * MiB, WS_GMW = 4 * MiB + 256 * 1024,
                 WS_KCMP = 4 * MiB + 512 * 1024, WS_VCMPT = 5 * MiB, WS_CBIAS = 5 * MiB + 512 * 1024, WS_GATE = 6 * MiB, WS_SSC = 9 * MiB, WS_SSD = 10 * MiB;
constexpr size_t WS_WIN = 11 * MiB;
constexpr size_t WS_WGB = WS_WIN + (size_t)N3 * 1024 * 2;
constexpr size_t WS_WA = WS_WGB + 2 * MiB, WS_WB = WS_WA + 2 * MiB, WS_WO = WS_WB + 2 * MiB, WS_WPG = WS_WO + 2 * MiB, WS_WPP = WS_WPG + 2 * MiB,
                 WS_WC1 = 33 * MiB;
constexpr size_t WS_WFIN = 35 * MiB, WS_WFOUT = 46 * MiB;
constexpr size_t WS_KC = 35 * MiB, WS_VC = 43 * MiB;
constexpr size_t WS_HID = 52 * MiB;
constexpr size_t WS_QRAW = 52 * MiB, WS_QROT = 84 * MiB, WS_KS = 92 * MiB, WS_KW = 100 * MiB, WS_VST = 108 * MiB, WS_VWT = 116 * MiB,
                 WS_GA = 124 * MiB, WS_UB = 156 * MiB, WS_HB = 188 * MiB, WS_GV = 220 * MiB, WS_CHID = 252 * MiB;
constexpr size_t WS_XB = 140 * MiB, WS_PB = 140 * MiB, WS_PP = 148 * MiB;
constexpr size_t WS_BAR = 51 * MiB + 512 * 1024;
constexpr size_t WS_END = 256 * MiB;
static_assert(WS_WPP + 512 * 1024 <= WS_WC1 && WS_WC1 + 2 * MiB <= WS_WFIN, "weight map");

typedef __bf16 bf16x2_t __attribute__((ext_vector_type(2)));
__device__ __forceinline__ unsigned cvt_pk_bf16(float lo, float hi) { f32x2 v = {lo, hi}; bf16x2_t b = __builtin_convertvector(v, bf16x2_t); return __builtin_bit_cast(unsigned, b); }
__device__ __forceinline__ float bf2f(unsigned short b) { return __uint_as_float((unsigned)b << 16); }
__device__ __forceinline__ float bflo(unsigned w) { return __uint_as_float(w << 16); }
__device__ __forceinline__ float bfhi(unsigned w) { return __uint_as_float(w & 0xffff0000u); }
__device__ __forceinline__ float fsigmoid(float x) { return __builtin_amdgcn_rcpf(1.0f + __builtin_amdgcn_exp2f(-x * LOG2E)); }
__device__ __forceinline__ float fsilu(float x) { return x * fsigmoid(x); }
__device__ __forceinline__ float fgelu(float x) { return x * fsigmoid(1.5957691216057308f * (x + 0.044715f * x * x * x)); }
__device__ __forceinline__ void sigmoid8(float (&v)[8]) {
#pragma unroll
    for (int i = 0; i < 8; i += 2) { f32x2 x = {v[i], v[i + 1]}; const f32x2 z = x * (-LOG2E); f32x2 e = {__builtin_amdgcn_exp2f(z.x), __builtin_amdgcn_exp2f(z.y)}; const f32x2 d = e + 1.0f;
        v[i] = __builtin_amdgcn_rcpf(d.x); v[i + 1] = __builtin_amdgcn_rcpf(d.y); }
}
__device__ __forceinline__ void silu8(float (&v)[8]) {
#pragma unroll
    for (int i = 0; i < 8; i += 2) { f32x2 x = {v[i], v[i + 1]}; const f32x2 z = x * (-LOG2E); f32x2 e = {__builtin_amdgcn_exp2f(z.x), __builtin_amdgcn_exp2f(z.y)}; const f32x2 d = e + 1.0f;
        const f32x2 r = {__builtin_amdgcn_rcpf(d.x), __builtin_amdgcn_rcpf(d.y)}; x = x * r; v[i] = x.x; v[i + 1] = x.y; }
}
__device__ __forceinline__ void gelu8(float (&v)[8]) {
    constexpr float c0 = -1.5957691216057308f * LOG2E, c1 = c0 * 0.044715f;
#pragma unroll
    for (int i = 0; i < 8; i += 2) { f32x2 x = {v[i], v[i + 1]}; const f32x2 w = (x * x) * c1 + c0; const f32x2 z = x * w; f32x2 e = {__builtin_amdgcn_exp2f(z.x), __builtin_amdgcn_exp2f(z.y)}; const f32x2 d = e + 1.0f;
        const f32x2 r = {__builtin_amdgcn_rcpf(d.x), __builtin_amdgcn_rcpf(d.y)}; x = x * r; v[i] = x.x; v[i + 1] = x.y; }
}
__device__ __forceinline__ u32x4 pack8(const float (&v)[8]) { u32x4 w; w.x = cvt_pk_bf16(v[0], v[1]); w.y = cvt_pk_bf16(v[2], v[3]); w.z = cvt_pk_bf16(v[4], v[5]); w.w = cvt_pk_bf16(v[6], v[7]); return w; }
__device__ __forceinline__ void unpack8(const u32x4 w, float (&v)[8]) { v[0] = bflo(w.x); v[1] = bfhi(w.x); v[2] = bflo(w.y); v[3] = bfhi(w.y); v[4] = bflo(w.z); v[5] = bfhi(w.z); v[6] = bflo(w.w); v[7] = bfhi(w.w); }
#define LDS_FENCE() asm volatile("s_waitcnt lgkmcnt(0)" ::: "memory")
__device__ __forceinline__ float quad_sum(float v) {
    v += __int_as_float(__builtin_amdgcn_update_dpp(0, __float_as_int(v), 0xB1, 0xF, 0xF, true));
    v += __int_as_float(__builtin_amdgcn_update_dpp(0, __float_as_int(v), 0x4E, 0xF, 0xF, true));
    return v;
}

namespace pg8 {
constexpr int BM = 256, BK = 64, HALF = 128, HTB = HALF * BK * 2, STAGE_BYTES = 8 * HTB, NXCD = 8, WGM = 4;
__host__ __device__ __forceinline__ int lds_byte(int r, int c) { const int st = (r >> 4) * 2 + (c >> 5), rr = r & 15, cc = c & 31, ob = rr * 64 + cc * 2; return st * 1024 + (ob ^ (((ob >> 9) & 1) << 5)); }
__host__ __device__ __forceinline__ void stage_rc(int b, int& R, int& C) { const int st = b / 1024, sb = b % 1024, swz = sb ^ (((sb >> 9) & 1) << 5); R = (st >> 1) * 16 + swz / 64; C = (st & 1) * 32 + (swz % 64) / 2; }
__host__ __device__ __forceinline__ int perm32(int rho) { const int n = rho >> 4, i = rho & 15; return 8 * (i >> 2) + 4 * n + (i & 3); }

struct Unit { int pm, pn; };
struct Gemm { const char* A; const char* Bt; int lda; int kstepA; int K; int nM, nN; int mode; };
__device__ __forceinline__ const char* abase(const Gemm& g, const Unit& u) {
    if (g.mode == 1) { const int pm = u.pm; return g.A + ((size_t)(pm >> 4) * ((size_t)T * 256) + (size_t)((pm & 15) >> 2) * 64 + (size_t)(pm & 3) * 256 * 4096) * 2; }
    return g.A + (size_t)u.pm * ((size_t)BM * g.lda * 2);
}
__device__ __forceinline__ const char* bbase(const Gemm& g, const Unit& u) {
    if (g.mode == 1) return g.Bt + (size_t)(u.pm >> 4) * ((size_t)256 * 2048 * 2);
    return g.Bt + (size_t)u.pn * ((size_t)BM * g.K * 2);
}

struct StaticOrder {
    int nM, nN, nwg, G, c;
    __device__ void init(int nM_, int nN_, int G_, int c_) { nM = nM_; nN = nN_; nwg = nM * nN; G = G_; c = c_; }
    __device__ bool next(int i, Unit& u) const {
        if (c < 0) return false;
        const long L = (long)i * G + c; if (L >= nwg) return false;
        int wgid = (int)L; { const int q = nwg / NXCD, r = nwg % NXCD, xcd = wgid % NXCD, off = wgid / NXCD; wgid = (xcd < r ? xcd * (q + 1) : r * (q + 1) + (xcd - r) * q) + off; }
        const int nig = WGM * nN, gid = wgid / nig, fm = gid * WGM, gsz = (nM - fm) < WGM ? (nM - fm) : WGM;
        u.pm = fm + ((wgid % nig) % gsz); u.pn = (wgid % nig) / gsz; return true;
    }
};

template <class Epi, class Sched, bool ALIGN_EPI = true, bool SP2 = true>
__device__ __forceinline__ void gemm_phase(LAS unsigned char* lds, const Gemm g, const Sched& S, const Epi& E) {
    const int tid = threadIdx.x, wid = __builtin_amdgcn_readfirstlane(tid >> 6), lane = tid & 63, wr = wid >> 2, wc = wid & 3, fr = lane & 15, fq = lane >> 4;
    const int K = g.K, nt = K / BK;
    unsigned voffA[2], voffB[2];
#pragma unroll
    for (int i = 0; i < 2; ++i) { int R, C; stage_rc(tid * 16 + i * 8192, R, C); const int Rb = Epi::PERM ? ((R & ~31) + perm32(R & 31)) : R;
        voffA[i] = (unsigned)(R * g.lda + C) * 2u; voffB[i] = (unsigned)(Rb * K + C) * 2u; }
    const size_t kstepA = (size_t)g.kstepA, kstepB = (size_t)(BK * 2);
    const size_t hstepA = (size_t)HALF * g.lda * 2, hstepB = (size_t)HALF * K * 2;
    const unsigned ldsw = (unsigned)wid * 1024u;
    const int aoff = lds_byte(wr * 64 + fr, fq * 8), boff = lds_byte(wc * 32 + fr, fq * 8);
#define PG8_SA(b, h) (((b) * 2 + (h)) * HTB)
#define PG8_SB(b, h) ((4 + (b) * 2 + (h)) * HTB)
#define PG8_STAGE(bufoff, gbase, voff) do { _Pragma("unroll") for (int _i = 0; _i < 2; ++_i) \
        __builtin_amdgcn_global_load_lds((const unsigned*)((const char*)(gbase) + (voff)[_i]), (LAS unsigned*)(lds + (bufoff) + ldsw + _i * 8192), 16, 0, 0); } while (0)
#define PG8_LDA(dst, b, h) do { _Pragma("unroll") for (int m = 0; m < 4; ++m) _Pragma("unroll") for (int k = 0; k < 2; ++k) dst[m][k] = *(const LAS bf16x8*)(lds + PG8_SA(b, h) + aoff + m * 2048 + k * 1024); } while (0)
#define PG8_LDB(dst, b, h) do { _Pragma("unroll") for (int n = 0; n < 2; ++n) _Pragma("unroll") for (int k = 0; k < 2; ++k) dst[n][k] = *(const LAS bf16x8*)(lds + PG8_SB(b, h) + boff + n * 2048 + k * 1024); } while (0)
#define PG8_MMA(ai, bj, At, Bt) do { __builtin_amdgcn_s_setprio(1); _Pragma("unroll") for (int m = 0; m < 4; ++m) _Pragma("unroll") for (int n = 0; n < 2; ++n) _Pragma("unroll") for (int k = 0; k < 2; ++k) \
        acc[ai][bj][m][n] = __builtin_amdgcn_mfma_f32_16x16x32_bf16(Bt[n][k], At[m][k], acc[ai][bj][m][n], 0, 0, 0); __builtin_amdgcn_s_setprio(0); } while (0)
#define PG8_WAIT_V(n) asm volatile("s_waitcnt vmcnt(" #n ")" ::: "memory")
#define PG8_WAIT_L(n) asm volatile("s_waitcnt lgkmcnt(" #n ")" ::: "memory")
#define PG8_BAR __builtin_amdgcn_s_barrier()
#define PG8_SCHED __builtin_amdgcn_sched_barrier(0)
    Unit cur, nxt; int ui = 0;
    if (!S.next(0, cur)) return;
    f32x4 acc[2][2][4][2];
#pragma unroll
    for (int a = 0; a < 2; ++a)
#pragma unroll
        for (int b = 0; b < 2; ++b)
#pragma unroll
            for (int m = 0; m < 4; ++m)
#pragma unroll
                for (int n = 0; n < 2; ++n) acc[a][b][m][n] = (f32x4){0.f, 0.f, 0.f, 0.f};
    bf16x8 At[4][2], B0[2][2], B1[2][2];
    const char* cA = abase(g, cur); const char* cB = bbase(g, cur);
    if constexpr (SP2) {
        PG8_STAGE(PG8_SB(0, 0), cB, voffB); PG8_STAGE(PG8_SB(0, 1), cB + hstepB, voffB); PG8_STAGE(PG8_SA(0, 0), cA, voffA); PG8_STAGE(PG8_SA(0, 1), cA + hstepA, voffA);
        if (wr == 1) PG8_BAR;
        PG8_WAIT_V(2); PG8_BAR;
        PG8_STAGE(PG8_SB(1, 0), cB + kstepB, voffB); PG8_STAGE(PG8_SA(1, 0), cA + kstepA, voffA); PG8_STAGE(PG8_SB(1, 1), cB + hstepB + kstepB, voffB);
        PG8_WAIT_V(6); PG8_BAR;
    } else {
        PG8_STAGE(PG8_SB(0, 0), cB, voffB); PG8_STAGE(PG8_SA(0, 0), cA, voffA); PG8_STAGE(PG8_SB(0, 1), cB + hstepB, voffB); PG8_STAGE(PG8_SA(0, 1), cA + hstepA, voffA);
        if (wr == 1) PG8_BAR;
        PG8_WAIT_V(4); PG8_BAR;
        PG8_STAGE(PG8_SB(1, 0), cB + kstepB, voffB); PG8_STAGE(PG8_SA(1, 0), cA + kstepA, voffA); PG8_STAGE(PG8_SB(1, 1), cB + hstepB + kstepB, voffB);
        PG8_WAIT_V(6); PG8_BAR;
    }
    for (;;) {
        const bool has_next = S.next(ui + 1, nxt);
        const char* nA = has_next ? abase(g, nxt) : cA + (size_t)(nt - 2) * kstepA; const char* nB = has_next ? bbase(g, nxt) : cB + (size_t)(nt - 2) * kstepB;
        for (int t = 0; t < nt; t += 2) {
            const bool last = (t == nt - 2);
            const char* a1 = cA + (size_t)(t + 1) * kstepA;
            const char* a2 = last ? nA : cA + (size_t)(t + 2) * kstepA; const char* b2 = last ? nB : cB + (size_t)(t + 2) * kstepB;
            const char* a3 = a2 + kstepA; const char* b3 = b2 + kstepB;
            if constexpr (SP2) {
            PG8_LDB(B0, 0, 0); PG8_LDB(B1, 0, 1); PG8_SCHED; PG8_LDA(At, 0, 0); PG8_STAGE(PG8_SA(1, 1), a1 + hstepA, voffA);
            PG8_WAIT_V(8); PG8_WAIT_L(0); PG8_BAR; PG8_MMA(0, 0, At, B0); PG8_MMA(0, 1, At, B1); PG8_BAR; PG8_SCHED;
            PG8_LDA(At, 0, 1); PG8_STAGE(PG8_SB(0, 0), b2, voffB); PG8_STAGE(PG8_SB(0, 1), b2 + hstepB, voffB); PG8_STAGE(PG8_SA(0, 0), a2, voffA);
            PG8_WAIT_V(8); PG8_WAIT_L(0); PG8_BAR; PG8_MMA(1, 0, At, B0); PG8_MMA(1, 1, At, B1); PG8_BAR; PG8_SCHED;
            PG8_LDB(B0, 1, 0); PG8_LDB(B1, 1, 1); PG8_SCHED; PG8_LDA(At, 1, 0); PG8_STAGE(PG8_SA(0, 1), a2 + hstepA, voffA);
            PG8_WAIT_V(8); PG8_WAIT_L(0); PG8_BAR; PG8_MMA(0, 0, At, B0); PG8_MMA(0, 1, At, B1); PG8_BAR; PG8_SCHED;
            PG8_LDA(At, 1, 1); PG8_STAGE(PG8_SB(1, 0), b3, voffB); PG8_STAGE(PG8_SB(1, 1), b3 + hstepB, voffB); PG8_STAGE(PG8_SA(1, 0), a3, voffA);
            PG8_WAIT_V(8); PG8_WAIT_L(0); PG8_BAR; PG8_MMA(1, 0, At, B0); PG8_MMA(1, 1, At, B1); PG8_BAR; PG8_SCHED;
            } else {
            PG8_LDB(B0, 0, 0); PG8_SCHED; PG8_LDA(At, 0, 0); PG8_STAGE(PG8_SA(1, 1), a1 + hstepA, voffA);
            PG8_WAIT_L(8); PG8_BAR; PG8_WAIT_L(0); PG8_MMA(0, 0, At, B0); PG8_BAR; PG8_SCHED;
            PG8_LDB(B1, 0, 1); PG8_STAGE(PG8_SB(0, 0), b2, voffB);
            PG8_BAR; PG8_WAIT_L(0); PG8_MMA(0, 1, At, B1); PG8_BAR;
            PG8_LDA(At, 0, 1); PG8_STAGE(PG8_SA(0, 0), a2, voffA);
            PG8_BAR; PG8_WAIT_L(0); PG8_MMA(1, 0, At, B0); PG8_BAR; PG8_SCHED;
            PG8_STAGE(PG8_SB(0, 1), b2 + hstepB, voffB);
            PG8_WAIT_V(6); PG8_BAR; PG8_MMA(1, 1, At, B1); PG8_BAR;
            PG8_LDB(B0, 1, 0); PG8_SCHED; PG8_LDA(At, 1, 0); PG8_STAGE(PG8_SA(0, 1), a2 + hstepA, voffA);
            PG8_WAIT_L(8); PG8_BAR; PG8_WAIT_L(0); PG8_MMA(0, 0, At, B0); PG8_BAR; PG8_SCHED;
            PG8_LDB(B1, 1, 1); PG8_STAGE(PG8_SB(1, 0), b3, voffB);
            PG8_BAR; PG8_WAIT_L(0); PG8_MMA(0, 1, At, B1); PG8_BAR;
            PG8_LDA(At, 1, 1); PG8_STAGE(PG8_SA(1, 0), a3, voffA);
            PG8_BAR; PG8_WAIT_L(0); PG8_MMA(1, 0, At, B0); PG8_BAR; PG8_SCHED;
            PG8_STAGE(PG8_SB(1, 1), b3 + hstepB, voffB);
            PG8_WAIT_V(6); PG8_BAR; PG8_MMA(1, 1, At, B1); PG8_BAR;
            }
        }
        if constexpr (ALIGN_EPI) { if (wr == 0) PG8_BAR; }
        if constexpr (!Epi::AFTER_DRAIN) E(acc, cur, wr, wc, fr, fq);
        if (!has_next) break;
#pragma unroll
        for (int a = 0; a < 2; ++a)
#pragma unroll
            for (int b = 0; b < 2; ++b)
#pragma unroll
                for (int m = 0; m < 4; ++m)
#pragma unroll
                    for (int n = 0; n < 2; ++n) acc[a][b][m][n] = (f32x4){0.f, 0.f, 0.f, 0.f};
        cur = nxt; cA = nA; cB = nB; ++ui;
        if constexpr (ALIGN_EPI) { if (wr == 1) PG8_BAR; }
    }
    PG8_WAIT_V(0);
    if constexpr (!ALIGN_EPI) { if (wr == 0) PG8_BAR; }
    PG8_BAR;
    if constexpr (Epi::AFTER_DRAIN) E.fused(acc, cur, wr, wc, fr, fq, lds, wid, lane);
#undef PG8_SA
#undef PG8_SB
#undef PG8_STAGE
#undef PG8_LDA
#undef PG8_LDB
#undef PG8_MMA
#undef PG8_WAIT_V
#undef PG8_WAIT_L
#undef PG8_BAR
#undef PG8_SCHED
}

typedef f32x4 Acc[2][2][4][2];
__device__ __forceinline__ void load_rs(const float* ssp, int row0, int fq, float (&rs)[2][4]) {
#pragma unroll
    for (int ai = 0; ai < 2; ++ai)
#pragma unroll
        for (int m = 0; m < 4; ++m) { const f32x4* pp = (const f32x4*)(ssp + (size_t)(row0 + 128 * ai + 16 * m) * 16); const f32x4 p0 = pp[0], p1 = pp[1], p2 = pp[2], p3 = pp[3];
            const float s = (((p0.x + p0.y) + (p0.z + p0.w)) + ((p1.x + p1.y) + (p1.z + p1.w))) + (((p2.x + p2.y) + (p2.z + p2.w)) + ((p3.x + p3.y) + (p3.z + p3.w)));
            rs[ai][m] = rsqrtf(s * (1.0f / 1024.0f) + EPS); asm volatile("" : "+v"(rs[ai][m]) :: "memory"); }
}
#define ACC8(v, ai, bj, m, sc) do { const f32x4 a0_ = acc[ai][bj][m][0], a1_ = acc[ai][bj][m][1]; v[0] = a0_[0] * (sc); v[1] = a0_[1] * (sc); v[2] = a0_[2] * (sc); v[3] = a0_[3] * (sc); \
        v[4] = a1_[0] * (sc); v[5] = a1_[1] * (sc); v[6] = a1_[2] * (sc); v[7] = a1_[3] * (sc); } while (0)

struct EpiSwiGLU { static constexpr bool PERM = true, AFTER_DRAIN = false; const float* ssp; bf16_t* hid;
    __device__ __forceinline__ void operator()(const Acc& acc, const Unit& u, int wr, int wc, int fr, int fq) const {
        const int row0 = u.pm * 256 + wr * 64 + fr; float rs[2][4]; load_rs(ssp, row0, fq, rs);
#pragma unroll
        for (int ai = 0; ai < 2; ++ai)
#pragma unroll
            for (int m = 0; m < 4; ++m) { float gt[8], up[8], o[8]; ACC8(gt, ai, 0, m, rs[ai][m]); ACC8(up, ai, 1, m, rs[ai][m]);
#pragma unroll
                for (int j = 0; j < 8; ++j) o[j] = gt[j];
                silu8(o);
#pragma unroll
                for (int j = 0; j < 8; ++j) o[j] *= up[j];
                *(u32x4*)(hid + (size_t)(row0 + 128 * ai + 16 * m) * FF + u.pn * 128 + wc * 32 + fq * 8) = pack8(o); }
    }
};
struct EpiResid { static constexpr bool PERM = true, AFTER_DRAIN = false; const bf16_t* baseb; float coef; bf16_t* hb; float* ssp;
    __device__ __forceinline__ void operator()(const Acc& acc, const Unit& u, int wr, int wc, int fr, int fq) const {
        const int row0 = u.pm * 256 + wr * 64 + fr;
#pragma unroll
        for (int ai = 0; ai < 2; ++ai)
#pragma unroll
            for (int m = 0; m < 4; ++m) { const int row = row0 + 128 * ai + 16 * m; float ss = 0.f;
#pragma unroll
                for (int bj = 0; bj < 2; ++bj) { const size_t off = (size_t)row * DM + u.pn * 256 + bj * 128 + wc * 32 + fq * 8; float v[8], bb[8]; ACC8(v, ai, bj, m, coef);
                    unpack8(*(const u32x4*)(baseb + off), bb);
#pragma unroll
                    for (int j = 0; j < 8; ++j) { v[j] += bb[j]; ss += v[j] * v[j]; }
                    *(u32x4*)(hb + off) = pack8(v); }
                ss += __shfl_xor(ss, 16); ss += __shfl_xor(ss, 32);
                if (fq == 0) ssp[(size_t)row * 16 + u.pn * 4 + wc] = ss; }
    }
};
struct EpiPle { static constexpr bool PERM = true, AFTER_DRAIN = false; const float* ssp_in; const bf16_t* pp; const bf16_t* hb; float* out; float* ssp;
    __device__ __forceinline__ void operator()(const Acc& acc, const Unit& u, int wr, int wc, int fr, int fq) const {
        const int row0 = u.pm * 256 + wr * 64 + fr; float rs[2][4]; load_rs(ssp_in, row0, fq, rs);
#pragma unroll
        for (int ai = 0; ai < 2; ++ai)
#pragma unroll
            for (int m = 0; m < 4; ++m) { const int row = row0 + 128 * ai + 16 * m; float ss = 0.f;
#pragma unroll
                for (int bj = 0; bj < 2; ++bj) { const size_t off = (size_t)row * DM + u.pn * 256 + bj * 128 + wc * 32 + fq * 8; float v[8], pv[8], bb[8]; ACC8(v, ai, bj, m, rs[ai][m]);
                    unpack8(*(const u32x4*)(pp + off), pv); unpack8(*(const u32x4*)(hb + off), bb);
#pragma unroll
                    for (int j = 0; j < 8; ++j) { v[j] = bb[j] + fsigmoid(v[j]) * pv[j]; ss += v[j] * v[j]; }
                    *(f32x4*)(out + off) = (f32x4){v[0], v[1], v[2], v[3]}; *(f32x4*)(out + off + 4) = (f32x4){v[4], v[5], v[6], v[7]}; }
                ss += __shfl_xor(ss, 16); ss += __shfl_xor(ss, 32);
                if (fq == 0) ssp[(size_t)row * 16 + u.pn * 4 + wc] = ss; }
    }
};
struct EpiPleFinal { static constexpr bool PERM = true, AFTER_DRAIN = true; const float* ssp_in; const bf16_t* pp; const bf16_t* hb; float* out; const float* fnorm; unsigned* xbuf; unsigned* cnt;
    __device__ __forceinline__ void operator()(const Acc&, const Unit&, int, int, int, int) const {}
    __device__ __forceinline__ void fused(Acc& acc, const Unit& u, int wr, int wc, int fr, int fq, LAS unsigned char* lds, int wid, int lane) const {
        const int row0 = u.pm * 256 + wr * 64 + fr; float rs[2][4]; load_rs(ssp_in, row0, fq, rs);
        LAS float* P = (LAS float*)lds;
        LAS float* Sr = (LAS float*)(lds + 4096);
        LAS unsigned* flag = (LAS unsigned*)(lds + 4096 + 1024);
#pragma unroll
        for (int ai = 0; ai < 2; ++ai)
#pragma unroll
            for (int m = 0; m < 4; ++m) { const int row = row0 + 128 * ai + 16 * m; float ss = 0.f;
#pragma unroll
                for (int bj = 0; bj < 2; ++bj) { const size_t off = (size_t)row * DM + u.pn * 256 + bj * 128 + wc * 32 + fq * 8; float v[8], pv[8], bb[8]; ACC8(v, ai, bj, m, rs[ai][m]);
                    unpack8(*(const u32x4*)(pp + off), pv); unpack8(*(const u32x4*)(hb + off), bb);
#pragma unroll
                    for (int j = 0; j < 8; ++j) { v[j] = bb[j] + fsigmoid(v[j]) * pv[j]; ss += v[j] * v[j]; }
                    acc[ai][bj][m][0] = (f32x4){v[0], v[1], v[2], v[3]}; acc[ai][bj][m][1] = (f32x4){v[4], v[5], v[6], v[7]}; }
                ss += __shfl_xor(ss, 16); ss += __shfl_xor(ss, 32);
                if (fq == 0) P[(128 * ai + 64 * wr + 16 * m + fr) * 4 + wc] = ss; }
        __syncthreads();
        const int tid = wid * 64 + lane;
        if (tid < 256) { const float sum = (P[tid * 4 + 0] + P[tid * 4 + 1]) + (P[tid * 4 + 2] + P[tid * 4 + 3]);
            __hip_atomic_store(xbuf + ((size_t)u.pm * 256 + tid) * 4 + u.pn, __float_as_uint(sum), __ATOMIC_RELAXED, __HIP_MEMORY_SCOPE_AGENT); }
        asm volatile("s_waitcnt vmcnt(0)" ::: "memory");
        if (lane == 0) __hip_atomic_fetch_add(cnt + 64 * u.pm, 1u, __ATOMIC_RELAXED, __HIP_MEMORY_SCOPE_AGENT);
        if (wid == 0) { unsigned sp = 0;
            while ((unsigned)__builtin_amdgcn_readfirstlane(__hip_atomic_load(cnt + 64 * u.pm, __ATOMIC_RELAXED, __HIP_MEMORY_SCOPE_AGENT)) < 32u) { __builtin_amdgcn_s_sleep(2); if (++sp > (1u << 22)) break; }
            __builtin_amdgcn_fence(__ATOMIC_ACQUIRE, "agent");
            if (lane == 0) flag[0] = 1u; }
        asm volatile("s_waitcnt vmcnt(0) lgkmcnt(0)" ::: "memory");
        __syncthreads();
        if (tid < 256) { const unsigned* slot = xbuf + ((size_t)u.pm * 256 + tid) * 4; float s = 0.f;
#pragma unroll
            for (int t = 0; t < 4; ++t) s += __uint_as_float(__hip_atomic_load(slot + t, __ATOMIC_RELAXED, __HIP_MEMORY_SCOPE_AGENT));
            Sr[tid] = rsqrtf(s * (1.0f / 1024.0f) + EPS); }
        __syncthreads();
#pragma unroll
        for (int ai = 0; ai < 2; ++ai)
#pragma unroll
            for (int m = 0; m < 4; ++m) { const int lrow = 128 * ai + 64 * wr + 16 * m + fr; const float r = Sr[lrow];
#pragma unroll
                for (int bj = 0; bj < 2; ++bj) { const int col = u.pn * 256 + bj * 128 + wc * 32 + fq * 8; const size_t off = (size_t)(u.pm * 256 + lrow) * DM + col;
                    const f32x4 g0 = *(const f32x4*)(fnorm + col), g1 = *(const f32x4*)(fnorm + col + 4); const f32x4 a0 = acc[ai][bj][m][0], a1 = acc[ai][bj][m][1];
                    *(f32x4*)(out + off) = (f32x4){a0[0] * r * g0[0], a0[1] * r * g0[1], a0[2] * r * g0[2], a0[3] * r * g0[3]};
                    *(f32x4*)(out + off + 4) = (f32x4){a1[0] * r * g1[0], a1[1] * r * g1[1], a1[2] * r * g1[2], a1[3] * r * g1[3]}; } }
    }
};
template <int MODE> struct EpiBf16 { static constexpr bool PERM = true, AFTER_DRAIN = false; bf16_t* O; const float* ssp; const bf16_t* mul; const bf16_t* add;
    __device__ __forceinline__ void operator()(const Acc& acc, const Unit& u, int wr, int wc, int fr, int fq) const {
        const int row0 = u.pm * 256 + wr * 64 + fr; float rs[2][4];
        if (MODE == 1 || MODE == 4) load_rs(ssp, row0, fq, rs);
#pragma unroll
        for (int ai = 0; ai < 2; ++ai)
#pragma unroll
            for (int m = 0; m < 4; ++m)
#pragma unroll
                for (int bj = 0; bj < 2; ++bj) { const size_t off = (size_t)(row0 + 128 * ai + 16 * m) * DM + u.pn * 256 + bj * 128 + wc * 32 + fq * 8; float v[8];
                    ACC8(v, ai, bj, m, (MODE == 1 ? rs[ai][m] : 1.0f));
                    if (MODE == 1) {
#pragma unroll
                        for (int j = 0; j < 8; ++j) v[j] = fsigmoid(v[j]); }
                    if (MODE == 2 || MODE == 3) { float mv[8]; unpack8(*(const u32x4*)(mul + off), mv);
#pragma unroll
                        for (int j = 0; j < 8; ++j) v[j] *= mv[j]; }
                    if (MODE == 4) { float mv[8]; unpack8(*(const u32x4*)(mul + off), mv);
#pragma unroll
                        for (int j = 0; j < 8; ++j) mv[j] *= rs[ai][m];
                        sigmoid8(mv);
#pragma unroll
                        for (int j = 0; j < 8; ++j) v[j] *= mv[j]; }
                    if (MODE == 3 || MODE == 4) { float av[8]; unpack8(*(const u32x4*)(add + off), av);
#pragma unroll
                        for (int j = 0; j < 8; ++j) v[j] += av[j]; }
                    *(u32x4*)(O + off) = pack8(v); }
    }
};
struct EpiCmp1 { static constexpr bool PERM = true, AFTER_DRAIN = false; bf16_t* chid; const float* bias;
    __device__ __forceinline__ void operator()(const Acc& acc, const Unit& u, int wr, int wc, int fr, int fq) const {
        const int row0 = u.pm * 256 + wr * 64 + fr; const float* bs = bias + (u.pm >> 4) * 256;
#pragma unroll
        for (int bj = 0; bj < 2; ++bj) { const int col = bj * 128 + wc * 32 + fq * 8; const f32x4 b0 = *(const f32x4*)(bs + col), b1 = *(const f32x4*)(bs + col + 4);
            const float bb[8] = {b0[0], b0[1], b0[2], b0[3], b1[0], b1[1], b1[2], b1[3]};
#pragma unroll
            for (int ai = 0; ai < 2; ++ai)
#pragma unroll
                for (int m = 0; m < 4; ++m) { float v[8]; ACC8(v, ai, bj, m, 1.0f);
#pragma unroll
                    for (int j = 0; j < 8; ++j) v[j] = fgelu(v[j] + bb[j]);
                    *(u32x4*)(chid + (size_t)(row0 + 128 * ai + 16 * m) * 256 + col) = pack8(v); } }
    }
};
__device__ __forceinline__ void rope8(float (&v)[8], int fq, const float* cs) {
    const f32x4 c0 = *(const f32x4*)(cs), c1 = *(const f32x4*)(cs + 4), c2 = *(const f32x4*)(cs + 8), c3 = *(const f32x4*)(cs + 12);
    const float cc[8] = {c0[0], c0[2], c1[0], c1[2], c2[0], c2[2], c3[0], c3[2]}, sn[8] = {c0[1], c0[3], c1[1], c1[3], c2[1], c2[3], c3[1], c3[3]};
#pragma unroll
    for (int j = 0; j < 8; ++j) { const float other = __shfl_xor(v[j], 16); v[j] = (fq == 0) ? (v[j] * cc[j] - other * sn[j]) : (v[j] * cc[j] + other * sn[j]); }
}
struct EpiProj { static constexpr bool PERM = true, AFTER_DRAIN = false;
    const float* ssp; const float* rope; bf16_t *ub, *gv, *qraw, *qrot, *kc, *vc, *ks, *kw, *vst, *vwt, *ga; float* vstat; float* gate;
    __device__ __forceinline__ void operator()(const Acc& acc, const Unit& u, int wr, int wc, int fr, int fq) const {
        const int row0 = u.pm * 256 + wr * 64 + fr; float rs[2][4]; load_rs(ssp, row0, fq, rs);
        const int pn = u.pn;
        if (pn < 4) {
#pragma unroll
            for (int ai = 0; ai < 2; ++ai)
#pragma unroll
                for (int m = 0; m < 4; ++m)
#pragma unroll
                    for (int bj = 0; bj < 2; ++bj) { float v[8]; ACC8(v, ai, bj, m, rs[ai][m]);
#pragma unroll
                        for (int j = 0; j < 1; ++j) {}
                        gelu8(v);
                        *(u32x4*)(ub + (size_t)(row0 + 128 * ai + 16 * m) * DM + pn * 256 + bj * 128 + wc * 32 + fq * 8) = pack8(v); }
        } else if (pn >= 18 && pn < 22) {
#pragma unroll
            for (int ai = 0; ai < 2; ++ai)
#pragma unroll
                for (int m = 0; m < 4; ++m)
#pragma unroll
                    for (int bj = 0; bj < 2; ++bj) { float v[8]; ACC8(v, ai, bj, m, rs[ai][m]);
#pragma unroll
                        for (int j = 0; j < 1; ++j) {}
                        sigmoid8(v);
                        *(u32x4*)(ga + (size_t)(row0 + 128 * ai + 16 * m) * DM + (pn - 18) * 256 + bj * 128 + wc * 32 + fq * 8) = pack8(v); }
        } else if (pn < 8) {
#pragma unroll
            for (int ai = 0; ai < 2; ++ai)
#pragma unroll
                for (int m = 0; m < 4; ++m) { const int row = row0 + 128 * ai + 16 * m; float s1 = 0.f, s2 = 0.f;
#pragma unroll
                    for (int bj = 0; bj < 2; ++bj) { float v[8]; ACC8(v, ai, bj, m, rs[ai][m]);
#pragma unroll
                        for (int j = 0; j < 1; ++j) {}
                        gelu8(v);
#pragma unroll
                        for (int j = 0; j < 8; ++j) { s1 += v[j]; s2 += v[j] * v[j]; }
                        *(u32x4*)(gv + (size_t)row * DM + (pn - 4) * 256 + bj * 128 + wc * 32 + fq * 8) = pack8(v); }
                    s1 += __shfl_xor(s1, 16); s1 += __shfl_xor(s1, 32); s2 += __shfl_xor(s2, 16); s2 += __shfl_xor(s2, 32);
                    if (fq == 0) *(f32x2*)(vstat + ((size_t)row * 16 + (pn - 4) * 4 + wc) * 2) = (f32x2){s1, s2}; }
        } else if (pn < 12) {
#pragma unroll
            for (int ai = 0; ai < 2; ++ai)
#pragma unroll
                for (int m = 0; m < 4; ++m) { const int row = row0 + 128 * ai + 16 * m;
#pragma unroll
                    for (int bj = 0; bj < 2; ++bj) { float v[8]; ACC8(v, ai, bj, m, rs[ai][m] * QSCALE);
                        *(u32x4*)(qraw + (size_t)row * DM + (pn - 8) * 256 + bj * 128 + wc * 32 + fq * 8) = pack8(v);
                        if ((wc & 1) == 0) { rope8(v, fq, rope + (size_t)(row & (SEQ - 1)) * 16);
                            const int head = (pn - 8) * 4 + bj * 2 + (wc >> 1);
                            if (fq < 2) *(u32x4*)(qrot + ((size_t)row * 16 + head) * 16 + fq * 8) = pack8(v); } } }
        } else if (pn == 12 || pn == 13 || pn == 14 || pn == 16) {
            bf16_t* O = pn == 12 ? kc : pn == 13 ? vc : pn == 14 ? ks : kw; const bool rot = pn >= 14;
#pragma unroll
            for (int ai = 0; ai < 2; ++ai)
#pragma unroll
                for (int m = 0; m < 4; ++m) { const int row = row0 + 128 * ai + 16 * m;
#pragma unroll
                    for (int bj = 0; bj < 2; ++bj) { float v[8]; ACC8(v, ai, bj, m, rs[ai][m]);
                        if (rot && (wc & 1) == 0) { float w[8];
#pragma unroll
                            for (int j = 0; j < 8; ++j) w[j] = v[j];
                            rope8(w, fq, rope + (size_t)(row & (SEQ - 1)) * 16);
                            if (fq < 2) {
#pragma unroll
                                for (int j = 0; j < 8; ++j) v[j] = w[j]; } }
                        *(u32x4*)(O + (size_t)row * 256 + bj * 128 + wc * 32 + fq * 8) = pack8(v); } }
        } else if (pn == 15 || pn == 17) {
            bf16_t* O = pn == 15 ? vst : vwt;
#pragma unroll
            for (int ai = 0; ai < 2; ++ai)
#pragma unroll
                for (int m = 0; m < 4; ++m) { const int row = row0 + 128 * ai + 16 * m; const int b = row >> 12, t = row & (SEQ - 1);
#pragma unroll
                    for (int bj = 0; bj < 2; ++bj) { float v[8]; ACC8(v, ai, bj, m, rs[ai][m]); const int kvh = bj * 2 + (wc >> 1), d0 = (wc & 1) * 32 + fq * 8;
                        bf16_t* p = O + ((size_t)(b * 4 + kvh) * 64 + d0) * SEQ + t;
#pragma unroll
                        for (int j = 0; j < 8; j += 2) { const unsigned w = cvt_pk_bf16(v[j], v[j + 1]); p[(size_t)j * SEQ] = (bf16_t)(w & 0xffffu); p[(size_t)(j + 1) * SEQ] = (bf16_t)(w >> 16); } } }
        } else {
            if (wc < 2) {
#pragma unroll
                for (int ai = 0; ai < 2; ++ai)
#pragma unroll
                    for (int m = 0; m < 4; ++m) { const int row = row0 + 128 * ai + 16 * m; float v[8]; ACC8(v, ai, 0, m, rs[ai][m]); const int col = wc * 32 + fq * 8;
                        if (col < 48) {
#pragma unroll
                            for (int j = 0; j < 8; ++j) v[j] = fsigmoid(v[j]);
                            *(f32x4*)(gate + (size_t)row * 48 + col) = (f32x4){v[0], v[1], v[2], v[3]}; *(f32x4*)(gate + (size_t)row * 48 + col + 4) = (f32x4){v[4], v[5], v[6], v[7]}; } }
            }
        }
    }
};
}

struct Ctx { LAS unsigned char* lds; int tid, lane, wave, G, bid; };

__device__ __forceinline__ float wave_sum(float v) {
#pragma unroll
    for (int o = 1; o < 64; o <<= 1) v += __shfl_xor(v, o);
    return v;
}
__device__ __forceinline__ int map_row(int map, int n) {
    if (map == 1) { const int up = n >= FF ? 1 : 0, j = n - up * FF; return (j >> 7) * 256 + up * 128 + (j & 127); }
    if (map == 2) { if (n < 4608) return n; if (n < 4656) return 5632 + (n - 4608); if (n < 5680) return 4608 + (n - 4656); return N3 + (n - 5680); }
    return n;
}
constexpr int TR_SCR = 17408;
__device__ __forceinline__ void transpose_item(const float* W, int K, int N, bf16_t* WT, const float* ks, int map, LAS float* scr, int item, int lane) {
    const int nblk = (N + 63) / 64, kb = item / nblk, nb = item % nblk, k0 = 64 * kb, n0 = 64 * nb;
    const int n4 = (lane & 15) * 4, r0 = lane >> 4;
    f32x4 v[16];
#pragma unroll
    for (int i = 0; i < 16; ++i) { const int kk = r0 + 4 * i; v[i] = (f32x4){0.f, 0.f, 0.f, 0.f}; if (n0 + n4 < N) v[i] = *(const f32x4*)(W + (size_t)(k0 + kk) * N + n0 + n4); }
#pragma unroll
    for (int i = 0; i < 16; ++i) { const int kk = r0 + 4 * i; const float sc = ks ? ks[k0 + kk] : 1.0f; LAS float* d = scr + kk * 65 + n4;
        d[0] = v[i].x * sc; d[1] = v[i].y * sc; d[2] = v[i].z * sc; d[3] = v[i].w * sc; }
    LDS_FENCE();
    const int c = lane >> 3, nl = lane & 7;
#pragma unroll
    for (int j = 0; j < 8; ++j) { const int nn = nl + 8 * j, n = n0 + nn;
        if (n < N) { const LAS float* s0 = scr + (8 * c) * 65 + nn;
            u32x4 o; o.x = cvt_pk_bf16(s0[0 * 65], s0[1 * 65]); o.y = cvt_pk_bf16(s0[2 * 65], s0[3 * 65]); o.z = cvt_pk_bf16(s0[4 * 65], s0[5 * 65]); o.w = cvt_pk_bf16(s0[6 * 65], s0[7 * 65]);
            *(u32x4*)(WT + (size_t)map_row(map, n) * K + k0 + 8 * c) = o; } }
    LDS_FENCE();
}
struct TJob { const float* W; int K, N; bf16_t* dst; const float* ks; int map; };
__device__ __forceinline__ int tjob_items(const TJob& j) { return (j.K / 64) * ((j.N + 63) / 64); }

struct Args {
    const float* in[27]; float* out; unsigned char* ws; int ph_lo, ph_hi;
};
enum { I_X = 0, I_P, I_F1N, I_F1WI, I_F1WO, I_MIXN, I_WIN, I_LNG, I_LNB, I_GWS, I_GBS, I_WA, I_CPK, I_CKW1, I_CKW2, I_CPV, I_CVW1, I_CVW2, I_WB, I_WO,
       I_F2N, I_F2WI, I_F2WO, I_PLEN, I_PLEG, I_PLEP, I_FIN };

__device__ __forceinline__ void run_tjobs(const Ctx& C, const TJob* jobs, int njobs) {
    LAS float* scr = (LAS float*)(C.lds + C.wave * TR_SCR);
    const int gw = C.bid * 8 + C.wave, NGW = C.G * 8;
    int total = 0;
    for (int j = 0; j < njobs; ++j) total += tjob_items(jobs[j]);
    for (int it = gw; it < total; it += NGW) { int r = it;
        for (int j = 0; j < njobs; ++j) { const int n = tjob_items(jobs[j]); if (r < n) { transpose_item(jobs[j].W, jobs[j].K, jobs[j].N, jobs[j].dst, jobs[j].ks, jobs[j].map, scr, r, C.lane); break; } r -= n; } }
}

__device__ __forceinline__ void small_weight_item(const Args& a, unsigned char* ws, LAS float* scr, int r, int lane) {
    if (r < 256) { transpose_item(a.in[I_WA], 1024, 1024, (bf16_t*)(ws + WS_WA), nullptr, 0, scr, r, lane); return; } r -= 256;
    if (r < 256) { transpose_item(a.in[I_WB], 1024, 1024, (bf16_t*)(ws + WS_WB), nullptr, 0, scr, r, lane); return; } r -= 256;
    if (r < 256) { transpose_item(a.in[I_WO], 1024, 1024, (bf16_t*)(ws + WS_WO), nullptr, 0, scr, r, lane); return; } r -= 256;
    if (r < 256) { transpose_item(a.in[I_PLEG], 1024, 1024, (bf16_t*)(ws + WS_WPG), a.in[I_PLEN], 0, scr, r, lane); return; } r -= 256;
    transpose_item(a.in[I_PLEP], 256, 1024, (bf16_t*)(ws + WS_WPP), nullptr, 0, scr, r, lane);
}

__device__ __forceinline__ void p0_prologue(const Ctx& C, const Args& a) {
    unsigned char* ws = a.ws;
    {
        const int gw = C.bid * 8 + C.wave, NGW = C.G * 8;
        LAS float* scr = (LAS float*)(C.lds + C.wave * TR_SCR);
        const bool split = (C.G == 256);
        for (int it = gw; it < (split ? 1664 : 5136); it += NGW) { int r = it;
            if (r < 1408) { transpose_item(a.in[I_F1WI], 1024, 5632, (bf16_t*)(ws + WS_WFIN), a.in[I_F1N], 1, scr, r, C.lane); continue; } r -= 1408;
            if (!split) { if (r < 704) { transpose_item(a.in[I_F1WO], 2816, 1024, (bf16_t*)(ws + WS_WFOUT), nullptr, 0, scr, r, C.lane); continue; } r -= 704; }
            if (!split) { if (r < 1680) { transpose_item(a.in[I_WIN], 1024, 6704, (bf16_t*)(ws + WS_WIN), a.in[I_MIXN], 2, scr, r, C.lane); continue; } r -= 1680; }
            if (r < 128) { transpose_item(a.in[I_CKW1], 2048, 256, (bf16_t*)(ws + WS_WC1), nullptr, 0, scr, r, C.lane); continue; } r -= 128;
            if (r < 128) { transpose_item(a.in[I_CVW1], 2048, 256, (bf16_t*)(ws + WS_WC1) + 256 * 2048, nullptr, 0, scr, r, C.lane); continue; } r -= 128;
            small_weight_item(a, ws, scr, r, C.lane);
        }
        const float* x = a.in[I_X]; bf16_t* xb = (bf16_t*)(ws + WS_XB); float* ssa = (float*)(ws + WS_SSA);
        for (int r = gw; r < T; r += NGW) { const f32x4* xr = (const f32x4*)(x + (size_t)r * DM) + C.lane; float s = 0.f; f32x4 v[4];
#pragma unroll
            for (int j = 0; j < 4; ++j) { v[j] = xr[64 * j]; s += (v[j].x * v[j].x + v[j].y * v[j].y) + (v[j].z * v[j].z + v[j].w * v[j].w); }
            s = wave_sum(s);
            u32x2* o = (u32x2*)(xb + (size_t)r * DM) + C.lane;
#pragma unroll
            for (int j = 0; j < 4; ++j) o[64 * j] = (u32x2){cvt_pk_bf16(v[j].x, v[j].y), cvt_pk_bf16(v[j].z, v[j].w)};
            if (C.lane < 16) ssa[(size_t)r * 16 + C.lane] = C.lane == 0 ? s : 0.f; }
        float* cb = (float*)(ws + WS_CBIAS);
        for (int it = gw; it < 64; it += NGW) { const int tsr = it >> 5, n0 = (it & 31) * 8; const float* pos = a.in[tsr ? I_CPV : I_CPK]; const float* w1 = a.in[tsr ? I_CVW1 : I_CKW1];
            float acc8[8] = {0.f, 0.f, 0.f, 0.f, 0.f, 0.f, 0.f, 0.f};
            for (int i = 0; i < 32; ++i) { const int k = C.lane + 64 * i; const float pk = pos[k]; const f32x4 w0 = *(const f32x4*)(w1 + (size_t)k * 256 + n0), w4 = *(const f32x4*)(w1 + (size_t)k * 256 + n0 + 4);
                acc8[0] += pk * w0[0]; acc8[1] += pk * w0[1]; acc8[2] += pk * w0[2]; acc8[3] += pk * w0[3]; acc8[4] += pk * w4[0]; acc8[5] += pk * w4[1]; acc8[6] += pk * w4[2]; acc8[7] += pk * w4[3]; }
#pragma unroll
            for (int j = 0; j < 8; ++j) { const float s = wave_sum(acc8[j]); if (C.lane == 0) cb[tsr * 256 + n0 + j] = s; } }
    }
    const int gt = C.bid * 512 + C.tid, NGT = C.G * 512;
    {
        float* rope = (float*)(ws + WS_ROPE);
        for (int e = gt; e < SEQ * 8; e += NGT) { const int t = e >> 3, i = e & 7;
            const float invf = i == 0 ? 1.0f : i == 1 ? 0.1939227432012558f : i == 2 ? 0.03760603070259094f : i == 3 ? 0.007292664609849453f : i == 4 ? 0.0014142135623842478f : i == 5 ? 0.00027424818836152554f : i == 6 ? 5.318296098266728e-05f : 1.0313386155758053e-05f;
            const float angf = (float)t * invf; const double ang = (double)angf;
            const double qd = __builtin_rint(ang * 0.63661977236758134308); const double r = (ang - qd * 1.5707963267948966192) - qd * 6.123233995736766e-17; const int qi = ((int)qd) & 3;
            const double r2 = r * r;
            const double sr = r * (1.0 + r2 * (-1.0 / 6 + r2 * (1.0 / 120 + r2 * (-1.0 / 5040 + r2 * (1.0 / 362880 + r2 * (-1.0 / 39916800 + r2 * (1.0 / 6227020800.0)))))));
            const double cr = 1.0 + r2 * (-0.5 + r2 * (1.0 / 24 + r2 * (-1.0 / 720 + r2 * (1.0 / 40320 + r2 * (-1.0 / 3628800 + r2 * (1.0 / 479001600.0 + r2 * (-1.0 / 87178291200.0)))))));
            const double sn = qi == 0 ? sr : qi == 1 ? cr : qi == 2 ? -sr : -cr, cs = qi == 0 ? cr : qi == 1 ? -sr : qi == 2 ? -cr : sr;
            rope[e * 2] = (float)cs; rope[e * 2 + 1] = (float)sn; }
    }
    {
        const float* w = a.in[I_GWS]; bf16_t* o = (bf16_t*)(ws + WS_GMW);
        for (int e = gt; e < 8 * 128 * 128; e += NGT) { const int t = (e >> 7) & 127, s = e & 127; const float v = s <= t ? w[e] : 0.f; o[e] = (bf16_t)(cvt_pk_bf16(v, 0.f) & 0xffffu); }
    }
}

__device__ __forceinline__ void p8_extras(const Ctx& C, const Args& a) {
    unsigned char* ws = a.ws; const int gw = C.bid * 8 + C.wave, NGW = C.G * 8;
    LAS float* scr = (LAS float*)(C.lds + C.wave * TR_SCR);
    for (int it = gw; it < 2112; it += NGW) { int r = it;
        if (r < 1408) { transpose_item(a.in[I_F2WI], 1024, 5632, (bf16_t*)(ws + WS_WFIN), a.in[I_F2N], 1, scr, r, C.lane); continue; } r -= 1408;
        transpose_item(a.in[I_F2WO], 2816, 1024, (bf16_t*)(ws + WS_WFOUT), nullptr, 0, scr, r, C.lane); }
    const float* p = a.in[I_P]; bf16_t* pb = (bf16_t*)(ws + WS_PB);
    for (int r = gw; r < T; r += NGW) { const f32x4 v = ((const f32x4*)(p + (size_t)r * PLE))[C.lane]; ((u32x2*)(pb + (size_t)r * PLE))[C.lane] = (u32x2){cvt_pk_bf16(v.x, v.y), cvt_pk_bf16(v.z, v.w)}; }
}

__device__ __forceinline__ void gmlp_job(const Ctx& C, const Args& a, int job) {
    unsigned char* ws = a.ws; const int g = job & 7, chunk = job >> 3; const int tok0 = chunk * 128;
    const bf16_t* gv = (const bf16_t*)(ws + WS_GV); bf16_t* ub = (bf16_t*)(ws + WS_UB); const float* vstat = (const float*)(ws + WS_VSTAT); const bf16_t* gmw = (const bf16_t*)(ws + WS_GMW);
    LAS bf16_t* vnT = (LAS bf16_t*)C.lds;
    const int wr = C.wave >> 1, wc = C.wave & 1, n = C.lane & 31, hi = C.lane >> 5;
    bf16x8 af[8];
    {   const bf16_t* wrow = gmw + ((size_t)g * 128 + wr * 32 + n) * 128 + 8 * hi;
#pragma unroll
        for (int k0 = 0; k0 < 8; ++k0) af[k0] = *(const bf16x8*)(wrow + 16 * k0); }
    {   const int s = C.tid >> 2, cq = C.tid & 3; const size_t row = (size_t)tok0 + s;
        float s1 = 0.f, s2 = 0.f;
#pragma unroll
        for (int k = 0; k < 8; ++k) { const f32x4 p = *(const f32x4*)(vstat + row * 32 + 4 * k); s1 += p.x + p.z; s2 += p.y + p.w; }
        const float mean = s1 * (1.0f / 1024.0f), var = s2 * (1.0f / 1024.0f) - mean * mean, rstd = rsqrtf(var + EPS);
        const float* lng = a.in[I_LNG] + g * 128 + cq * 32; const float* lnb = a.in[I_LNB] + g * 128 + cq * 32;
#pragma unroll
        for (int c8 = 0; c8 < 4; ++c8) { float v[8]; unpack8(*(const u32x4*)(gv + row * DM + g * 128 + cq * 32 + c8 * 8), v);
#pragma unroll
            for (int j = 0; j < 8; ++j) { const float y = (v[j] - mean) * rstd * lng[c8 * 8 + j] + lnb[c8 * 8 + j]; vnT[(cq * 32 + c8 * 8 + j) * 136 + s] = (bf16_t)(cvt_pk_bf16(y, 0.f) & 0xffffu); } }
    }
    __syncthreads();
    {   f32x16 acc0 = {}, acc1 = {};
        const LAS bf16_t* b0p = vnT + (wc * 64 + n) * 136 + 8 * hi; const LAS bf16_t* b1p = b0p + 32 * 136;
#pragma unroll
        for (int k0 = 0; k0 < 8; ++k0) if (k0 < 2 * (wr + 1)) { const bf16x8 bf0 = *(const LAS bf16x8*)(b0p + 16 * k0), bf1 = *(const LAS bf16x8*)(b1p + 16 * k0);
            acc0 = __builtin_amdgcn_mfma_f32_32x32x16_bf16(af[k0], bf0, acc0, 0, 0, 0); acc1 = __builtin_amdgcn_mfma_f32_32x32x16_bf16(af[k0], bf1, acc1, 0, 0, 0); }
        const float* bs = a.in[I_GBS] + g * 128 + wr * 32;
#pragma unroll
        for (int r = 0; r < 16; ++r) { const int tl = (r & 3) + 8 * (r >> 2) + 4 * hi; const float bias = bs[tl]; const size_t off = ((size_t)tok0 + wr * 32 + tl) * DM + g * 128 + wc * 64 + n;
            const float u0 = bf2f(ub[off]), u1 = bf2f(ub[off + 32]);
            ub[off] = (bf16_t)(cvt_pk_bf16(u0 * (acc0[r] + bias), 0.f) & 0xffffu); ub[off + 32] = (bf16_t)(cvt_pk_bf16(u1 * (acc1[r] + bias), 0.f) & 0xffffu); }
    }
    __syncthreads();
}

__device__ __forceinline__ void cmp2_phase(const Ctx& C, const Args& a) {
    unsigned char* ws = a.ws; const bf16_t* chid = (const bf16_t*)(ws + WS_CHID); bf16_t* kcmp = (bf16_t*)(ws + WS_KCMP); bf16_t* vcmpT = (bf16_t*)(ws + WS_VCMPT);
    const int gw = C.bid * 8 + C.wave, NGW = C.G * 8;
    for (int it = gw; it < 2048; it += NGW) { const int tsr = it >> 10, R0 = (it & 1023) * 4;
        const float* w2 = a.in[tsr ? I_CVW2 : I_CKW2]; const bf16_t* hr = chid + ((size_t)tsr * 4096 + R0) * 256;
        float acc[4] = {0.f, 0.f, 0.f, 0.f};
        for (int k8 = 0; k8 < 32; ++k8) { float wv[8];
#pragma unroll
            for (int j = 0; j < 8; ++j) wv[j] = w2[(k8 * 8 + j) * 64 + C.lane];
#pragma unroll
            for (int rr = 0; rr < 4; ++rr) { float hv[8]; unpack8(*(const u32x4*)(hr + rr * 256 + k8 * 8), hv);
#pragma unroll
                for (int j = 0; j < 8; ++j) acc[rr] += hv[j] * wv[j]; } }
#pragma unroll
        for (int rr = 0; rr < 4; ++rr) { const int R = R0 + rr; const int h = R >> 10, b = (R >> 8) & 3, i = R & 255;
            const bf16_t o = (bf16_t)(cvt_pk_bf16(i == 255 ? 0.f : acc[rr], 0.f) & 0xffffu);
            if (tsr == 0) kcmp[((size_t)(b * 4 + h) * 256 + i) * 64 + C.lane] = o; else vcmpT[((size_t)(b * 4 + h) * 64 + C.lane) * 256 + i] = o; } }
}

__device__ __forceinline__ void final_phase(const Ctx& C, const Args& a) {
    const float* ssa = (const float*)(a.ws + WS_SSA); const float* fn = a.in[I_FIN]; const int gw = C.bid * 8 + C.wave, NGW = C.G * 8;
    for (int r = gw; r < T; r += NGW) { float s = C.lane < 16 ? ssa[(size_t)r * 16 + C.lane] : 0.f; s = wave_sum(s); const float rstd = rsqrtf(s * (1.0f / 1024.0f) + EPS);
        f32x4* o = (f32x4*)(a.out + (size_t)r * DM) + C.lane; const f32x4* gp = (const f32x4*)fn + C.lane;
#pragma unroll
        for (int j = 0; j < 4; ++j) { const f32x4 v = o[64 * j], gg = gp[64 * j]; o[64 * j] = (f32x4){v.x * rstd * gg.x, v.y * rstd * gg.y, v.z * rstd * gg.z, v.w * rstd * gg.w}; } }
}

namespace att {
constexpr int ROWB = 144;
constexpr int TILEB = 64 * ROWB;
constexpr int OFF_K = 0, OFF_V = 2 * TILEB, OFF_PC = 4 * TILEB, PCROW = 260, OFF_WSF = OFF_PC + 64 * PCROW * 4, OFF_SELM = OFF_WSF + 8 * 64 * 4, LDS_END = OFF_SELM + 64 * 8;
static_assert(LDS_END <= 131072, "attention LDS");
__device__ __forceinline__ int crow(int r, int hi) { return (r & 3) + 8 * (r >> 2) + 4 * hi; }

struct Stream { const bf16_t* K; size_t kstride; const bf16_t* V; size_t vstride; };

struct State { float m, l; f32x16 o0, o1; };

struct Pre { u32x4 k0, v0, k1; };
__device__ __forceinline__ Pre prefetch(int tid, const Stream& S, int t0, int nt, bool needv) {
    const int lr = tid >> 3, lc = tid & 7; Pre p;
    const bf16_t* kg = S.K + (size_t)(t0 * 64 + lr) * S.kstride + lc * 8;
    p.k0 = *(const u32x4*)kg; p.v0 = (u32x4){0u, 0u, 0u, 0u}; p.k1 = p.v0;
    if (needv) p.v0 = *(const u32x4*)(S.V + (size_t)lr * S.vstride + (size_t)t0 * 64 + lc * 8);
    if (nt > 1) p.k1 = *(const u32x4*)(kg + (size_t)64 * S.kstride);
    return p;
}
template <int MODE>
__device__ __forceinline__ void run_branch(int tid, LAS unsigned char* lds, const Stream& S, const Pre& pre, int t0, int nt, const bf16x8 (&qf)[4], int klo, int khi, unsigned long long selbits,
                                           State& st, float inv_l, int tokl, int g) {
    const int lane = tid & 63, q = lane & 31, hi = lane >> 5, wid = __builtin_amdgcn_readfirstlane(tid >> 6);
    const int lr = tid >> 3, lc = tid & 7;
    const int pim = 16 * (q >> 4) + 8 * ((q >> 2) & 1) + 4 * ((q >> 3) & 1) + (q & 3);
    LAS float* wsf = (LAS float*)(lds + OFF_WSF) + wid * 64;
    LAS float* pc = (LAS float*)(lds + OFF_PC);
    const bf16_t* kg = S.K + (size_t)(t0 * 64 + lr) * S.kstride + lc * 8;
    const bf16_t* vg = S.V + (size_t)lr * S.vstride + (size_t)t0 * 64 + lc * 8;
    const unsigned sto = lr * ROWB + lc * 16;
    u32x4 kreg = pre.k1, vreg = pre.v0;
    *(LAS u32x4*)(lds + OFF_K + sto) = pre.k0; if (MODE != 1) *(LAS u32x4*)(lds + OFF_V + sto) = pre.v0;
    if (nt > 1) *(LAS u32x4*)(lds + OFF_K + TILEB + sto) = pre.k1;
    __syncthreads();
    const LAS unsigned char* kfb = lds + OFF_K + pim * ROWB + hi * 16;
    f32x16 p0 = {}, p1 = {};
#pragma unroll
    for (int d0 = 0; d0 < 4; ++d0) { const bf16x8 a0 = *(const LAS bf16x8*)(kfb + d0 * 32), a1 = *(const LAS bf16x8*)(kfb + 32 * ROWB + d0 * 32);
        p0 = __builtin_amdgcn_mfma_f32_32x32x16_bf16(a0, qf[d0], p0, 0, 0, 0); p1 = __builtin_amdgcn_mfma_f32_32x32x16_bf16(a1, qf[d0], p1, 0, 0, 0); }
    f32x16 q0 = {}, q1 = {};
    for (int t = 0; t < nt; t += 2) {
        {   const int jt = t0 + t; constexpr int buf = 0;
        if (t + 2 < nt) kreg = *(const u32x4*)(kg + (size_t)(t + 2) * 64 * S.kstride);
        if (MODE != 1 && t + 1 < nt) vreg = *(const u32x4*)(vg + (size_t)(t + 1) * 64);
        const int kb0 = jt * 64;
        const bool bit = (selbits >> jt) & 1ull;
        const bool none = !bit || kb0 > khi || kb0 + 63 < klo;
        const bool allv = bit && kb0 >= klo && kb0 + 63 <= khi;
        const bool colv = !none;
        if (__any(colv && !allv)) {
            const int hr = khi - kb0 - 8 * hi, lrr = klo - kb0 - 8 * hi;
#pragma unroll
            for (int r = 0; r < 16; ++r) { const int c = 16 * (r >> 3) + (r & 7);
                if (!(c <= hr && c >= lrr)) p0[r] = -__builtin_inff();
                if (!(c + 32 <= hr && c + 32 >= lrr)) p1[r] = -__builtin_inff(); }
        }
        float tm = fmaxf(fmaxf(p0[0], p0[1]), p0[2]);
#pragma unroll
        for (int r = 3; r < 15; r += 2) tm = fmaxf(fmaxf(tm, p0[r]), p0[r + 1]);
        tm = fmaxf(tm, p0[15]);
#pragma unroll
        for (int r = 0; r < 16; r += 2) tm = fmaxf(fmaxf(tm, p1[r]), p1[r + 1]);
        tm = fmaxf(tm, __shfl_xor(tm, 32));
        if (!colv) tm = -__builtin_inff();
        float mref;
        if (MODE == 2) { mref = st.m; }
        else {
            if (__any(tm > st.m + 8.0f)) {
                const float mn = fmaxf(st.m, tm); const float alpha = __builtin_amdgcn_exp2f(st.m - mn); st.l *= alpha; st.m = mn;
                if (MODE == 0) { if (hi == 0) wsf[q] = alpha; LDS_FENCE();
#pragma unroll
                    for (int r = 0; r < 16; ++r) { const float f = wsf[crow(r, hi)]; st.o0[r] *= f; st.o1[r] *= f; }
                    LDS_FENCE(); }
            }
            mref = st.m;
        }
        const float msub = colv ? mref : __builtin_inff();
        q0 = (f32x16){}; q1 = (f32x16){};
        {   const LAS unsigned char* kb = kfb + (buf ^ 1) * TILEB;
#pragma unroll
            for (int d0 = 0; d0 < 4; ++d0) { const bf16x8 a0 = *(const LAS bf16x8*)(kb + d0 * 32), a1 = *(const LAS bf16x8*)(kb + 32 * ROWB + d0 * 32);
                q0 = __builtin_amdgcn_mfma_f32_32x32x16_bf16(a0, qf[d0], q0, 0, 0, 0); q1 = __builtin_amdgcn_mfma_f32_32x32x16_bf16(a1, qf[d0], q1, 0, 0, 0); } }
        float ls = 0.f;
#pragma unroll
        for (int r = 0; r < 16; ++r) { p0[r] = __builtin_amdgcn_exp2f(p0[r] - msub); p1[r] = __builtin_amdgcn_exp2f(p1[r] - msub); ls += p0[r] + p1[r]; }
        if (MODE != 2) st.l += ls;
        if (MODE == 2) {
#pragma unroll
            for (int r = 0; r < 16; ++r) { p0[r] *= inv_l; p1[r] *= inv_l; }
            float hs0[16], hs1[16];
#pragma unroll
            for (int r = 0; r < 16; ++r) { hs0[r] = quad_sum(p0[r]); hs1[r] = quad_sum(p1[r]); }
            if (g == 0) { LAS float* pr = pc + tokl * PCROW + kb0 + 8 * hi;
#pragma unroll
                for (int r = 0; r < 16; ++r) { pr[16 * (r >> 3) + (r & 7)] = hs0[r]; pr[16 * (r >> 3) + (r & 7) + 32] = hs1[r]; } }
        }
        if (MODE != 1) {
            bf16x8 pa[4];
            {   u32x4 w;
                w.x = cvt_pk_bf16(p0[0], p0[1]); w.y = cvt_pk_bf16(p0[2], p0[3]); w.z = cvt_pk_bf16(p0[4], p0[5]); w.w = cvt_pk_bf16(p0[6], p0[7]); pa[0] = __builtin_bit_cast(bf16x8, w);
                w.x = cvt_pk_bf16(p0[8], p0[9]); w.y = cvt_pk_bf16(p0[10], p0[11]); w.z = cvt_pk_bf16(p0[12], p0[13]); w.w = cvt_pk_bf16(p0[14], p0[15]); pa[1] = __builtin_bit_cast(bf16x8, w);
                w.x = cvt_pk_bf16(p1[0], p1[1]); w.y = cvt_pk_bf16(p1[2], p1[3]); w.z = cvt_pk_bf16(p1[4], p1[5]); w.w = cvt_pk_bf16(p1[6], p1[7]); pa[2] = __builtin_bit_cast(bf16x8, w);
                w.x = cvt_pk_bf16(p1[8], p1[9]); w.y = cvt_pk_bf16(p1[10], p1[11]); w.z = cvt_pk_bf16(p1[12], p1[13]); w.w = cvt_pk_bf16(p1[14], p1[15]); pa[3] = __builtin_bit_cast(bf16x8, w); }
            const LAS unsigned char* vb = lds + OFF_V + buf * TILEB + q * ROWB + hi * 16;
#pragma unroll
            for (int c = 0; c < 4; ++c) { const bf16x8 v0 = *(const LAS bf16x8*)(vb + c * 32), v1 = *(const LAS bf16x8*)(vb + 32 * ROWB + c * 32);
                st.o0 = __builtin_amdgcn_mfma_f32_32x32x16_bf16(pa[c], v0, st.o0, 0, 0, 0); st.o1 = __builtin_amdgcn_mfma_f32_32x32x16_bf16(pa[c], v1, st.o1, 0, 0, 0); }
        }
        if (t + 2 < nt) *(LAS u32x4*)(lds + OFF_K + buf * TILEB + sto) = kreg;
        if (MODE != 1 && t + 1 < nt) *(LAS u32x4*)(lds + OFF_V + (buf ^ 1) * TILEB + sto) = vreg;
        __syncthreads();
        }
        if (t + 1 < nt) { const int t_ = t; { const int t = t_ + 1; const int jt = t0 + t; constexpr int buf = 1;
        if (t + 2 < nt) kreg = *(const u32x4*)(kg + (size_t)(t + 2) * 64 * S.kstride);
        if (MODE != 1 && t + 1 < nt) vreg = *(const u32x4*)(vg + (size_t)(t + 1) * 64);
        const int kb0 = jt * 64;
        const bool bit = (selbits >> jt) & 1ull;
        const bool none = !bit || kb0 > khi || kb0 + 63 < klo;
        const bool allv = bit && kb0 >= klo && kb0 + 63 <= khi;
        const bool colv = !none;
        if (__any(colv && !allv)) {
            const int hr = khi - kb0 - 8 * hi, lrr = klo - kb0 - 8 * hi;
#pragma unroll
            for (int r = 0; r < 16; ++r) { const int c = 16 * (r >> 3) + (r & 7);
                if (!(c <= hr && c >= lrr)) q0[r] = -__builtin_inff();
                if (!(c + 32 <= hr && c + 32 >= lrr)) q1[r] = -__builtin_inff(); }
        }
        float tm = fmaxf(fmaxf(q0[0], q0[1]), q0[2]);
#pragma unroll
        for (int r = 3; r < 15; r += 2) tm = fmaxf(fmaxf(tm, q0[r]), q0[r + 1]);
        tm = fmaxf(tm, q0[15]);
#pragma unroll
        for (int r = 0; r < 16; r += 2) tm = fmaxf(fmaxf(tm, q1[r]), q1[r + 1]);
        tm = fmaxf(tm, __shfl_xor(tm, 32));
        if (!colv) tm = -__builtin_inff();
        float mref;
        if (MODE == 2) { mref = st.m; }
        else {
            if (__any(tm > st.m + 8.0f)) {
                const float mn = fmaxf(st.m, tm); const float alpha = __builtin_amdgcn_exp2f(st.m - mn); st.l *= alpha; st.m = mn;
                if (MODE == 0) { if (hi == 0) wsf[q] = alpha; LDS_FENCE();
#pragma unroll
                    for (int r = 0; r < 16; ++r) { const float f = wsf[crow(r, hi)]; st.o0[r] *= f; st.o1[r] *= f; }
                    LDS_FENCE(); }
            }
            mref = st.m;
        }
        const float msub = colv ? mref : __builtin_inff();
        p0 = (f32x16){}; p1 = (f32x16){};
        {   const LAS unsigned char* kb = kfb + (buf ^ 1) * TILEB;
#pragma unroll
            for (int d0 = 0; d0 < 4; ++d0) { const bf16x8 a0 = *(const LAS bf16x8*)(kb + d0 * 32), a1 = *(const LAS bf16x8*)(kb + 32 * ROWB + d0 * 32);
                p0 = __builtin_amdgcn_mfma_f32_32x32x16_bf16(a0, qf[d0], p0, 0, 0, 0); p1 = __builtin_amdgcn_mfma_f32_32x32x16_bf16(a1, qf[d0], p1, 0, 0, 0); } }
        float ls = 0.f;
#pragma unroll
        for (int r = 0; r < 16; ++r) { q0[r] = __builtin_amdgcn_exp2f(q0[r] - msub); q1[r] = __builtin_amdgcn_exp2f(q1[r] - msub); ls += q0[r] + q1[r]; }
        if (MODE != 2) st.l += ls;
        if (MODE == 2) {
#pragma unroll
            for (int r = 0; r < 16; ++r) { q0[r] *= inv_l; q1[r] *= inv_l; }
            float hs0[16], hs1[16];
#pragma unroll
            for (int r = 0; r < 16; ++r) { hs0[r] = quad_sum(q0[r]); hs1[r] = quad_sum(q1[r]); }
            if (g == 0) { LAS float* pr = pc + tokl * PCROW + kb0 + 8 * hi;
#pragma unroll
                for (int r = 0; r < 16; ++r) { pr[16 * (r >> 3) + (r & 7)] = hs0[r]; pr[16 * (r >> 3) + (r & 7) + 32] = hs1[r]; } }
        }
        if (MODE != 1) {
            bf16x8 pa[4];
            {   u32x4 w;
                w.x = cvt_pk_bf16(q0[0], q0[1]); w.y = cvt_pk_bf16(q0[2], q0[3]); w.z = cvt_pk_bf16(q0[4], q0[5]); w.w = cvt_pk_bf16(q0[6], q0[7]); pa[0] = __builtin_bit_cast(bf16x8, w);
                w.x = cvt_pk_bf16(q0[8], q0[9]); w.y = cvt_pk_bf16(q0[10], q0[11]); w.z = cvt_pk_bf16(q0[12], q0[13]); w.w = cvt_pk_bf16(q0[14], q0[15]); pa[1] = __builtin_bit_cast(bf16x8, w);
                w.x = cvt_pk_bf16(q1[0], q1[1]); w.y = cvt_pk_bf16(q1[2], q1[3]); w.z = cvt_pk_bf16(q1[4], q1[5]); w.w = cvt_pk_bf16(q1[6], q1[7]); pa[2] = __builtin_bit_cast(bf16x8, w);
                w.x = cvt_pk_bf16(q1[8], q1[9]); w.y = cvt_pk_bf16(q1[10], q1[11]); w.z = cvt_pk_bf16(q1[12], q1[13]); w.w = cvt_pk_bf16(q1[14], q1[15]); pa[3] = __builtin_bit_cast(bf16x8, w); }
            const LAS unsigned char* vb = lds + OFF_V + buf * TILEB + q * ROWB + hi * 16;
#pragma unroll
            for (int c = 0; c < 4; ++c) { const bf16x8 v0 = *(const LAS bf16x8*)(vb + c * 32), v1 = *(const LAS bf16x8*)(vb + 32 * ROWB + c * 32);
                st.o0 = __builtin_amdgcn_mfma_f32_32x32x16_bf16(pa[c], v0, st.o0, 0, 0, 0); st.o1 = __builtin_amdgcn_mfma_f32_32x32x16_bf16(pa[c], v1, st.o1, 0, 0, 0); }
        }
        if (t + 2 < nt) *(LAS u32x4*)(lds + OFF_K + buf * TILEB + sto) = kreg;
        if (MODE != 1 && t + 1 < nt) *(LAS u32x4*)(lds + OFF_V + (buf ^ 1) * TILEB + sto) = vreg;
        __syncthreads();
        } }
    }
}

struct Tensors { const bf16_t *qraw, *qrot, *ks, *kw, *vst, *vwt, *kcmp, *vcmpT; const float* gate; bf16_t* ob; };

template <bool FIRST>
__device__ __forceinline__ void fold(LAS float* wsf, LAS float* oacc, int q, int hi, float fac, const State& st) {
    if (hi == 0) wsf[q] = fac; LDS_FENCE();
#pragma unroll
    for (int r = 0; r < 16; ++r) { const int row = crow(r, hi); const float f = wsf[row]; LAS float* p = oacc + row * 64 + q;
        if (FIRST) { p[0] = st.o0[r] * f; p[32] = st.o1[r] * f; } else { p[0] += st.o0[r] * f; p[32] += st.o1[r] * f; } }
    LDS_FENCE();
}

__device__ __forceinline__ void job(LAS unsigned char* lds, const Tensors& X, int b, int kvh, int qb) {
    int tid_ = threadIdx.x; asm volatile("" : "+v"(tid_));
    const int tid = tid_, lane = tid & 63, q = lane & 31, hi = lane >> 5, wid = __builtin_amdgcn_readfirstlane(tid >> 6);
    const int tokl = 8 * wid + (q >> 2), g = q & 3, tq = 64 * qb + tokl, head = 4 * kvh + g;
    const size_t trow = (size_t)b * SEQ + tq;
    LAS float* wsf = (LAS float*)(lds + OFF_WSF) + wid * 64;
    LAS float* pc = (LAS float*)(lds + OFF_PC);
    LAS unsigned long long* selm = (LAS unsigned long long*)(lds + OFF_SELM);
    bf16x8 qf[4];
    {   const bf16_t* qp = X.qraw + trow * DM + head * 64 + 8 * hi;
#pragma unroll
        for (int d0 = 0; d0 < 4; ++d0) qf[d0] = *(const bf16x8*)(qp + 16 * d0); }
    const float g0 = X.gate[trow * 48 + head * 3 + 0], g1 = X.gate[trow * 48 + head * 3 + 1], g2 = X.gate[trow * 48 + head * 3 + 2];
    LAS float* oacc = pc + 8 * wid * PCROW;
    const size_t bk = (size_t)b * 4 + kvh;
    const Stream Ssel{X.ks + (size_t)b * SEQ * 256 + kvh * 64, 256, X.vst + bk * 64 * SEQ, SEQ};
    Pre prs;
    {   const Stream S{X.kcmp + bk * 256 * 64, 64, X.vcmpT + bk * 64 * 256, 256};
        const int nct = (qb >> 4) + 1; const int mmax = tq >= 31 ? ((tq - 31) >> 4) : -1;
        State st; st.m = -1e30f; st.l = 0.f; st.o0 = (f32x16){}; st.o1 = (f32x16){};
        const Pre prc = prefetch(tid, S, 0, nct, true);
        run_branch<1>(tid, lds, S, prc, 0, nct, qf, -(1 << 30), mmax, ~0ull, st, 0.f, tokl, g);
        float lt = st.l + __shfl_xor(st.l, 32); const float inv_l = lt > 0.f ? 1.0f / lt : 0.f;
        run_branch<2>(tid, lds, S, prc, 0, nct, qf, -(1 << 30), mmax, ~0ull, st, inv_l, tokl, g);
    prs = prefetch(tid, Ssel, 0, qb + 1, true);
    {
        if (qb < 16) { if (lane < 8) selm[8 * wid + lane] = (2ull << qb) - 1ull; }
        else
#pragma unroll 1
        for (int i = 0; i < 4; ++i) { const int j = lane; unsigned keyA, keyB;
            if (j == 0 || j == qb || j == qb - 1) { keyA = 0xffffffc0u; keyB = 0xffffffc0u; } else if (j > qb) { keyA = 0u; keyB = 0u; }
            else { const LAS float* pa_ = pc + (8 * wid + i) * PCROW + 4 * j; const LAS float* pb_ = pa_ + 4 * PCROW;
                const float sa = (((pa_[-1] + pa_[0]) + pa_[1]) + pa_[2]) + pa_[3], sb = (((pb_[-1] + pb_[0]) + pb_[1]) + pb_[2]) + pb_[3];
                keyA = (__float_as_uint(sa) & 0x7fffffc0u) + 64u; keyB = (__float_as_uint(sb) & 0x7fffffc0u) + 64u; }
            keyA |= (unsigned)(63 - j); keyB |= (unsigned)(63 - j);
            unsigned thrA = 0u, thrB = 0u;
#pragma unroll
            for (int bpos = 29; bpos >= 0; --bpos) { const unsigned cA = thrA | (1u << bpos), cB = thrB | (1u << bpos);
                const unsigned long long mA = __ballot(keyA >= cA), mB = __ballot(keyB >= cB); if (__popcll(mA) >= 16) thrA = cA; if (__popcll(mB) >= 16) thrB = cB; }
            const unsigned long long maskA = __ballot(keyA >= thrA), maskB = __ballot(keyB >= thrB);
            if (lane == 0) { selm[8 * wid + i] = maskA; selm[8 * wid + i + 4] = maskB; } }
        LDS_FENCE();
        fold<true>(wsf, oacc, q, hi, g0, st);
    }
    }
    const unsigned long long mysel = selm[tokl];
    qf[0] = *(const bf16x8*)(X.qrot + (trow * 16 + head) * 16 + 8 * hi);
    const Stream Swin{X.kw + (size_t)b * SEQ * 256 + kvh * 64, 256, X.vwt + bk * 64 * SEQ, SEQ};
    const int tw0 = qb >= 8 ? qb - 8 : 0;
    Pre prw;
    {   State st; st.m = -1e30f; st.l = 0.f; st.o0 = (f32x16){}; st.o1 = (f32x16){};
        run_branch<0>(tid, lds, Ssel, prs, 0, qb + 1, qf, -(1 << 30), tq, mysel, st, 0.f, tokl, g);
        prw = prefetch(tid, Swin, tw0, qb + 1 - tw0, true);
        const float lt = st.l + __shfl_xor(st.l, 32); fold<false>(wsf, oacc, q, hi, lt > 0.f ? g1 / lt : 0.f, st);
    }
    {   State st; st.m = -1e30f; st.l = 0.f; st.o0 = (f32x16){}; st.o1 = (f32x16){};
        run_branch<0>(tid, lds, Swin, prw, tw0, qb + 1 - tw0, qf, tq - 511, tq, ~0ull, st, 0.f, tokl, g);
        const float lt = st.l + __shfl_xor(st.l, 32); fold<false>(wsf, oacc, q, hi, lt > 0.f ? g2 / lt : 0.f, st);
    }
    {   const int qq = lane >> 1, ch = lane & 1; const LAS float* src = oacc + qq * 64 + ch * 32;
        bf16_t* op = X.ob + ((size_t)b * SEQ + 64 * qb + 8 * wid + (qq >> 2)) * DM + (4 * kvh + (qq & 3)) * 64 + ch * 32;
#pragma unroll
        for (int c = 0; c < 4; ++c) { const f32x4 x0 = *(const LAS f32x4*)(src + c * 8), x1 = *(const LAS f32x4*)(src + c * 8 + 4);
            *(u32x4*)(op + c * 8) = (u32x4){cvt_pk_bf16(x0[0], x0[1]), cvt_pk_bf16(x0[2], x0[3]), cvt_pk_bf16(x1[0], x1[1]), cvt_pk_bf16(x1[2], x1[3])}; }
        LDS_FENCE(); }
}
}


#define XB_TMO      128
#define XB_XCNT(j)  (256  + 64 * (j))
#define XB_XSUB(j)  (1280 + 64 * (j))
#define XB_XGEN(j)  (2304 + 64 * (j))
#define XB_TOP      3328
#define XB_TOPGEN   3392
#define XCD_BAR_WORDS 3456
#define XB_SPIN_CAP (1u << 20)
__device__ __forceinline__ unsigned xb_ld(unsigned* p)              { return __hip_atomic_load(p, __ATOMIC_RELAXED, __HIP_MEMORY_SCOPE_AGENT); }
__device__ __forceinline__ unsigned xb_add(unsigned* p, unsigned v) { return __hip_atomic_fetch_add(p, v, __ATOMIC_RELAXED, __HIP_MEMORY_SCOPE_AGENT); }
__device__ __forceinline__ unsigned xb_xcc_id() { return (unsigned)__builtin_amdgcn_s_getreg((3 << 11) | 20) & 0xFu; }
#define XB_SPIN(cond, bar) do { unsigned _sp = 0; while (cond) { __builtin_amdgcn_s_sleep(1); \
    if ((++_sp & 255u) == 0u) { if (xb_ld(&(bar)[XB_TMO])) break; if (_sp > XB_SPIN_CAP) { atomicAdd(&(bar)[XB_TMO], 1u); break; } } } } while (0)
struct XcdBarrier { unsigned* bar; unsigned x; volatile LAS unsigned* st; };
__device__ __forceinline__ XcdBarrier xcd_barrier_post(unsigned* bar, volatile LAS unsigned* st) {
    XcdBarrier b; b.bar = bar; b.x = xb_xcc_id(); b.st = st;
    if (threadIdx.x == 0) (void)xb_add(&bar[XB_XCNT(b.x)], 1u);
    return b;
}
__device__ __forceinline__ void xcd_barrier_complete(unsigned* bar, unsigned x, unsigned& nloc, unsigned& nx) {
    const unsigned G = gridDim.x * gridDim.y * gridDim.z;
    unsigned sum, cnt, mine, sp = 0u;
    for (;;) {
        sum = 0u; cnt = 0u; mine = 0u;
#pragma unroll
        for (unsigned j = 0; j < 16; ++j) { const unsigned c = xb_ld(&bar[XB_XCNT(j)]); sum += c; cnt += (c > 0u) ? 1u : 0u; mine = (j == x) ? c : mine; }
        if (sum == G) break;
        __builtin_amdgcn_s_sleep(1);
        if ((++sp & 255u) == 0u) { if (xb_ld(&bar[XB_TMO])) break; if (sp > XB_SPIN_CAP) { atomicAdd(&bar[XB_TMO], 1u); break; } }
    }
    nloc = mine > 0u ? mine : 1u; nx = cnt > 0u ? cnt : 1u;
}
__device__ __forceinline__ void xcd_barrier(const XcdBarrier& b) {
    asm volatile("s_waitcnt vmcnt(0)" ::: "memory");
    __syncthreads();
    if (threadIdx.x == 0) {
        unsigned* bar = b.bar;
        __builtin_amdgcn_s_waitcnt(0);
        unsigned nloc = b.st[0], nx = b.st[1];
        if (nloc == 0u) { xcd_barrier_complete(bar, b.x, nloc, nx); b.st[0] = nloc; b.st[1] = nx; }
        const unsigned old = xb_add(&bar[XB_XSUB(b.x)], 1u);
        const unsigned gen = old / nloc;
        if (old + 1u == (gen + 1u) * nloc) {
            __builtin_amdgcn_fence(__ATOMIC_RELEASE, "agent");
            asm volatile("s_waitcnt vmcnt(0)" ::: "memory");
            const unsigned og = xb_add(&bar[XB_TOP], 1u);
            const unsigned tg = og / nx;
            if (og + 1u == (tg + 1u) * nx) xb_add(&bar[XB_TOPGEN], 1u);
            else XB_SPIN(xb_ld(&bar[XB_TOPGEN]) == tg, bar);
            __builtin_amdgcn_fence(__ATOMIC_ACQUIRE, "agent");
            xb_add(&bar[XB_XGEN(b.x)], 1u);
            asm volatile("s_waitcnt vmcnt(0)" ::: "memory");
        } else {
            XB_SPIN(xb_ld(&bar[XB_XGEN(b.x)]) == gen, bar);
            __builtin_amdgcn_fence(__ATOMIC_ACQUIRE, "agent");
            asm volatile("s_waitcnt vmcnt(0)" ::: "memory");
        }
    }
    __syncthreads();
}

constexpr int LDS_BYTES = 147456;
typedef const __attribute__((address_space(4))) Args* KArgP;
#define KARGS() (*(const Args*)({ KArgP p_ = (KArgP)__builtin_amdgcn_kernarg_segment_ptr(); asm volatile("" : "+s"(p_)); p_; }))
__global__ void __launch_bounds__(512, 2) mk_fwd(Args a_unused) {
    extern __shared__ __attribute__((aligned(16))) unsigned char lds_raw[];
    Ctx C; C.lds = (LAS unsigned char*)lds_raw; C.tid = threadIdx.x; C.lane = C.tid & 63; C.wave = __builtin_amdgcn_readfirstlane(C.tid >> 6); C.G = gridDim.x; C.bid = blockIdx.x;
    const int lo = KARGS().ph_lo, hi = KARGS().ph_hi;
    volatile LAS unsigned* xst = (volatile LAS unsigned*)(C.lds + LDS_BYTES - 64);
    if (C.tid < 2) xst[C.tid] = 0u;
    __syncthreads();
    if (lo > NPHASE) cg::this_grid().sync();
    const XcdBarrier xbar = xcd_barrier_post((unsigned*)(KARGS().ws + WS_BAR), xst);
#ifdef ONLY_PHASE
#define IN(k) ((k) == ONLY_PHASE && lo <= (k) && (k) < hi)
#else
#define IN(k) (lo <= (k) && (k) < hi)
#endif
#define SEAM(k) do { if (IN(k) && IN((k) + 1)) { xcd_barrier(xbar); } } while (0)
    using namespace pg8;
    const int NT = T / 256;
#define PHASE_VARS const Args& a = KARGS(); unsigned char* ws = a.ws; float* ssA = (float*)(ws + WS_SSA); float* ssB = (float*)(ws + WS_SSB); bf16_t* hb = (bf16_t*)(ws + WS_HB); bf16_t* hid = (bf16_t*)(ws + WS_HID); float* ssC = (float*)(ws + WS_SSC); float* ssD = (float*)(ws + WS_SSD); (void)ssC; (void)ssD; \
    (void)ssA; (void)ssB; (void)hb; (void)hid;

    if (IN(0)) { PHASE_VARS p0_prologue(C, a);
#ifdef PROBE_P0X2
        __syncthreads(); p0_prologue(C, a);
#endif
    } SEAM(0);
    if (IN(1)) { PHASE_VARS
        Gemm g{(const char*)(ws + WS_XB), (const char*)(ws + WS_WFIN), DM, 128, DM, NT, 22, 0}; StaticOrder S; S.init(NT, 22, C.G, C.bid);
        EpiSwiGLU E{ssA, hid}; gemm_phase<EpiSwiGLU, StaticOrder>(C.lds, g, S, E);
        if (C.G == 256 && C.bid >= 128) { __syncthreads(); LAS float* scr = (LAS float*)(C.lds + C.wave * TR_SCR);
            for (int it = (C.bid - 128) * 8 + C.wave; it < 2384; it += 1024) { if (it < 704) transpose_item(a.in[I_F1WO], 2816, 1024, (bf16_t*)(ws + WS_WFOUT), nullptr, 0, scr, it, C.lane);
                else transpose_item(a.in[I_WIN], 1024, 6704, (bf16_t*)(ws + WS_WIN), a.in[I_MIXN], 2, scr, it - 704, C.lane); } }
#ifdef PROBE_G1X2
        gemm_phase<EpiSwiGLU, StaticOrder>(C.lds, g, S, E);
#endif
    } SEAM(1);
    if (IN(2)) { PHASE_VARS
        Gemm g{(const char*)hid, (const char*)(ws + WS_WFOUT), FF, 128, FF, NT, 4, 0}; StaticOrder S; S.init(NT, 4, C.G, C.bid);
        EpiResid E{(const bf16_t*)(ws + WS_XB), 0.5f, hb, ssB}; gemm_phase<EpiResid, StaticOrder>(C.lds, g, S, E);
    } SEAM(2);
    if (IN(3)) { PHASE_VARS
        Gemm g{(const char*)hb, (const char*)(ws + WS_WIN), DM, 128, DM, NT, 23, 0}; StaticOrder S; S.init(NT, 23, C.G, C.bid);
        EpiProj E{ssB, (const float*)(ws + WS_ROPE), (bf16_t*)(ws + WS_UB), (bf16_t*)(ws + WS_GV), (bf16_t*)(ws + WS_QRAW), (bf16_t*)(ws + WS_QROT), (bf16_t*)(ws + WS_KC), (bf16_t*)(ws + WS_VC),
                  (bf16_t*)(ws + WS_KS), (bf16_t*)(ws + WS_KW), (bf16_t*)(ws + WS_VST), (bf16_t*)(ws + WS_VWT), (bf16_t*)(ws + WS_GA), (float*)(ws + WS_VSTAT), (float*)(ws + WS_GATE)};
        gemm_phase<EpiProj, StaticOrder>(C.lds, g, S, E);
        if (C.G == 256 && C.bid >= 192) { __syncthreads(); LAS float* scr = (LAS float*)(C.lds + C.wave * TR_SCR);
            for (int it = (C.bid - 192) * 8 + C.wave; it < 1088; it += 512) small_weight_item(a, ws, scr, it, C.lane); }
#ifdef PROBE_G3X2
        gemm_phase<EpiProj, StaticOrder>(C.lds, g, S, E);
#endif
    } SEAM(3);
    if (IN(4)) { PHASE_VARS
#ifndef NO_CMP
        {   Gemm g{(const char*)(ws + WS_KC), (const char*)(ws + WS_WC1), 4096, 512, 2048, 32, 1, 1}; StaticOrder S; S.init(32, 1, C.G, C.bid);
            EpiCmp1 E{(bf16_t*)(ws + WS_CHID), (const float*)(ws + WS_CBIAS)}; gemm_phase<EpiCmp1, StaticOrder>(C.lds, g, S, E); }
#endif
        __syncthreads();
#ifndef NO_GMLP
        if (C.G == 256) { if (C.bid >= 32) for (int j = C.bid - 32; j < 1024; j += 224) gmlp_job(C, a, j); }
        else for (int j = C.bid; j < 1024; j += C.G) gmlp_job(C, a, j);
#endif
    } SEAM(4);
    if (IN(5)) { PHASE_VARS
        {   Gemm g{(const char*)(ws + WS_UB), (const char*)(ws + WS_WA), DM, 128, DM, NT, 4, 0}; StaticOrder S; S.init(NT, 4, C.G, C.bid);
            EpiBf16<2> E{(bf16_t*)(ws + WS_GV), nullptr, (const bf16_t*)(ws + WS_GA), nullptr}; gemm_phase<EpiBf16<2>, StaticOrder>(C.lds, g, S, E); }
#ifndef NO_CMP
        cmp2_phase(C, a);
#endif
    } SEAM(5);
    if (IN(6)) { PHASE_VARS
        att::Tensors X{(const bf16_t*)(ws + WS_QRAW), (const bf16_t*)(ws + WS_QROT), (const bf16_t*)(ws + WS_KS), (const bf16_t*)(ws + WS_KW), (const bf16_t*)(ws + WS_VST), (const bf16_t*)(ws + WS_VWT),
                       (const bf16_t*)(ws + WS_KCMP), (const bf16_t*)(ws + WS_VCMPT), (const float*)(ws + WS_GATE), (bf16_t*)(ws + WS_QRAW)};
#ifndef NO_ATTN
#ifdef PROBE_ATTN2
        { att::Tensors X0 = X; X0.ob = (bf16_t*)(ws + WS_UB);
        if (C.G == 256) { const int vcu = (C.bid & 7) * 32 + (C.bid >> 3); const int bkv = vcu >> 4, s = vcu & 15;
#pragma unroll 1
            for (int i = 0; i < 4; ++i) { const int qb = i == 0 ? 63 - s : i == 1 ? 32 + s : i == 2 ? 31 - s : s; att::job(C.lds, X0, bkv >> 2, bkv & 3, qb); }
        } else { for (int j = C.bid; j < 1024; j += C.G) { const int bkv = j & 15, qb = 63 - (j >> 4); att::job(C.lds, X0, bkv >> 2, bkv & 3, qb); } }
        __syncthreads(); }
#endif
        if (C.G == 256) { const int vcu = (C.bid & 7) * 32 + (C.bid >> 3); const int bkv = vcu >> 4, s = vcu & 15;
#pragma unroll 1
            for (int i = 0; i < 4; ++i) { const int qb = i == 0 ? 63 - s : i == 1 ? 32 + s : i == 2 ? 31 - s : s; att::job(C.lds, X, bkv >> 2, bkv & 3, qb); }
        } else { for (int j = C.bid; j < 1024; j += C.G) { const int bkv = j & 15, qb = 63 - (j >> 4); att::job(C.lds, X, bkv >> 2, bkv & 3, qb); } }
#endif
        __syncthreads();
#ifndef NO_GB
        {   Gemm g{(const char*)hb, (const char*)(ws + WS_WGB), DM, 128, DM, NT, 4, 0}; StaticOrder S; S.init(NT, 4, C.G, C.bid);
            EpiBf16<0> E{(bf16_t*)(ws + WS_UB), nullptr, nullptr, nullptr}; gemm_phase<EpiBf16<0>, StaticOrder>(C.lds, g, S, E); }
#endif
    } SEAM(6);
    if (IN(7)) { PHASE_VARS
        Gemm g{(const char*)(ws + WS_QRAW), (const char*)(ws + WS_WB), DM, 128, DM, NT, 4, 0}; StaticOrder S; S.init(NT, 4, C.G, C.bid);
        EpiBf16<4> E{(bf16_t*)(ws + WS_GV), ssB, (const bf16_t*)(ws + WS_UB), (const bf16_t*)(ws + WS_GV)}; gemm_phase<EpiBf16<4>, StaticOrder>(C.lds, g, S, E);
    } SEAM(7);
    if (IN(8)) { PHASE_VARS
        {   Gemm g{(const char*)(ws + WS_GV), (const char*)(ws + WS_WO), DM, 128, DM, NT, 4, 0}; StaticOrder S; S.init(NT, 4, C.G, C.bid);
            EpiResid E{hb, 1.0f, hb, ssC}; gemm_phase<EpiResid, StaticOrder>(C.lds, g, S, E); }
        __syncthreads();
        p8_extras(C, a);
    } SEAM(8);
    if (IN(9)) { PHASE_VARS
        {   Gemm g{(const char*)hb, (const char*)(ws + WS_WFIN), DM, 128, DM, NT, 22, 0}; StaticOrder S; S.init(NT, 22, C.G, C.bid);
            EpiSwiGLU E{ssC, hid}; gemm_phase<EpiSwiGLU, StaticOrder>(C.lds, g, S, E); }
        int opq = 0; asm volatile("" : "+s"(opq));
        if (opq == 0) {   int kple = PLE; asm volatile("" : "+s"(kple));
            Gemm g{(const char*)(ws + WS_PB), (const char*)(ws + WS_WPP), PLE, 128, kple, NT, 4, 0}; StaticOrder S;
            if (C.G == 256) S.init(NT, 4, 128, C.bid >= 128 ? C.bid - 128 : -1); else S.init(NT, 4, C.G, C.bid);
            EpiBf16<0> E{(bf16_t*)(ws + WS_PP), nullptr, nullptr, nullptr}; gemm_phase<EpiBf16<0>, StaticOrder>(C.lds, g, S, E); }
    } SEAM(9);
    if (IN(10)) { PHASE_VARS
        Gemm g{(const char*)hid, (const char*)(ws + WS_WFOUT), FF, 128, FF, NT, 4, 0}; StaticOrder S; S.init(NT, 4, C.G, C.bid);
        EpiResid E{hb, 0.5f, hb, ssD}; gemm_phase<EpiResid, StaticOrder>(C.lds, g, S, E);
    } SEAM(10);
    if (IN(11)) { PHASE_VARS
        Gemm g{(const char*)hb, (const char*)(ws + WS_WPG), DM, 128, DM, NT, 4, 0}; StaticOrder S; S.init(NT, 4, C.G, C.bid);
        if (C.G == 256) { EpiPleFinal E{ssD, (const bf16_t*)(ws + WS_PP), hb, a.out, a.in[I_FIN], (unsigned*)(ws + WS_BAR + 32768), (unsigned*)(ws + WS_BAR + 16384)};
            gemm_phase<EpiPleFinal, StaticOrder>(C.lds, g, S, E); }
        else { EpiPle E{ssD, (const bf16_t*)(ws + WS_PP), hb, a.out, ssA}; gemm_phase<EpiPle, StaticOrder>(C.lds, g, S, E); }
    }
    if (C.G != 256) { SEAM(11); if (IN(12)) { PHASE_VARS final_phase(C, a); } }
#undef IN
#undef SEAM
}

extern "C" void kernel_launch(void* const* d_in, const int* in_sizes, int n_in, void* d_out, int out_size, void* d_ws, size_t ws_size, hipStream_t stream) {
    static int grid = 0;
    if (grid == 0) {
        if (n_in != 27 || out_size != T * DM || ws_size < WS_END) { fprintf(stderr, "kernel_launch: unexpected problem (n_in %d, out %d, ws %zu)\n", n_in, out_size, ws_size); grid = -1; return; }
        int dev = 0, cus = 0, per_cu = 0;
        hipGetDevice(&dev); hipDeviceGetAttribute(&cus, hipDeviceAttributeMultiprocessorCount, dev);
        hipFuncSetAttribute((const void*)mk_fwd, hipFuncAttributeMaxDynamicSharedMemorySize, LDS_BYTES);
        hipOccupancyMaxActiveBlocksPerMultiprocessor(&per_cu, (const void*)mk_fwd, 512, LDS_BYTES);
        if (per_cu < 1) { fprintf(stderr, "kernel_launch: occupancy query says %d blocks per CU\n", per_cu); per_cu = 1; }
        (void)hipGetLastError();
        grid = cus * 1;
    }
    if (grid < 0) return;
    Args a{};
    for (int i = 0; i < 27; ++i) a.in[i] = (const float*)d_in[i];
    a.out = (float*)d_out; a.ws = (unsigned char*)d_ws;
#if MK_SINGLE
    hipMemsetAsync((char*)d_ws + WS_BAR, 0, 32768, stream);
    a.ph_lo = 0; a.ph_hi = NPHASE;
    void* args[] = {&a};
    hipError_t e = hipLaunchCooperativeKernel((const void*)mk_fwd, dim3(grid), dim3(512), args, LDS_BYTES, stream);
    if (e != hipSuccess) fprintf(stderr, "cooperative launch failed: %s (grid %d)\n", hipGetErrorString(e), grid);
#else
    for (int k = 0; k < NPHASE; ++k) { a.ph_lo = k; a.ph_hi = k + 1; hipLaunchKernelGGL(mk_fwd, dim3(grid), dim3(512), LDS_BYTES, stream, a); }
#endif
}
```
